# Optimizing an MI355X kernel written in HIP

```python
import jax, jax.numpy as jnp
from jax import lax
import numpy as np

D_MODEL = 1024
BATCH = 4
SEQ = 8192
DEPTH = 2
DEC_BATCH = 4
DEC_SEQ = 4096
PAST_LEN = 128

D_MIX = D_MODEL
CONV_WIDTH = D_MIX // 4
CONV_KERNEL = 31
CONV_PAD = CONV_KERNEL // 2
SGU_WIDTH = D_MIX // 4
SGU_HEADS = 4
SGU_HEAD_DIM = SGU_WIDTH // SGU_HEADS
SGU_CHUNK = 128
HGRN_WIDTH = D_MIX // 2
HGRN_EXPAND = 128
HGRN_HEADS = HGRN_WIDTH // HGRN_EXPAND
HGRN_HEAD_V = HGRN_WIDTH // HGRN_HEADS
HGRN_CHUNK = 64
SPLIT_SIZES = (CONV_WIDTH, CONV_WIDTH, CONV_WIDTH,
               SGU_WIDTH, SGU_WIDTH, SGU_WIDTH,
               HGRN_WIDTH, HGRN_WIDTH, HGRN_WIDTH, HGRN_WIDTH, HGRN_WIDTH)
SPLIT_OFFSETS = tuple(int(o) for o in np.cumsum(SPLIT_SIZES)[:-1])
D_IN = int(sum(SPLIT_SIZES))
EPS = 1e-6

kernel_name = "hymba_conv_sgu_hgrn2_bidir_encoder"


def rmsnorm(x, g):
    xf = x.astype(jnp.float32)
    y = xf * lax.rsqrt(jnp.mean(xf * xf, axis=-1, keepdims=True) + EPS)
    return (y * g.astype(jnp.float32)).astype(x.dtype)


def layernorm(x, g, b):
    xf = x.astype(jnp.float32)
    mu = jnp.mean(xf, axis=-1, keepdims=True)
    xc = xf - mu
    y = xc * lax.rsqrt(jnp.mean(xc * xc, axis=-1, keepdims=True) + EPS)
    return (y * g.astype(jnp.float32) + b.astype(jnp.float32)).astype(x.dtype)


def conv_branch(a_val, a_glu, a_gate, conv_w, conv_b, ln_g, ln_b, pw):
    y = a_val * jax.nn.sigmoid(a_glu)
    y = lax.conv_general_dilated(
        y, conv_w[:, None, :], window_strides=(1,), padding=[(CONV_PAD, CONV_PAD)],
        dimension_numbers=('NWC', 'WIO', 'NWC'), feature_group_count=CONV_WIDTH) + conv_b
    y = jax.nn.silu(layernorm(y, ln_g, ln_b))
    y = y @ pw
    return y * jax.nn.silu(a_gate)


def sgu_branch(b_u, b_v, b_gate, ln_g, ln_b, w_s, b_s):
    bsz, seq, _ = b_u.shape
    u = jax.nn.gelu(b_u, approximate=False)
    v = layernorm(jax.nn.gelu(b_v, approximate=False), ln_g, ln_b)
    v = v.reshape(bsz, seq // SGU_CHUNK, SGU_CHUNK, SGU_HEADS, SGU_HEAD_DIM)
    s = jnp.einsum('hts,bnshd->bnthd', w_s, v) + b_s.T[:, :, None]
    s = s.reshape(bsz, seq, SGU_WIDTH)
    return u * s * jax.nn.silu(b_gate)


def hgrn2_scan(q, k, logf, v):
    bsz, seq, nh, dk = q.shape
    dv = v.shape[-1]
    n = seq // HGRN_CHUNK

    def chunks(t):
        return t.reshape(bsz, n, HGRN_CHUNK, nh, t.shape[-1]).transpose(1, 0, 3, 2, 4)

    qc, kc, vc = chunks(q), chunks(k), chunks(v)
    bc = jnp.cumsum(chunks(logf), axis=3)
    mask = jnp.tril(jnp.ones((HGRN_CHUNK, HGRN_CHUNK), dtype=bool))

    def step(state, inp):
        qt, kt, vt, bt = inp
        diff = bt[:, :, :, None, :] - bt[:, :, None, :, :]
        decay = jnp.exp(jnp.where(mask[:, :, None], diff, -jnp.inf))
        scores = jnp.einsum('bhtk,bhsk,bhtsk->bhts', qt, kt, decay)
        o = (jnp.einsum('bhts,bhsv->bhtv', scores, vt)
             + jnp.einsum('bhtk,bhkv->bhtv', qt * jnp.exp(bt), state))
        b_last = bt[:, :, -1:, :]
        state = (jnp.exp(b_last[:, :, 0, :, None]) * state
                 + jnp.einsum('bhsk,bhsv->bhkv', kt * jnp.exp(b_last - bt), vt))
        return state, o

    s0 = jnp.zeros((bsz, nh, dk, dv), jnp.float32)
    _, o = lax.scan(step, s0, (qc, kc, vc, bc))
    return o.transpose(1, 0, 3, 2, 4).reshape(bsz, seq, nh, dv)


def hgrn_branch(c_q, c_i, c_ff, c_fb, c_gate, lb_f, lb_b, norm_g):
    bsz, seq, _ = c_q.shape

    def heads(t):
        return t.astype(jnp.float32).reshape(bsz, seq, HGRN_HEADS, -1)

    q, v = heads(c_q), heads(c_i)

    def forget(z, lb):
        lb = lb.astype(jnp.float32).reshape(HGRN_HEADS, HGRN_EXPAND)
        logf = jnp.logaddexp(jnp.log(lb), jnp.log1p(-lb) + jax.nn.log_sigmoid(z))
        k = (1.0 - lb) * jax.nn.sigmoid(-z)
        return k, logf

    k_f, logf_f = forget(heads(c_ff), lb_f)
    k_b, logf_b = forget(heads(c_fb), lb_b)
    flip = lambda t: jnp.flip(t, axis=1)
    o_f = hgrn2_scan(q, k_f, logf_f, v)
    o_b = flip(hgrn2_scan(flip(q), flip(k_b), flip(logf_b), flip(v)))
    o = rmsnorm(o_f + o_b, norm_g)
    o = o.reshape(bsz, seq, HGRN_WIDTH).astype(c_gate.dtype)
    return o * jax.nn.silu(c_gate)


def trunk(x, norm_g, w_in, conv_w, conv_b, conv_ln_g, conv_ln_b, conv_pw,
          sgu_ln_g, sgu_ln_b, sgu_w, sgu_b, hgrn_lb_fwd, hgrn_lb_bwd, hgrn_norm_g,
          w_out, final_norm_g):
    def lower_bounds(p):
        lb = jnp.cumsum(jax.nn.softmax(p.astype(jnp.float32), axis=0), axis=0)
        return lb - lb[0:1]

    lbf_all = lower_bounds(hgrn_lb_fwd)
    lbb_all = lower_bounds(hgrn_lb_bwd)
    for l in range(DEPTH):
        h = rmsnorm(x, norm_g[l])
        p = h @ w_in[l]
        (a_val, a_glu, a_gate, b_u, b_v, b_gate,
         c_q, c_i, c_ff, c_fb, c_gate) = jnp.split(p, SPLIT_OFFSETS, axis=-1)
        y_a = conv_branch(a_val, a_glu, a_gate, conv_w[l], conv_b[l],
                          conv_ln_g[l], conv_ln_b[l], conv_pw[l])
        y_b = sgu_branch(b_u, b_v, b_gate, sgu_ln_g[l], sgu_ln_b[l], sgu_w[l], sgu_b[l])
        y_c = hgrn_branch(c_q, c_i, c_ff, c_fb, c_gate, lbf_all[l], lbb_all[l], hgrn_norm_g[l])
        y = jnp.concatenate([y_a, y_b, y_c], axis=-1)
        x = x + y @ w_out[l]
    return rmsnorm(x, final_norm_g)


def setup_inputs(seed: int = 0) -> dict:
    key = jax.random.key(seed)
    ks = jax.random.split(key, 20)
    f32 = jnp.float32
    nrm = lambda k, shape, scale: (jax.random.normal(k, shape, f32) * scale).astype(f32)
    return {
        "x_prompt": nrm(ks[0], (BATCH, SEQ, D_MODEL), 1.0),
        "x_sample": nrm(ks[1], (DEC_BATCH, DEC_SEQ, D_MODEL), 1.0),
        "norm_g": 1.0 + nrm(ks[2], (DEPTH, D_MODEL), 0.02),
        "w_in": nrm(ks[3], (DEPTH, D_MODEL, D_IN), D_MODEL ** -0.5),
        "conv_w": nrm(ks[4], (DEPTH, CONV_KERNEL, CONV_WIDTH), CONV_KERNEL ** -0.5),
        "conv_b": nrm(ks[5], (DEPTH, CONV_WIDTH), 0.02),
        "conv_ln_g": 1.0 + nrm(ks[6], (DEPTH, CONV_WIDTH), 0.02),
        "conv_ln_b": nrm(ks[7], (DEPTH, CONV_WIDTH), 0.02),
        "conv_pw": nrm(ks[8], (DEPTH, CONV_WIDTH, CONV_WIDTH), CONV_WIDTH ** -0.5),
        "sgu_ln_g": 1.0 + nrm(ks[9], (DEPTH, SGU_WIDTH), 0.02),
        "sgu_ln_b": nrm(ks[10], (DEPTH, SGU_WIDTH), 0.02),
        "sgu_w": nrm(ks[11], (DEPTH, SGU_HEADS, SGU_CHUNK, SGU_CHUNK), SGU_CHUNK ** -0.5),
        "sgu_b": 1.0 + nrm(ks[12], (DEPTH, SGU_HEADS, SGU_CHUNK), 0.02),
        "hgrn_lb_fwd": nrm(ks[13], (DEPTH, HGRN_WIDTH), 0.5),
        "hgrn_lb_bwd": nrm(ks[14], (DEPTH, HGRN_WIDTH), 0.5),
        "hgrn_norm_g": 1.0 + nrm(ks[15], (DEPTH, HGRN_HEAD_V), 0.02),
        "w_out": nrm(ks[16], (DEPTH, D_MIX, D_MODEL), (2.0 * D_MIX) ** -0.5),
        "final_norm_g": 1.0 + nrm(ks[17], (D_MODEL,), 0.02),
    }


def reference(x_prompt, x_sample, norm_g, w_in, conv_w, conv_b, conv_ln_g, conv_ln_b, conv_pw,
              sgu_ln_g, sgu_ln_b, sgu_w, sgu_b, hgrn_lb_fwd, hgrn_lb_bwd, hgrn_norm_g,
              w_out, final_norm_g):
    y_prompt = trunk(x_prompt, norm_g, w_in, conv_w, conv_b, conv_ln_g, conv_ln_b, conv_pw,
                     sgu_ln_g, sgu_ln_b, sgu_w, sgu_b, hgrn_lb_fwd, hgrn_lb_bwd, hgrn_norm_g,
                     w_out, final_norm_g)
    y_sample = trunk(x_sample, norm_g, w_in, conv_w, conv_b, conv_ln_g, conv_ln_b, conv_pw,
                     sgu_ln_g, sgu_ln_b, sgu_w, sgu_b, hgrn_lb_fwd, hgrn_lb_bwd, hgrn_norm_g,
                     w_out, final_norm_g)
    return (y_prompt, y_sample)
```

```cpp
#include <hip/hip_runtime.h>
#include <hip/hip_cooperative_groups.h>
#include <cstdio>
#include <cstdint>
namespace cg = cooperative_groups;

__device__ __forceinline__ int ltid() { int t = threadIdx.x; asm volatile("" : "+v"(t)); return t; }
namespace pg8 {
#define PG8_LAS __attribute__((address_space(3)))
typedef unsigned short bf16_t;
typedef short bf16x8 __attribute__((ext_vector_type(8)));
typedef float f32x4 __attribute__((ext_vector_type(4)));
typedef unsigned u32x4 __attribute__((ext_vector_type(4)));
constexpr int BM = 256, BK = 64, HALF = 128, HTB = HALF * BK * 2  , STAGE_BYTES = 8 * HTB, NXCD = 8, WGM = 8;

__host__ __device__ __forceinline__ int lds_byte(int r, int c) { const int st = (r >> 4) * 2 + (c >> 5), rr = r & 15, cc = c & 31, ob = rr * 64 + cc * 2; return st * 1024 + (ob ^ (((ob >> 9) & 1) << 5)); }
__host__ __device__ __forceinline__ void stage_rc(int b, int& R, int& C) { const int st = b / 1024, sb = b % 1024, swz = sb ^ (((sb >> 9) & 1) << 5); R = (st >> 1) * 16 + swz / 64; C = (st & 1) * 32 + (swz % 64) / 2; }
__host__ __device__ __forceinline__ int perm32(int rho) { const int n = rho >> 4, i = rho & 15; return 8 * (i >> 2) + 4 * n + (i & 3); }

struct Unit { int pm, pn; };
struct Gemm { const bf16_t* A; const bf16_t* Bt; int M, N, K, lda; };

struct StaticOrder {
    int nM, nN, nwg, G, c;
    __host__ __device__ void init(int M, int N, int G_, int c_) { nM = M / BM; nN = N / BM; nwg = nM * nN; G = G_; c = c_; }
    __host__ __device__ bool next(int i, Unit& u) const {
        const long L = (long)i * G + c; if (L >= nwg) return false;
        int wgid = (int)L; { const int q = nwg / NXCD, r = nwg % NXCD, xcd = wgid % NXCD, off = wgid / NXCD; wgid = (xcd < r ? xcd * (q + 1) : r * (q + 1) + (xcd - r) * q) + off; }
        const int nig = WGM * nN, gid = wgid / nig, fm = gid * WGM, gsz = (nM - fm) < WGM ? (nM - fm) : WGM;
        u.pm = fm + ((wgid % nig) % gsz); u.pn = (wgid % nig) / gsz; return true;
    }
    __device__ __forceinline__ void a_ready(const Unit&) const {}
    __device__ __forceinline__ void done(const Unit&) const {}
};

typedef float f32x2 __attribute__((ext_vector_type(2)));
__device__ __forceinline__ f32x2 gelu_pk(f32x2 v) {
    const f32x2 av = __builtin_elementwise_abs(v), d = av * 0.2316418882f + 1.0f;
    f32x2 t; t.x = __builtin_amdgcn_rcpf(d.x); t.y = __builtin_amdgcn_rcpf(d.y);
    f32x2 q = t * 0.5307027145f + (-0.7265760135f); q = q * t + 0.7107068705f; q = q * t + (-0.142248368f); q = q * t + 0.127414796f; q = q * t;
    const f32x2 s = (v * v) * (-0.72134752044f);
    f32x2 e; e.x = __builtin_amdgcn_exp2f(s.x); e.y = __builtin_amdgcn_exp2f(s.y);
    const f32x2 m = v * (q * e), r = v - m;
    f32x2 o; o.x = v.x < 0.f ? m.x : r.x; o.y = v.y < 0.f ? m.y : r.y; return o;
}

template <class Epi, class Sched, bool ALIGN_EPI = false, bool SP2 = false>
__device__ __forceinline__ void gemm_phase(PG8_LAS unsigned char* lds, const Gemm g, const Sched& S, const Epi& E) {
    const int tid = ltid(), wid = __builtin_amdgcn_readfirstlane(tid >> 6), lane = tid & 63, wr = wid >> 2, wc = wid & 3, fr = lane & 15, fq = lane >> 4;
    const int K = g.K, nt = K / BK;
    unsigned voffA[2], voffB[2];
#pragma unroll
    for (int i = 0; i < 2; ++i) { int R, C; stage_rc(tid * 16 + i * 8192, R, C); const int Rb = Epi::PERM ? ((R & ~31) + perm32(R & 31)) : R;
        voffA[i] = (unsigned)(R * g.lda + C) * 2u; voffB[i] = (unsigned)(Rb * K + C) * 2u; }
    const size_t kstep = (size_t)(BK * 2);
    const size_t hstepB = (size_t)HALF * K * 2, hstepA = (size_t)HALF * g.lda * 2;
    const size_t tstepA = 2 * hstepA, tstepB = 2 * hstepB;
    const unsigned ldsw = (unsigned)wid * 1024u;
    const int aoff = lds_byte(wr * 64 + fr, fq * 8), boff = lds_byte(wc * 32 + fr, fq * 8);
#define PG8_SA(b, h) (((b) * 2 + (h)) * HTB)
#define PG8_SB(b, h) ((4 + (b) * 2 + (h)) * HTB)
#define PG8_STAGE(bufoff, gbase, voff) do { _Pragma("unroll") for (int _i = 0; _i < 2; ++_i) \
        __builtin_amdgcn_global_load_lds((const unsigned*)((const char*)(gbase) + (voff)[_i]), (PG8_LAS unsigned*)(lds + (bufoff) + ldsw + _i * 8192), 16, 0, 0); } while (0)
#define PG8_LDA(dst, b, h) do { _Pragma("unroll") for (int m = 0; m < 4; ++m) _Pragma("unroll") for (int k = 0; k < 2; ++k) dst[m][k] = *(const PG8_LAS bf16x8*)(lds + PG8_SA(b, h) + aoff + m * 2048 + k * 1024); } while (0)
#define PG8_LDB(dst, b, h) do { _Pragma("unroll") for (int n = 0; n < 2; ++n) _Pragma("unroll") for (int k = 0; k < 2; ++k) dst[n][k] = *(const PG8_LAS bf16x8*)(lds + PG8_SB(b, h) + boff + n * 2048 + k * 1024); } while (0)
#define PG8_MMA(ai, bj, At, Bt) do { __builtin_amdgcn_s_setprio(1); _Pragma("unroll") for (int m = 0; m < 4; ++m) _Pragma("unroll") for (int n = 0; n < 2; ++n) _Pragma("unroll") for (int k = 0; k < 2; ++k) \
        acc[ai][bj][m][n] = __builtin_amdgcn_mfma_f32_16x16x32_bf16(Bt[n][k], At[m][k], acc[ai][bj][m][n], 0, 0, 0); __builtin_amdgcn_s_setprio(0); } while (0)
#define PG8_WAIT_V(n) asm volatile("s_waitcnt vmcnt(" #n ")" ::: "memory")
#define PG8_WAIT_L(n) asm volatile("s_waitcnt lgkmcnt(" #n ")" ::: "memory")
#define PG8_BAR __builtin_amdgcn_s_barrier()
#define PG8_SCHED __builtin_amdgcn_sched_barrier(0)
    Unit cur, nxt; int ui = 0;
    if (!S.next(0, cur)) return;
    f32x4 acc[2][2][4][2];
#pragma unroll
    for (int a = 0; a < 2; ++a)
#pragma unroll
        for (int b = 0; b < 2; ++b)
#pragma unroll
            for (int m = 0; m < 4; ++m)
#pragma unroll
                for (int n = 0; n < 2; ++n) acc[a][b][m][n] = (f32x4){0.f, 0.f, 0.f, 0.f};
    bf16x8 At[4][2], B0[2][2], B1[2][2];
    const char* cA = (const char*)g.A + (size_t)cur.pm * tstepA; const char* cB = (const char*)g.Bt + (size_t)cur.pn * tstepB;
    S.a_ready(cur);
    if constexpr (SP2) {
        PG8_STAGE(PG8_SB(0, 0), cB, voffB); PG8_STAGE(PG8_SB(0, 1), cB + hstepB, voffB); PG8_STAGE(PG8_SA(0, 0), cA, voffA); PG8_STAGE(PG8_SA(0, 1), cA + hstepA, voffA);
        if (wr == 1) PG8_BAR;
        PG8_WAIT_V(2); PG8_BAR;
        PG8_STAGE(PG8_SB(1, 0), cB + kstep, voffB); PG8_STAGE(PG8_SA(1, 0), cA + kstep, voffA); PG8_STAGE(PG8_SB(1, 1), cB + hstepB + kstep, voffB);
        PG8_WAIT_V(6); PG8_BAR;
    } else {
        PG8_STAGE(PG8_SB(0, 0), cB, voffB); PG8_STAGE(PG8_SA(0, 0), cA, voffA); PG8_STAGE(PG8_SB(0, 1), cB + hstepB, voffB); PG8_STAGE(PG8_SA(0, 1), cA + hstepA, voffA);
        if (wr == 1) PG8_BAR;
        PG8_WAIT_V(4); PG8_BAR;
        PG8_STAGE(PG8_SB(1, 0), cB + kstep, voffB); PG8_STAGE(PG8_SA(1, 0), cA + kstep, voffA); PG8_STAGE(PG8_SB(1, 1), cB + hstepB + kstep, voffB);
        PG8_WAIT_V(6); PG8_BAR;
    }
    for (;;) {
        const bool has_next = S.next(ui + 1, nxt);
        const char* nA = has_next ? (const char*)g.A + (size_t)nxt.pm * tstepA : cA; const char* nB = has_next ? (const char*)g.Bt + (size_t)nxt.pn * tstepB : cB;
        for (int t = 0; t < nt; t += 2) {
            const bool last = (t == nt - 2);
            const char* a1 = cA + (size_t)(t + 1) * kstep;
            const char* a2 = last ? nA : cA + (size_t)(t + 2) * kstep; const char* b2 = last ? nB : cB + (size_t)(t + 2) * kstep;
            const char* a3 = a2 + kstep; const char* b3 = b2 + kstep;
            if (last && has_next) S.a_ready(nxt);
            if constexpr (SP2) {
            PG8_LDB(B0, 0, 0); PG8_LDB(B1, 0, 1); PG8_SCHED; PG8_LDA(At, 0, 0); PG8_STAGE(PG8_SA(1, 1), a1 + hstepA, voffA);
            PG8_WAIT_V(8); PG8_WAIT_L(0); PG8_BAR; PG8_MMA(0, 0, At, B0); PG8_MMA(0, 1, At, B1); PG8_BAR; PG8_SCHED;
            PG8_LDA(At, 0, 1); PG8_STAGE(PG8_SB(0, 0), b2, voffB); PG8_STAGE(PG8_SB(0, 1), b2 + hstepB, voffB); PG8_STAGE(PG8_SA(0, 0), a2, voffA);
            PG8_WAIT_V(8); PG8_WAIT_L(0); PG8_BAR; PG8_MMA(1, 0, At, B0); PG8_MMA(1, 1, At, B1); PG8_BAR; PG8_SCHED;
            PG8_LDB(B0, 1, 0); PG8_LDB(B1, 1, 1); PG8_SCHED; PG8_LDA(At, 1, 0); PG8_STAGE(PG8_SA(0, 1), a2 + hstepA, voffA);
            PG8_WAIT_V(8); PG8_WAIT_L(0); PG8_BAR; PG8_MMA(0, 0, At, B0); PG8_MMA(0, 1, At, B1); PG8_BAR; PG8_SCHED;
            PG8_LDA(At, 1, 1); PG8_STAGE(PG8_SB(1, 0), b3, voffB); PG8_STAGE(PG8_SB(1, 1), b3 + hstepB, voffB); PG8_STAGE(PG8_SA(1, 0), a3, voffA);
            PG8_WAIT_V(8); PG8_WAIT_L(0); PG8_BAR; PG8_MMA(1, 0, At, B0); PG8_MMA(1, 1, At, B1); PG8_BAR; PG8_SCHED;
            } else {
            PG8_LDB(B0, 0, 0); PG8_SCHED; PG8_LDA(At, 0, 0); PG8_STAGE(PG8_SA(1, 1), a1 + hstepA, voffA);
            PG8_WAIT_L(8); PG8_BAR; PG8_WAIT_L(0); PG8_MMA(0, 0, At, B0); PG8_BAR; PG8_SCHED;
            PG8_LDB(B1, 0, 1); PG8_STAGE(PG8_SB(0, 0), b2, voffB);
            PG8_BAR; PG8_WAIT_L(0); PG8_MMA(0, 1, At, B1); PG8_BAR;
            PG8_LDA(At, 0, 1); PG8_STAGE(PG8_SA(0, 0), a2, voffA);
            PG8_BAR; PG8_WAIT_L(0); PG8_MMA(1, 0, At, B0); PG8_BAR; PG8_SCHED;
            PG8_STAGE(PG8_SB(0, 1), b2 + hstepB, voffB);
            PG8_WAIT_V(6); PG8_BAR; PG8_MMA(1, 1, At, B1); PG8_BAR;
            PG8_LDB(B0, 1, 0); PG8_SCHED; PG8_LDA(At, 1, 0); PG8_STAGE(PG8_SA(0, 1), a2 + hstepA, voffA);
            PG8_WAIT_L(8); PG8_BAR; PG8_WAIT_L(0); PG8_MMA(0, 0, At, B0); PG8_BAR; PG8_SCHED;
            PG8_LDB(B1, 1, 1); PG8_STAGE(PG8_SB(1, 0), b3, voffB);
            PG8_BAR; PG8_WAIT_L(0); PG8_MMA(0, 1, At, B1); PG8_BAR;
            PG8_LDA(At, 1, 1); PG8_STAGE(PG8_SA(1, 0), a3, voffA);
            PG8_BAR; PG8_WAIT_L(0); PG8_MMA(1, 0, At, B0); PG8_BAR; PG8_SCHED;
            PG8_STAGE(PG8_SB(1, 1), b3 + hstepB, voffB);
            PG8_WAIT_V(6); PG8_BAR; PG8_MMA(1, 1, At, B1); PG8_BAR;
            }
        }
        if constexpr (ALIGN_EPI) { if (wr == 0) PG8_BAR; }
        if constexpr (!Epi::AFTER_DRAIN) { E(acc, cur, wr, wc, fr, fq); S.done(cur); }
        if (!has_next) break;
#pragma unroll
        for (int a = 0; a < 2; ++a)
#pragma unroll
            for (int b = 0; b < 2; ++b)
#pragma unroll
                for (int m = 0; m < 4; ++m)
#pragma unroll
                    for (int n = 0; n < 2; ++n) acc[a][b][m][n] = (f32x4){0.f, 0.f, 0.f, 0.f};
        cur = nxt; cA = nA; cB = nB; ++ui;
        if constexpr (ALIGN_EPI) { if (wr == 1) PG8_BAR; }
    }
    PG8_WAIT_V(0);
    if constexpr (!ALIGN_EPI) { if (wr == 0) PG8_BAR; }
    PG8_BAR;
    if constexpr (Epi::AFTER_DRAIN) { E.fused(acc, cur, wr, wc, fr, fq, lds, wid, lane); S.done(cur); }
#undef PG8_SA
#undef PG8_SB
#undef PG8_STAGE
#undef PG8_LDA
#undef PG8_LDB
#undef PG8_MMA
#undef PG8_WAIT_V
#undef PG8_WAIT_L
#undef PG8_BAR
#undef PG8_SCHED
}
}

#ifndef ONE_LAUNCH
#define ONE_LAUNCH 0
#endif
#define LAS __attribute__((address_space(3)))
typedef unsigned short bf16;
typedef unsigned u32x4 __attribute__((ext_vector_type(4)));
typedef unsigned u32x2 __attribute__((ext_vector_type(2)));
typedef float f32x4 __attribute__((ext_vector_type(4)));
typedef float f32x2 __attribute__((ext_vector_type(2)));
typedef short bf16x8 __attribute__((ext_vector_type(8)));
typedef __bf16 bf16x2_t __attribute__((ext_vector_type(2)));
typedef LAS unsigned char* ldsp;

constexpr int M = 49152, M0 = 32768, D = 1024, NP = 3840, DIN = 4096;
constexpr float EPS = 1e-6f;
constexpr int PC_YA = 0, PC_YB = 256, PC_YC = 512, PC_GLU = 1024, PC_BU = 1280, PC_BV = 1536, PC_Q = 1792, PC_V = 2304, PC_ZF = 2816, PC_ZB = 3328;
constexpr size_t MiB = 1u << 20;
constexpr size_t WS_PART = 0, WS_LOGD = 3 * MiB, WS_BT1 = 4 * MiB, WS_BT2 = 20 * MiB, WS_PWT = 24 * MiB, WS_SGW = 24 * MiB + 256 * 1024;
constexpr size_t WS_XB = 26 * MiB, WS_ST = WS_XB, WS_P = 122 * MiB, WS_END = 482 * MiB;
constexpr int LDS_BYTES = 147456;
constexpr int NPH = 12;

struct Params {
    const float *xp, *xs, *norm_g, *w_in, *conv_w, *conv_b, *conv_ln_g, *conv_ln_b, *conv_pw, *sgu_ln_g, *sgu_ln_b, *sgu_w, *sgu_b, *lb_f, *lb_b, *hgrn_g, *w_out, *final_g;
    float* out; unsigned char* ws; int ph_lo, ph_hi;
};

__device__ __forceinline__ float bf2f(bf16 b) { return __uint_as_float((unsigned)b << 16); }
__device__ __forceinline__ float bflo(unsigned w) { return __uint_as_float(w << 16); }
__device__ __forceinline__ float bfhi(unsigned w) { return __uint_as_float(w & 0xffff0000u); }
__device__ __forceinline__ unsigned pk2(float lo, float hi) { f32x2 v = {lo, hi}; bf16x2_t b = __builtin_convertvector(v, bf16x2_t); return __builtin_bit_cast(unsigned, b); }
__device__ __forceinline__ bf16 f2bf(float x) { return (bf16)(pk2(x, 0.f) & 0xffffu); }
__device__ __forceinline__ float sigmoidf_(float x) { return __builtin_amdgcn_rcpf(1.f + __expf(-x)); }
__device__ __forceinline__ float siluf_(float x) { return x * sigmoidf_(x); }
__device__ __forceinline__ float wave_sum(float v) {
#pragma unroll
    for (int o = 1; o < 64; o <<= 1) v += __shfl_xor(v, o);
    return v;
}
__device__ __forceinline__ bf16x8 mk8(unsigned a, unsigned b, unsigned c, unsigned d) { u32x4 v = {a, b, c, d}; return __builtin_bit_cast(bf16x8, v); }
#define MFMA16(a, b, c) __builtin_amdgcn_mfma_f32_16x16x32_bf16((a), (b), (c), 0, 0, 0)

struct Epi1 {
    static constexpr bool PERM = true, AFTER_DRAIN = false;
    bf16* P; const float* part;
    __device__ __forceinline__ void operator()(const pg8::f32x4 (&acc)[2][2][4][2], const pg8::Unit& u, int wr, int wc, int fr, int fq) const {
        const int row0 = u.pm * 256 + wr * 64 + fr; const int pn = u.pn;
        const int cw = wc * 32 + 8 * fq;
#pragma unroll
        for (int ai = 0; ai < 2; ++ai)
#pragma unroll
            for (int m = 0; m < 4; ++m) {
                const int r = row0 + ai * 128 + m * 16;
                float s = 0.f;
#pragma unroll
                for (int q = 0; q < 16; ++q) s += part[(size_t)q * M + r];
                const float rs = __builtin_amdgcn_rsqf(s * (1.f / D) + EPS);
                bf16* rowp = P + (size_t)r * NP;
                if (pn < 2) {
                    f32x4 a0 = acc[ai][0][m][0] * rs, a1 = acc[ai][0][m][1] * rs, g0 = acc[ai][1][m][0] * rs, g1 = acc[ai][1][m][1] * rs;
                    u32x4 w;
                    w.x = pk2(a0[0] * sigmoidf_(g0[0]), a0[1] * sigmoidf_(g0[1])); w.y = pk2(a0[2] * sigmoidf_(g0[2]), a0[3] * sigmoidf_(g0[3]));
                    w.z = pk2(a1[0] * sigmoidf_(g1[0]), a1[1] * sigmoidf_(g1[1])); w.w = pk2(a1[2] * sigmoidf_(g1[2]), a1[3] * sigmoidf_(g1[3]));
                    *(u32x4*)(rowp + PC_GLU + 128 * pn + cw) = w;
                } else {
                    const int obase = pn < 6 ? 256 * (pn - 2) : (pn < 8 ? 1280 + 256 * (pn - 6) : 1792 + 256 * (pn - 8));
#pragma unroll
                    for (int bj = 0; bj < 2; ++bj) {
                        f32x4 v0 = acc[ai][bj][m][0] * rs, v1 = acc[ai][bj][m][1] * rs;
                        if (pn < 6) {
#pragma unroll
                            for (int e = 0; e < 4; ++e) { v0[e] = siluf_(v0[e]); v1[e] = siluf_(v1[e]); }
                        } else if (pn < 8) {
                            f32x2 a = pg8::gelu_pk((f32x2){v0[0], v0[1]}), b = pg8::gelu_pk((f32x2){v0[2], v0[3]}), c = pg8::gelu_pk((f32x2){v1[0], v1[1]}), d = pg8::gelu_pk((f32x2){v1[2], v1[3]});
                            v0 = (f32x4){a.x, a.y, b.x, b.y}; v1 = (f32x4){c.x, c.y, d.x, d.y};
                        }
                        u32x4 w; w.x = pk2(v0[0], v0[1]); w.y = pk2(v0[2], v0[3]); w.z = pk2(v1[0], v1[1]); w.w = pk2(v1[2], v1[3]);
                        *(u32x4*)(rowp + obase + 128 * bj + cw) = w;
                    }
                }
            }
    }
};
struct Epi2 {
    static constexpr bool PERM = true, AFTER_DRAIN = false;
    const float* xin0; const float* xin1; int split; float* xout; bf16* XB; float* part;
    __device__ __forceinline__ void operator()(const pg8::f32x4 (&acc)[2][2][4][2], const pg8::Unit& u, int wr, int wc, int fr, int fq) const {
        const int row0 = u.pm * 256 + wr * 64 + fr; const int pn = u.pn;
        const int cw = pn * 256 + wc * 32 + 8 * fq;
#pragma unroll
        for (int ai = 0; ai < 2; ++ai)
#pragma unroll
            for (int m = 0; m < 4; ++m) {
                const int r = row0 + ai * 128 + m * 16;
                const float* src = (r < split) ? xin0 + (size_t)r * D : xin1 + (size_t)(r - split) * D;
                float ss = 0.f;
#pragma unroll
                for (int bj = 0; bj < 2; ++bj) {
                    const int col = cw + 128 * bj;
                    f32x4 v0 = *(const f32x4*)(src + col) + acc[ai][bj][m][0], v1 = *(const f32x4*)(src + col + 4) + acc[ai][bj][m][1];
                    *(f32x4*)(xout + (size_t)r * D + col) = v0; *(f32x4*)(xout + (size_t)r * D + col + 4) = v1;
                    ss += (v0[0] * v0[0] + v0[1] * v0[1]) + (v0[2] * v0[2] + v0[3] * v0[3]) + (v1[0] * v1[0] + v1[1] * v1[1]) + (v1[2] * v1[2] + v1[3] * v1[3]);
                    if (XB) { u32x4 w; w.x = pk2(v0[0], v0[1]); w.y = pk2(v0[2], v0[3]); w.z = pk2(v1[0], v1[1]); w.w = pk2(v1[2], v1[3]); *(u32x4*)(XB + (size_t)r * D + col) = w; }
                }
                ss += __shfl_xor(ss, 16); ss += __shfl_xor(ss, 32);
                if (fq == 0) part[(size_t)(pn * 4 + wc) * M + r] = ss;
            }
    }
};

__device__ __forceinline__ int srcmap128(int b) {
    if (b < 4) return ((b & 1) ? 256 : 0) + 128 * (b >> 1);
    if (b < 6) return 512 + 128 * (b - 4);
    if (b < 8) return 1280 + 128 * (b - 6);
    if (b < 12) return 3584 + 128 * (b - 8);
    if (b < 14) return 768 + 128 * (b - 12);
    if (b < 16) return 1024 + 128 * (b - 14);
    if (b < 20) return 1536 + 128 * (b - 16);
    if (b < 24) return 2048 + 128 * (b - 20);
    if (b < 28) return 2560 + 128 * (b - 24);
    return 3072 + 128 * (b - 28);
}
__device__ __forceinline__ void tr_item(const float* W, int N, int sc0, const float* gk, int k0, bf16* WT, int K, int drow0, LAS float* scr, int lane) {
#pragma unroll 8
    for (int i = 0; i < 32; ++i) { const int kk = 2 * i + (lane >> 5); float v = W[(size_t)(k0 + kk) * N + sc0 + (lane & 31)]; if (gk) v *= gk[k0 + kk]; scr[kk * 33 + (lane & 31)] = v; }
    asm volatile("s_waitcnt lgkmcnt(0)" ::: "memory");
    const int c = lane & 7;
#pragma unroll
    for (int j = 0; j < 4; ++j) { const int n = (lane >> 3) + 8 * j; const LAS float* s = scr + (8 * c) * 33 + n;
        u32x4 o; o.x = pk2(s[0 * 33], s[1 * 33]); o.y = pk2(s[2 * 33], s[3 * 33]); o.z = pk2(s[4 * 33], s[5 * 33]); o.w = pk2(s[6 * 33], s[7 * 33]);
        *(u32x4*)(WT + (size_t)(drow0 + n) * K + k0 + 8 * c) = o; }
    asm volatile("s_waitcnt lgkmcnt(0)" ::: "memory");
}
__device__ __forceinline__ void prologue(ldsp lds, const Params& p) {
    const int tid = ltid(), lane = tid & 63, wave = __builtin_amdgcn_readfirstlane(tid >> 6);
    const int gw = blockIdx.x * 8 + wave, NGW = gridDim.x * 8;
    LAS float* scr = (LAS float*)(lds + wave * 16384);
    unsigned char* ws = p.ws;
    constexpr int I_IN = 16 * 128, I_OUT = 16 * 32, I_PW = 4 * 8, I_L = I_IN + I_OUT + I_PW;
    for (int it = gw; it < 2 * I_L; it += NGW) {
        const int l = it / I_L; int r = it - l * I_L;
        if (r < I_IN) { const int kb = r >> 7, nb = r & 127; tr_item(p.w_in + (size_t)l * D * DIN, DIN, srcmap128(nb >> 2) + 32 * (nb & 3), p.norm_g + l * D, 64 * kb, (bf16*)(ws + WS_BT1) + (size_t)l * DIN * D, D, 32 * nb, scr, lane); continue; }
        r -= I_IN;
        if (r < I_OUT) { const int kb = r >> 5, nb = r & 31; tr_item(p.w_out + (size_t)l * D * D, D, 32 * nb, nullptr, 64 * kb, (bf16*)(ws + WS_BT2) + (size_t)l * D * D, D, 32 * nb, scr, lane); continue; }
        r -= I_OUT;
        { const int kb = r >> 3, nb = r & 7; tr_item(p.conv_pw + (size_t)l * 65536, 256, 32 * nb, nullptr, 64 * kb, (bf16*)(ws + WS_PWT) + (size_t)l * 65536, 256, 32 * nb, scr, lane); }
    }
    { const int gt = blockIdx.x * 512 + tid, NT = gridDim.x * 512; bf16* o = (bf16*)(ws + WS_SGW);
      for (int i = gt; i < 2 * 4 * 128 * 128 / 4; i += NT) { const f32x4 v = *(const f32x4*)(p.sgu_w + 4 * (size_t)i); u32x2 w; w.x = pk2(v[0], v[1]); w.y = pk2(v[2], v[3]); *(u32x2*)(o + 4 * (size_t)i) = w; } }
    bf16* XB = (bf16*)(ws + WS_XB); float* part = (float*)(ws + WS_PART);
    for (int r = gw; r < M; r += NGW) {
        const float* src = (r < M0) ? p.xp + (size_t)r * D : p.xs + (size_t)(r - M0) * D;
        const f32x4* xr = (const f32x4*)src + lane; float s = 0.f;
        unsigned long long* o8 = (unsigned long long*)(XB + (size_t)r * D) + lane;
#pragma unroll
        for (int j = 0; j < 4; ++j) { const f32x4 v = xr[64 * j]; s += (v[0] * v[0] + v[1] * v[1]) + (v[2] * v[2] + v[3] * v[3]); o8[64 * j] = (unsigned long long)pk2(v[0], v[1]) | ((unsigned long long)pk2(v[2], v[3]) << 32); }
        s = wave_sum(s);
        if (lane < 16) part[(size_t)lane * M + r] = lane == 0 ? s : 0.f;
    }
}

__device__ __forceinline__ void final_norm(const Params& p) {
    const int tid = ltid(), lane = tid & 63, wave = tid >> 6;
    const int gw = blockIdx.x * 8 + wave, NGW = gridDim.x * 8;
    const float* part = (const float*)(p.ws + WS_PART);
    f32x4 g[4];
#pragma unroll
    for (int j = 0; j < 4; ++j) g[j] = *((const f32x4*)p.final_g + lane + 64 * j);
    for (int r = gw; r < M; r += NGW) {
        float s = lane < 16 ? part[(size_t)lane * M + r] : 0.f; s = wave_sum(s);
        const float rs = __builtin_amdgcn_rsqf(s * (1.f / D) + EPS);
        f32x4* xr = (f32x4*)(p.out + (size_t)r * D) + lane;
#pragma unroll
        for (int j = 0; j < 4; ++j) { f32x4 v = xr[64 * j]; v = v * rs * g[j]; xr[64 * j] = v; }
    }
}

__device__ __forceinline__ void conv_item(ldsp lds, int item, int layer, const Params& p, bf16* P) {
    const int tid = ltid(), lane = tid & 63, w = __builtin_amdgcn_readfirstlane(tid >> 6), r16 = lane & 15, quad = lane >> 4;
    const int r0 = item * 64;
    int s0, s1; if (r0 < M0) { s0 = r0 & ~8191; s1 = s0 + 8192; } else { s0 = M0 + ((r0 - M0) & ~4095); s1 = s0 + 4096; }
    const float* cw = p.conv_w + layer * 31 * 256; const float* cb = p.conv_b + layer * 256;
    const float* lg = p.conv_ln_g + layer * 256; const float* lbeta = p.conv_ln_b + layer * 256;
    const bf16* pwT = (const bf16*)(p.ws + WS_PWT) + (size_t)layer * 65536;
    ldsp IN = lds;
    LAS float* CV = (LAS float*)(lds + 49152);
    ldsp AO = lds;
    for (int idx = tid; idx < 94 * 32; idx += 512) { const int row = idx >> 5, c16 = idx & 31, gr = r0 - 15 + row;
        u32x4 v = {0u, 0u, 0u, 0u}; if (gr >= s0 && gr < s1) v = *(const u32x4*)(P + (size_t)gr * NP + PC_GLU + c16 * 8);
        *(LAS u32x4*)(IN + row * 512 + c16 * 16) = v; }
    __syncthreads();
    {
        const int c = tid & 255, half = tid >> 8;
        float w0[31];
#pragma unroll
        for (int j = 0; j < 31; ++j) w0[j] = cw[j * 256 + c];
        const float bb = cb[c];
        float a0[32];
#pragma unroll
        for (int o = 0; o < 32; ++o) a0[o] = bb;
#pragma unroll
        for (int i = 0; i < 62; ++i) {
            const float x0 = bf2f(*(LAS bf16*)(IN + (32 * half + i) * 512 + c * 2));
#pragma unroll
            for (int o = 0; o < 32; ++o) { if (i - o >= 0 && i - o <= 30) a0[o] += x0 * w0[i - o]; }
        }
#pragma unroll
        for (int o = 0; o < 32; ++o) CV[(32 * half + o) * 264 + c] = a0[o];
    }
    __syncthreads();
    {
        const int tok = tid >> 3, part = tid & 7;
        f32x4 v[8]; float s = 0.f;
#pragma unroll
        for (int i = 0; i < 8; ++i) { v[i] = *(LAS f32x4*)(CV + tok * 264 + 32 * i + 4 * part); s += (v[i][0] + v[i][1]) + (v[i][2] + v[i][3]); }
        s += __shfl_xor(s, 1); s += __shfl_xor(s, 2); s += __shfl_xor(s, 4);
        const float mean = s * (1.f / 256.f); float q = 0.f;
#pragma unroll
        for (int i = 0; i < 8; ++i) { v[i] = v[i] - mean; q += (v[i][0] * v[i][0] + v[i][1] * v[i][1]) + (v[i][2] * v[i][2] + v[i][3] * v[i][3]); }
        q += __shfl_xor(q, 1); q += __shfl_xor(q, 2); q += __shfl_xor(q, 4);
        const float rstd = __builtin_amdgcn_rsqf(q * (1.f / 256.f) + EPS);
#pragma unroll
        for (int i = 0; i < 8; ++i) { const int c = 32 * i + 4 * part; const f32x4 gg = *(const f32x4*)(lg + c), bb = *(const f32x4*)(lbeta + c);
            f32x4 y = v[i] * rstd * gg + bb;
            u32x2 o; o.x = pk2(siluf_(y[0]), siluf_(y[1])); o.y = pk2(siluf_(y[2]), siluf_(y[3]));
            *(LAS u32x2*)(AO + tok * 528 + c * 2) = o; }
    }
    __syncthreads();
    {
        f32x4 acc[4][2];
#pragma unroll
        for (int m = 0; m < 4; ++m) { acc[m][0] = (f32x4){0.f, 0.f, 0.f, 0.f}; acc[m][1] = (f32x4){0.f, 0.f, 0.f, 0.f}; }
#pragma unroll
        for (int kk = 0; kk < 8; ++kk) {
            const bf16x8 b0 = *(const bf16x8*)(pwT + (size_t)(32 * w + r16) * 256 + 32 * kk + 8 * quad), b1 = *(const bf16x8*)(pwT + (size_t)(32 * w + 16 + r16) * 256 + 32 * kk + 8 * quad);
#pragma unroll
            for (int m = 0; m < 4; ++m) { const bf16x8 a = *(LAS bf16x8*)(AO + (16 * m + r16) * 528 + (32 * kk + 8 * quad) * 2);
                acc[m][0] = MFMA16(b0, a, acc[m][0]); acc[m][1] = MFMA16(b1, a, acc[m][1]); }
        }
#pragma unroll
        for (int m = 0; m < 4; ++m)
#pragma unroll
            for (int nt = 0; nt < 2; ++nt) { bf16* gp = P + (size_t)(r0 + 16 * m + r16) * NP + PC_YA + 32 * w + 16 * nt + 4 * quad;
                const u32x2 g = *(const u32x2*)gp; u32x2 o; o.x = pk2(acc[m][nt][0] * bflo(g.x), acc[m][nt][1] * bfhi(g.x)); o.y = pk2(acc[m][nt][2] * bflo(g.y), acc[m][nt][3] * bfhi(g.y));
                *(u32x2*)gp = o; }
    }
    __syncthreads();
}

__device__ __forceinline__ void sgu_item(ldsp lds, int item, int layer, const Params& p, bf16* P) {
    const int tid = ltid(), lane = tid & 63, w = __builtin_amdgcn_readfirstlane(tid >> 6), r16 = lane & 15, quad = lane >> 4;
    const int r0 = item * 128;
    const float* lg = p.sgu_ln_g + layer * 256; const float* lbeta = p.sgu_ln_b + layer * 256;
    const bf16* SW = (const bf16*)(p.ws + WS_SGW) + (size_t)layer * 65536; const float* sb = p.sgu_b + layer * 512;
    ldsp VT = lds;
    {
        const int tok = tid >> 2, part = tid & 3;
        const bf16* src = P + (size_t)(r0 + tok) * NP + PC_BV;
        float v[64]; float s = 0.f;
#pragma unroll
        for (int i = 0; i < 8; ++i) { const u32x4 t = *(const u32x4*)(src + 32 * i + 8 * part);
            v[8 * i + 0] = bflo(t.x); v[8 * i + 1] = bfhi(t.x); v[8 * i + 2] = bflo(t.y); v[8 * i + 3] = bfhi(t.y); v[8 * i + 4] = bflo(t.z); v[8 * i + 5] = bfhi(t.z); v[8 * i + 6] = bflo(t.w); v[8 * i + 7] = bfhi(t.w); }
#pragma unroll
        for (int i = 0; i < 64; ++i) s += v[i];
        s += __shfl_xor(s, 1); s += __shfl_xor(s, 2);
        const float mean = s * (1.f / 256.f); float q = 0.f;
#pragma unroll
        for (int i = 0; i < 64; ++i) { v[i] -= mean; q += v[i] * v[i]; }
        q += __shfl_xor(q, 1); q += __shfl_xor(q, 2);
        const float rstd = __builtin_amdgcn_rsqf(q * (1.f / 256.f) + EPS);
        const bool odd = tok & 1;
#pragma unroll
        for (int i = 0; i < 8; ++i) {
            const int cb = 32 * i + 8 * part;
#pragma unroll
            for (int e = 0; e < 8; e += 2) {
                const f32x2 gg = *(const f32x2*)(lg + cb + e), bb = *(const f32x2*)(lbeta + cb + e);
                const unsigned own = pk2(v[8 * i + e] * rstd * gg.x + bb.x, v[8 * i + e + 1] * rstd * gg.y + bb.y);
                const unsigned oth = (unsigned)__shfl_xor((int)own, 4);
                const unsigned val = odd ? ((oth >> 16) | (own & 0xffff0000u)) : ((own & 0xffffu) | (oth << 16));
                const int ch = cb + e + (odd ? 1 : 0), t0 = tok & ~1;
                *(LAS unsigned*)(VT + ch * 272 + t0 * 2) = val;
            }
        }
    }
    __syncthreads();
    {
        const int h = w >> 1, th = w & 1;
        bf16x8 vf[4][4];
#pragma unroll
        for (int dt = 0; dt < 4; ++dt)
#pragma unroll
            for (int kk = 0; kk < 4; ++kk) vf[dt][kk] = *(LAS bf16x8*)(VT + (h * 64 + 16 * dt + r16) * 272 + (32 * kk + 8 * quad) * 2);
#pragma unroll 1
        for (int tti = 0; tti < 4; ++tti) {
            const int tt = 4 * th + tti;
            bf16x8 wf[4];
#pragma unroll
            for (int kk = 0; kk < 4; ++kk) wf[kk] = *(const bf16x8*)(SW + (size_t)(h * 128 + 16 * tt + r16) * 128 + 32 * kk + 8 * quad);
            f32x4 acc[4];
#pragma unroll
            for (int dt = 0; dt < 4; ++dt) { acc[dt] = (f32x4){0.f, 0.f, 0.f, 0.f};
#pragma unroll
                for (int kk = 0; kk < 4; ++kk) acc[dt] = MFMA16(vf[dt][kk], wf[kk], acc[dt]); }
            const float bias = sb[h * 128 + 16 * tt + r16];
            bf16* rowp = P + (size_t)(r0 + 16 * tt + r16) * NP;
#pragma unroll
            for (int dt = 0; dt < 4; ++dt) { const int ch = h * 64 + 16 * dt + 4 * quad;
                const u32x2 uu = *(const u32x2*)(rowp + PC_BU + ch), g = *(const u32x2*)(rowp + PC_YB + ch); u32x2 o;
                o.x = pk2(bflo(uu.x) * (acc[dt][0] + bias) * bflo(g.x), bfhi(uu.x) * (acc[dt][1] + bias) * bfhi(g.x));
                o.y = pk2(bflo(uu.y) * (acc[dt][2] + bias) * bflo(g.y), bfhi(uu.y) * (acc[dt][3] + bias) * bfhi(g.y));
                *(u32x2*)(rowp + PC_YB + ch) = o; }
        }
    }
    __syncthreads();
}

constexpr int H_QD = 0, H_KD = 17408, H_KO = 34816, H_Q3 = 52224, H_K0 = 56576, H_KST = 60928, H_VT = 79360, H_SC = 97792, H_TT = 107008, H_ER = 109056, H_DEC = 111104, H_OS = 111616;

__device__ __forceinline__ void score_tile(ldsp lds, int qoff, int koff, int ti, int sj, bool diag, int r16, int quad) {
    f32x4 acc = {0.f, 0.f, 0.f, 0.f};
#pragma unroll
    for (int kk = 0; kk < 4; ++kk) { const bf16x8 a = *(LAS bf16x8*)(lds + koff + r16 * 272 + (32 * kk + 8 * quad) * 2), b = *(LAS bf16x8*)(lds + qoff + r16 * 272 + (32 * kk + 8 * quad) * 2); acc = MFMA16(a, b, acc); }
    if (diag) {
#pragma unroll
        for (int e = 0; e < 4; ++e) if (4 * quad + e > r16) acc[e] = 0.f;
    }
    u32x2 o; o.x = pk2(acc[0], acc[1]); o.y = pk2(acc[2], acc[3]);
    *(LAS u32x2*)(lds + H_SC + (16 * ti + r16) * 144 + (16 * sj + 4 * quad) * 2) = o;
}

__device__ __forceinline__ void gate_math(float z, int layer, float lbv, float l1m, float& logf_, float& logk_) {
    z = fminf(fmaxf(z, -30.f), 30.f);
    const float e = __expf(-z), l = __logf(1.f + e);
    float lf = -l, lk = -z - l;
    if (layer) { lf += __logf(1.f + lbv * e); lk += l1m; }
    logf_ = lf; logk_ = lk;
}

__device__ __forceinline__ void hgrn_passA_item(ldsp lds, int item, int layer, const Params& p, const bf16* P) {
    const int tid = ltid(), lane = tid & 63, w = __builtin_amdgcn_readfirstlane(tid >> 6), r16 = lane & 15, quad = lane >> 4;
    const int dir = item & 1, h = (item >> 1) & 3, sg = item >> 3; const int slot = item;
    const int k = tid & 127, j = tid >> 7;
    float lbv = 0.f, l1m = 0.f;
    if (layer) { const float df = p.lb_f[512 + h * 128 + k] - p.lb_f[h * 128 + k], db = p.lb_b[512 + h * 128 + k] - p.lb_b[h * 128 + k]; const float d = dir ? db : df; lbv = sigmoidf_(d); l1m = -__logf(1.f + __expf(d)); }
    f32x4 S[8];
#pragma unroll
    for (int m = 0; m < 8; ++m) S[m] = (f32x4){0.f, 0.f, 0.f, 0.f};
    float logD = 0.f;
    const unsigned char* Pb = (const unsigned char*)P; const unsigned colz = ((dir ? PC_ZB : PC_ZF) + h * 128 + k) * 2u, colv = (PC_V + h * 128 + k) * 2u;
#pragma unroll 1
    for (int cc = 0; cc < 8; ++cc) {
        const int c0 = sg * 512 + (dir ? (7 - cc) : cc) * 64;
        float cs[16], lk[16]; unsigned vtp[8]; float c = 0.f;
        bf16 zr[16], vr[16];
#pragma unroll
        for (int i = 0; i < 16; ++i) { const int tau = 16 * j + i; const unsigned off = (unsigned)(dir ? c0 + 63 - tau : c0 + tau) * (unsigned)(NP * 2); zr[i] = *(const bf16*)(Pb + (off + colz)); vr[i] = *(const bf16*)(Pb + (off + colv)); }
#pragma unroll
        for (int i = 0; i < 16; ++i) { float lf; gate_math(bf2f(zr[i]), layer, lbv, l1m, lf, lk[i]); c += lf; cs[i] = c; }
#pragma unroll
        for (int i = 0; i < 8; ++i) vtp[i] = (unsigned)vr[2 * i] | ((unsigned)vr[2 * i + 1] << 16);
        *(LAS u32x4*)(lds + H_VT + k * 144 + 32 * j) = (u32x4){vtp[0], vtp[1], vtp[2], vtp[3]};
        *(LAS u32x4*)(lds + H_VT + k * 144 + 32 * j + 16) = (u32x4){vtp[4], vtp[5], vtp[6], vtp[7]};
        *(LAS float*)(lds + H_TT + (j * 128 + k) * 4) = c;
        __syncthreads();
        const float T0 = *(LAS float*)(lds + H_TT + k * 4), T1 = *(LAS float*)(lds + H_TT + (128 + k) * 4), T2 = *(LAS float*)(lds + H_TT + (256 + k) * 4), T3 = *(LAS float*)(lds + H_TT + (384 + k) * 4);
        const float bl = (T0 + T1) + (T2 + T3);
        const float rj1 = (j == 0 ? T0 : j == 1 ? T0 + T1 : j == 2 ? T0 + T1 + T2 : bl);
        const float tail = c + (bl - rj1);
        unsigned kp[8];
#pragma unroll
        for (int i = 0; i < 8; ++i) kp[i] = pk2(__expf(lk[2 * i] + (tail - cs[2 * i])), __expf(lk[2 * i + 1] + (tail - cs[2 * i + 1])));
        *(LAS u32x4*)(lds + H_KST + k * 144 + 32 * j) = (u32x4){kp[0], kp[1], kp[2], kp[3]};
        *(LAS u32x4*)(lds + H_KST + k * 144 + 32 * j + 16) = (u32x4){kp[4], kp[5], kp[6], kp[7]};
        if (j == 0) { *(LAS float*)(lds + H_DEC + k * 4) = __expf(bl); logD += bl; }
        __syncthreads();
        bf16x8 vf[2];
#pragma unroll
        for (int kk = 0; kk < 2; ++kk) vf[kk] = *(LAS bf16x8*)(lds + H_VT + (16 * w + r16) * 144 + (32 * kk + 8 * quad) * 2);
#pragma unroll
        for (int m = 0; m < 8; ++m) { const f32x4 d = *(LAS f32x4*)(lds + H_DEC + (16 * m + 4 * quad) * 4); S[m] = S[m] * d;
#pragma unroll
            for (int kk = 0; kk < 2; ++kk) { const bf16x8 a = *(LAS bf16x8*)(lds + H_KST + (16 * m + r16) * 144 + (32 * kk + 8 * quad) * 2); S[m] = MFMA16(a, vf[kk], S[m]); } }
        __syncthreads();
    }
    float* sp = (float*)(p.ws + WS_ST) + (size_t)slot * 16384;
#pragma unroll
    for (int m = 0; m < 8; ++m)
#pragma unroll
        for (int e = 0; e < 4; ++e) sp[(16 * m + 4 * quad + e) * 128 + 16 * w + r16] = S[m][e];
    if (j == 0) ((float*)(p.ws + WS_LOGD))[slot * 128 + k] = logD;
}

__device__ __forceinline__ void hgrn_passB(const Params& p) {
    float* ST = (float*)(p.ws + WS_ST); const float* LD = (const float*)(p.ws + WS_LOGD);
    const int gt = blockIdx.x * 512 + ltid(), NT = gridDim.x * 512;
    for (int e = gt; e < 64 * 16384; e += NT) {
        const int chain = e >> 14, el = e & 16383, kk = el >> 7, sq = chain >> 3, h = (chain >> 1) & 3, dir = chain & 1;
        const int seg0 = sq < 4 ? sq * 16 : 64 + (sq - 4) * 8, n = sq < 4 ? 16 : 8;
        float carry = 0.f;
        for (int s = 0; s < n; ++s) { const int sg = dir ? seg0 + n - 1 - s : seg0 + s; const int slot = (sg * 4 + h) * 2 + dir; const size_t a = (size_t)slot * 16384 + el;
            const float loc = ST[a]; ST[a] = carry; carry = __expf(LD[slot * 128 + kk]) * carry + loc; }
    }
}

__device__ __forceinline__ void hgrn_passC_item(ldsp lds, int item, int layer, const Params& p, bf16* P) {
    const int tid = ltid(), lane = tid & 63, w = __builtin_amdgcn_readfirstlane(tid >> 6), r16 = lane & 15, quad = lane >> 4;
    const int h = item & 3, sg = item >> 2;
    const int k = tid & 127, j = tid >> 7;
    const f32x4 gn = *(const f32x4*)(p.hgrn_g + layer * 128 + 16 * w + 4 * quad);
#pragma unroll 1
    for (int dir = 0; dir < 2; ++dir) {
        const int slot = (sg * 4 + h) * 2 + dir;
        float lbv = 0.f, l1m = 0.f;
        if (layer) { const float df = p.lb_f[512 + h * 128 + k] - p.lb_f[h * 128 + k], db = p.lb_b[512 + h * 128 + k] - p.lb_b[h * 128 + k]; const float d = dir ? db : df; lbv = sigmoidf_(d); l1m = -__logf(1.f + __expf(d)); }
        f32x4 S[8];
        { const float* sp = (const float*)(p.ws + WS_ST) + (size_t)slot * 16384;
#pragma unroll
          for (int m = 0; m < 8; ++m)
#pragma unroll
              for (int e = 0; e < 4; ++e) S[m][e] = sp[(16 * m + 4 * quad + e) * 128 + 16 * w + r16]; }
        const unsigned char* Pb = (const unsigned char*)P; const unsigned colq = (PC_Q + h * 128 + k) * 2u, colz = ((dir ? PC_ZB : PC_ZF) + h * 128 + k) * 2u, colv = (PC_V + h * 128 + k) * 2u;
#pragma unroll 1
        for (int cc = 0; cc < 8; ++cc) {
            const int c0 = sg * 512 + (dir ? (7 - cc) : cc) * 64;
            {
                float cs[16], lk[16], qd[16], ko[16]; float c = 0.f;
                bf16 zr[16], vr[16], qr[16];
#pragma unroll
                for (int i = 0; i < 16; ++i) { const int tau = 16 * j + i; const unsigned off = (unsigned)(dir ? c0 + 63 - tau : c0 + tau) * (unsigned)(NP * 2); zr[i] = *(const bf16*)(Pb + (off + colz)); vr[i] = *(const bf16*)(Pb + (off + colv)); qr[i] = *(const bf16*)(Pb + (off + colq)); }
#pragma unroll
                for (int i = 0; i < 16; ++i) { const int tau = 16 * j + i; float lf; gate_math(bf2f(zr[i]), layer, lbv, l1m, lf, lk[i]); c += lf; cs[i] = c;
                    qd[i] = bf2f(qr[i]) * __expf(c);
                    const float kd = __expf(fminf(lk[i] - c, 80.f));
                    *(LAS bf16*)(lds + H_QD + tau * 272 + k * 2) = f2bf(qd[i]);
                    *(LAS bf16*)(lds + H_KD + tau * 272 + k * 2) = f2bf(kd); }
#pragma unroll
                for (int i = 0; i < 16; ++i) { const int tau = 16 * j + i; ko[i] = __expf(lk[i] + (c - cs[i])); *(LAS bf16*)(lds + H_KO + tau * 272 + k * 2) = f2bf(ko[i]); }
                unsigned vtp[8];
#pragma unroll
                for (int i = 0; i < 8; ++i) vtp[i] = (unsigned)vr[2 * i] | ((unsigned)vr[2 * i + 1] << 16);
                *(LAS u32x4*)(lds + H_VT + k * 144 + 32 * j) = (u32x4){vtp[0], vtp[1], vtp[2], vtp[3]};
                *(LAS u32x4*)(lds + H_VT + k * 144 + 32 * j + 16) = (u32x4){vtp[4], vtp[5], vtp[6], vtp[7]};
                *(LAS float*)(lds + H_TT + (j * 128 + k) * 4) = c;
                __syncthreads();
                const float T0 = *(LAS float*)(lds + H_TT + k * 4), T1 = *(LAS float*)(lds + H_TT + (128 + k) * 4), T2 = *(LAS float*)(lds + H_TT + (256 + k) * 4), T3 = *(LAS float*)(lds + H_TT + (384 + k) * 4);
                const float bl = (T0 + T1) + (T2 + T3);
                const float rj = (j == 0 ? 0.f : j == 1 ? T0 : j == 2 ? T0 + T1 : T0 + T1 + T2);
                const float fK = __expf(bl - (rj + c));
                unsigned kp[8];
#pragma unroll
                for (int i = 0; i < 8; ++i) kp[i] = pk2(ko[2 * i] * fK, ko[2 * i + 1] * fK);
                *(LAS u32x4*)(lds + H_KST + k * 144 + 32 * j) = (u32x4){kp[0], kp[1], kp[2], kp[3]};
                *(LAS u32x4*)(lds + H_KST + k * 144 + 32 * j + 16) = (u32x4){kp[4], kp[5], kp[6], kp[7]};
                if (j == 3) { const float f = __expf(T2);
#pragma unroll
                    for (int i = 0; i < 16; ++i) *(LAS bf16*)(lds + H_Q3 + i * 272 + k * 2) = f2bf(qd[i] * f); }
                if (j == 0) { const float f = __expf(T1);
#pragma unroll
                    for (int i = 0; i < 16; ++i) *(LAS bf16*)(lds + H_K0 + i * 272 + k * 2) = f2bf(ko[i] * f);
                    *(LAS float*)(lds + H_DEC + k * 4) = __expf(bl); }
                *(LAS float*)(lds + H_ER + (j * 128 + k) * 4) = __expf(rj);
                __syncthreads();
            }
            if (w < 4) score_tile(lds, H_QD + 16 * w * 272, H_KD + 16 * w * 272, w, w, true, r16, quad);
            else if (w < 7) score_tile(lds, H_QD + 16 * (w - 3) * 272, H_KO + 16 * (w - 4) * 272, w - 3, w - 4, false, r16, quad);
            else score_tile(lds, H_QD + 32 * 272, H_K0, 2, 0, false, r16, quad);
            if (w == 0) score_tile(lds, H_Q3, H_KO + 16 * 272, 3, 1, false, r16, quad);
            if (w == 1) score_tile(lds, H_Q3, H_K0, 3, 0, false, r16, quad);
            if (w == 2) *(LAS u32x2*)(lds + H_SC + (r16) * 144 + (16 + 4 * quad) * 2) = (u32x2){0u, 0u};
            if (w == 3) *(LAS u32x2*)(lds + H_SC + (32 + r16) * 144 + (48 + 4 * quad) * 2) = (u32x2){0u, 0u};
            f32x4 o[4];
#pragma unroll
            for (int tt = 0; tt < 4; ++tt) { o[tt] = (f32x4){0.f, 0.f, 0.f, 0.f};
#pragma unroll
                for (int pp = 0; pp < 4; ++pp) {
                    const f32x4 e0 = *(LAS f32x4*)(lds + H_ER + (tt * 128 + 32 * pp + 4 * quad) * 4), e1 = *(LAS f32x4*)(lds + H_ER + (tt * 128 + 32 * pp + 16 + 4 * quad) * 4);
                    const f32x4 s0 = S[2 * pp] * e0, s1 = S[2 * pp + 1] * e1;
                    const bf16x8 a = mk8(pk2(s0[0], s0[1]), pk2(s0[2], s0[3]), pk2(s1[0], s1[1]), pk2(s1[2], s1[3]));
                    const u32x2 b0 = *(LAS u32x2*)(lds + H_QD + (16 * tt + r16) * 272 + (32 * pp + 4 * quad) * 2), b1 = *(LAS u32x2*)(lds + H_QD + (16 * tt + r16) * 272 + (32 * pp + 16 + 4 * quad) * 2);
                    o[tt] = MFMA16(a, mk8(b0.x, b0.y, b1.x, b1.y), o[tt]); } }
            __syncthreads();
            bf16x8 vf[2];
#pragma unroll
            for (int kk = 0; kk < 2; ++kk) vf[kk] = *(LAS bf16x8*)(lds + H_VT + (16 * w + r16) * 144 + (32 * kk + 8 * quad) * 2);
#pragma unroll
            for (int tt = 0; tt < 4; ++tt)
#pragma unroll
                for (int kk = 0; kk < 2; ++kk) { if (kk == 1 && tt < 2) continue;
                    const bf16x8 b = *(LAS bf16x8*)(lds + H_SC + (16 * tt + r16) * 144 + (32 * kk + 8 * quad) * 2); o[tt] = MFMA16(vf[kk], b, o[tt]); }
#pragma unroll
            for (int m = 0; m < 8; ++m) { const f32x4 d = *(LAS f32x4*)(lds + H_DEC + (16 * m + 4 * quad) * 4); S[m] = S[m] * d;
#pragma unroll
                for (int kk = 0; kk < 2; ++kk) { const bf16x8 a = *(LAS bf16x8*)(lds + H_KST + (16 * m + r16) * 144 + (32 * kk + 8 * quad) * 2); S[m] = MFMA16(a, vf[kk], S[m]); } }
            if (dir == 0) {
#pragma unroll
                for (int tt = 0; tt < 4; ++tt) { const int tok = c0 + 16 * tt + r16; u32x2 ov; ov.x = pk2(o[tt][0], o[tt][1]); ov.y = pk2(o[tt][2], o[tt][3]);
                    *(u32x2*)(P + (size_t)tok * NP + PC_ZF + h * 128 + 16 * w + 4 * quad) = ov; }
                __syncthreads();
            } else {
#pragma unroll
                for (int tt = 0; tt < 4; ++tt) { const int tok = c0 + 63 - (16 * tt + r16);
                    const u32x2 of = *(const u32x2*)(P + (size_t)tok * NP + PC_ZF + h * 128 + 16 * w + 4 * quad);
                    o[tt][0] += bflo(of.x); o[tt][1] += bfhi(of.x); o[tt][2] += bflo(of.y); o[tt][3] += bfhi(of.y);
                    float ss = (o[tt][0] * o[tt][0] + o[tt][1] * o[tt][1]) + (o[tt][2] * o[tt][2] + o[tt][3] * o[tt][3]);
                    ss += __shfl_xor(ss, 16); ss += __shfl_xor(ss, 32);
                    if (quad == 0) *(LAS float*)(lds + H_OS + (w * 64 + 16 * tt + r16) * 4) = ss; }
                __syncthreads();
#pragma unroll
                for (int tt = 0; tt < 4; ++tt) { const int tau = 16 * tt + r16, tok = c0 + 63 - tau; float tot = 0.f;
#pragma unroll
                    for (int ww = 0; ww < 8; ++ww) tot += *(LAS float*)(lds + H_OS + (ww * 64 + tau) * 4);
                    const float rs = __builtin_amdgcn_rsqf(tot * (1.f / 128.f) + EPS);
                    bf16* gp = P + (size_t)tok * NP + PC_YC + h * 128 + 16 * w + 4 * quad; const u32x2 g = *(const u32x2*)gp; u32x2 ov;
                    ov.x = pk2(o[tt][0] * rs * gn[0] * bflo(g.x), o[tt][1] * rs * gn[1] * bfhi(g.x)); ov.y = pk2(o[tt][2] * rs * gn[2] * bflo(g.y), o[tt][3] * rs * gn[3] * bfhi(g.y));
                    *(u32x2*)gp = ov; }
            }
        }
        __syncthreads();
    }
}

__global__ void __launch_bounds__(512, 2) fwd_kernel(Params p) {
    extern __shared__ __attribute__((aligned(16))) unsigned char lds_raw[];
    ldsp lds = (ldsp)lds_raw;
    cg::grid_group grid = cg::this_grid();
    unsigned char* ws = p.ws;
    bf16* P = (bf16*)(ws + WS_P); bf16* XB = (bf16*)(ws + WS_XB); float* part = (float*)(ws + WS_PART);
    const int G = gridDim.x, bx = blockIdx.x;
#pragma unroll 1
    for (int ph = p.ph_lo; ph < p.ph_hi; ++ph) {
        if (ph == 0) prologue(lds, p);
        else if (ph == NPH - 1) final_norm(p);
        else {
            const int layer = (ph - 1) / 5, sub = (ph - 1) % 5;
            if (sub == 0) {
                pg8::Gemm g{XB, (const bf16*)(ws + WS_BT1) + (size_t)layer * DIN * D, M, DIN, D, D}; pg8::StaticOrder S; S.init(M, DIN, G, bx);
                Epi1 E{P, part};
                pg8::gemm_phase<Epi1, pg8::StaticOrder, true, true>(lds, g, S, E);
            } else if (sub == 1) {
                for (int it = bx; it < 768; it += G) hgrn_passA_item(lds, it, layer, p, P);
                for (int it = bx; it < 768; it += G) conv_item(lds, it, layer, p, P);
            } else if (sub == 2) {
                hgrn_passB(p);
                for (int it = bx; it < 384; it += G) sgu_item(lds, it, layer, p, P);
            } else if (sub == 3) {
                for (int it = bx; it < 384; it += G) hgrn_passC_item(lds, it, layer, p, P);
            } else {
                pg8::Gemm g{P, (const bf16*)(ws + WS_BT2) + (size_t)layer * D * D, M, D, D, NP}; pg8::StaticOrder S; S.init(M, D, G, bx);
                Epi2 E{layer == 0 ? p.xp : p.out, p.xs, layer == 0 ? M0 : M, p.out, layer == 0 ? XB : nullptr, part};
                pg8::gemm_phase<Epi2, pg8::StaticOrder, true, true>(lds, g, S, E);
            }
        }
        if (ph + 1 < p.ph_hi) grid.sync();
    }
}

extern "C" void kernel_launch(void* const* d_in, const int* in_sizes, int n_in, void* d_out, int out_size, void* d_ws, size_t ws_size, hipStream_t stream) {
    static int grid = 0;
    if (grid == 0) {
        if (n_in != 18 || out_size != M * D || ws_size < WS_END) { fprintf(stderr, "kernel_launch: unexpected shapes (n_in %d out %d ws %zu)\n", n_in, out_size, ws_size); grid = -1; return; }
        int dev = 0, cus = 0, per_cu = 0;
        hipGetDevice(&dev); hipDeviceGetAttribute(&cus, hipDeviceAttributeMultiprocessorCount, dev);
        hipFuncSetAttribute((const void*)fwd_kernel, hipFuncAttributeMaxDynamicSharedMemorySize, LDS_BYTES);
        if (hipOccupancyMaxActiveBlocksPerMultiprocessor(&per_cu, (const void*)fwd_kernel, 512, LDS_BYTES) != hipSuccess || per_cu < 1) per_cu = 1;
        (void)hipGetLastError();
        grid = cus * per_cu;
    }
    if (grid < 0) return;
    Params p{};
    const float** pp = (const float**)&p;
    for (int i = 0; i < 18; ++i) pp[i] = (const float*)d_in[i];
    p.out = (float*)d_out; p.ws = (unsigned char*)d_ws;
#if ONE_LAUNCH
    p.ph_lo = 0; p.ph_hi = NPH;
    void* args[] = {&p};
    hipError_t e = hipLaunchCooperativeKernel((const void*)fwd_kernel, dim3(grid), dim3(512), args, LDS_BYTES, stream);
    if (e != hipSuccess) fprintf(stderr, "cooperative launch failed: %s (grid %d)\n", hipGetErrorString(e), grid);
#else
    for (int ph = 0; ph < NPH; ++ph) { p.ph_lo = ph; p.ph_hi = ph + 1; hipLaunchKernelGGL(fwd_kernel, dim3(grid), dim3(512), LDS_BYTES, stream, p); }
#endif
}
```

```cpp
#include <hip/hip_runtime.h>
#include <hip/hip_cooperative_groups.h>
#include <cstdio>
#include <cstdint>
namespace cg = cooperative_groups;

__device__ __forceinline__ int ltid() { int t = threadIdx.x; asm volatile("" : "+v"(t)); return t; }
namespace pg8 {
#define PG8_LAS __attribute__((address_space(3)))
typedef unsigned short bf16_t;
typedef short bf16x8 __attribute__((ext_vector_type(8)));
typedef float f32x4 __attribute__((ext_vector_type(4)));
typedef unsigned u32x4 __attribute__((ext_vector_type(4)));
constexpr int BM = 256, BK = 64, HALF = 128, HTB = HALF * BK * 2  , STAGE_BYTES = 8 * HTB, NXCD = 8, WGM = 8;

__host__ __device__ __forceinline__ int lds_byte(int r, int c) { const int st = (r >> 4) * 2 + (c >> 5), rr = r & 15, cc = c & 31, ob = rr * 64 + cc * 2; return st * 1024 + (ob ^ (((ob >> 9) & 1) << 5)); }
__host__ __device__ __forceinline__ void stage_rc(int b, int& R, int& C) { const int st = b / 1024, sb = b % 1024, swz = sb ^ (((sb >> 9) & 1) << 5); R = (st >> 1) * 16 + swz / 64; C = (st & 1) * 32 + (swz % 64) / 2; }
__host__ __device__ __forceinline__ int perm32(int rho) { const int n = rho >> 4, i = rho & 15; return 8 * (i >> 2) + 4 * n + (i & 3); }

struct Unit { int pm, pn; };
struct Gemm { const bf16_t* A; const bf16_t* Bt; int M, N, K, lda; };

struct StaticOrder {
    int nM, nN, nwg, G, c;
    __host__ __device__ void init(int M, int N, int G_, int c_) { nM = M / BM; nN = N / BM; nwg = nM * nN; G = G_; c = c_; }
    __host__ __device__ bool next(int i, Unit& u) const {
        const long L = (long)i * G + c; if (L >= nwg) return false;
        int wgid = (int)L; { const int q = nwg / NXCD, r = nwg % NXCD, xcd = wgid % NXCD, off = wgid / NXCD; wgid = (xcd < r ? xcd * (q + 1) : r * (q + 1) + (xcd - r) * q) + off; }
        const int nig = WGM * nN, gid = wgid / nig, fm = gid * WGM, gsz = (nM - fm) < WGM ? (nM - fm) : WGM;
        u.pm = fm + ((wgid % nig) % gsz); u.pn = (wgid % nig) / gsz; return true;
    }
    __device__ __forceinline__ void a_ready(const Unit&) const {}
    __device__ __forceinline__ void done(const Unit&) const {}
};

typedef float f32x2 __attribute__((ext_vector_type(2)));
__device__ __forceinline__ f32x2 gelu_pk(f32x2 v) {
    const f32x2 av = __builtin_elementwise_abs(v), d = av * 0.2316418882f + 1.0f;
    f32x2 t; t.x = __builtin_amdgcn_rcpf(d.x); t.y = __builtin_amdgcn_rcpf(d.y);
    f32x2 q = t * 0.5307027145f + (-0.7265760135f); q = q * t + 0.7107068705f; q = q * t + (-0.142248368f); q = q * t + 0.127414796f; q = q * t;
    const f32x2 s = (v * v) * (-0.72134752044f);
    f32x2 e; e.x = __builtin_amdgcn_exp2f(s.x); e.y = __builtin_amdgcn_exp2f(s.y);
    const f32x2 m = v * (q * e), r = v - m;
    f32x2 o; o.x = v.x < 0.f ? m.x : r.x; o.y = v.y < 0.f ? m.y : r.y; return o;
}

template <class Epi, class Sched, bool ALIGN_EPI = false, bool SP2 = false>
__device__ __forceinline__ void gemm_phase(PG8_LAS unsigned char* lds, const Gemm g, const Sched& S, const Epi& E) {
    const int tid = ltid(), wid = __builtin_amdgcn_readfirstlane(tid >> 6), lane = tid & 63, wr = wid >> 2, wc = wid & 3, fr = lane & 15, fq = lane >> 4;
    const int K = g.K, nt = K / BK;
    unsigned voffA[2], voffB[2];
#pragma unroll
    for (int i = 0; i < 2; ++i) { int R, C; stage_rc(tid * 16 + i * 8192, R, C); const int Rb = Epi::PERM ? ((R & ~31) + perm32(R & 31)) : R;
        voffA[i] = (unsigned)(R * g.lda + C) * 2u; voffB[i] = (unsigned)(Rb * K + C) * 2u; }
    const size_t kstep = (size_t)(BK * 2);
    const size_t hstepB = (size_t)HALF * K * 2, hstepA = (size_t)HALF * g.lda * 2;
    const size_t tstepA = 2 * hstepA, tstepB = 2 * hstepB;
    const unsigned ldsw = (unsigned)wid * 1024u;
    const int aoff = lds_byte(wr * 64 + fr, fq * 8), boff = lds_byte(wc * 32 + fr, fq * 8);
#define PG8_SA(b, h) (((b) * 2 + (h)) * HTB)
#define PG8_SB(b, h) ((4 + (b) * 2 + (h)) * HTB)
#define PG8_STAGE(bufoff, gbase, voff) do { _Pragma("unroll") for (int _i = 0; _i < 2; ++_i) \
        __builtin_amdgcn_global_load_lds((const unsigned*)((const char*)(gbase) + (voff)[_i]), (PG8_LAS unsigned*)(lds + (bufoff) + ldsw + _i * 8192), 16, 0, 0); } while (0)
#define PG8_LDA(dst, b, h) do { _Pragma("unroll") for (int m = 0; m < 4; ++m) _Pragma("unroll") for (int k = 0; k < 2; ++k) dst[m][k] = *(const PG8_LAS bf16x8*)(lds + PG8_SA(b, h) + aoff + m * 2048 + k * 1024); } while (0)
#define PG8_LDB(dst, b, h) do { _Pragma("unroll") for (int n = 0; n < 2; ++n) _Pragma("unroll") for (int k = 0; k < 2; ++k) dst[n][k] = *(const PG8_LAS bf16x8*)(lds + PG8_SB(b, h) + boff + n * 2048 + k * 1024); } while (0)
#define PG8_MMA(ai, bj, At, Bt) do { __builtin_amdgcn_s_setprio(1); _Pragma("unroll") for (int m = 0; m < 4; ++m) _Pragma("unroll") for (int n = 0; n < 2; ++n) _Pragma("unroll") for (int k = 0; k < 2; ++k) \
        acc[ai][bj][m][n] = __builtin_amdgcn_mfma_f32_16x16x32_bf16(Bt[n][k], At[m][k], acc[ai][bj][m][n], 0, 0, 0); __builtin_amdgcn_s_setprio(0); } while (0)
#define PG8_WAIT_V(n) asm volatile("s_waitcnt vmcnt(" #n ")" ::: "memory")
#define PG8_WAIT_L(n) asm volatile("s_waitcnt lgkmcnt(" #n ")" ::: "memory")
#define PG8_BAR __builtin_amdgcn_s_barrier()
#define PG8_SCHED __builtin_amdgcn_sched_barrier(0)
    Unit cur, nxt; int ui = 0;
    if (!S.next(0, cur)) return;
    f32x4 acc[2][2][4][2];
#pragma unroll
    for (int a = 0; a < 2; ++a)
#pragma unroll
        for (int b = 0; b < 2; ++b)
#pragma unroll
            for (int m = 0; m < 4; ++m)
#pragma unroll
                for (int n = 0; n < 2; ++n) acc[a][b][m][n] = (f32x4){0.f, 0.f, 0.f, 0.f};
    bf16x8 At[4][2], B0[2][2], B1[2][2];
    const char* cA = (const char*)g.A + (size_t)cur.pm * tstepA; const char* cB = (const char*)g.Bt + (size_t)cur.pn * tstepB;
    S.a_ready(cur);
    if constexpr (SP2) {
        PG8_STAGE(PG8_SB(0, 0), cB, voffB); PG8_STAGE(PG8_SB(0, 1), cB + hstepB, voffB); PG8_STAGE(PG8_SA(0, 0), cA, voffA); PG8_STAGE(PG8_SA(0, 1), cA + hstepA, voffA);
        if (wr == 1) PG8_BAR;
        PG8_WAIT_V(2); PG8_BAR;
        PG8_STAGE(PG8_SB(1, 0), cB + kstep, voffB); PG8_STAGE(PG8_SA(1, 0), cA + kstep, voffA); PG8_STAGE(PG8_SB(1, 1), cB + hstepB + kstep, voffB);
        PG8_WAIT_V(6); PG8_BAR;
    } else {
        PG8_STAGE(PG8_SB(0, 0), cB, voffB); PG8_STAGE(PG8_SA(0, 0), cA, voffA); PG8_STAGE(PG8_SB(0, 1), cB + hstepB, voffB); PG8_STAGE(PG8_SA(0, 1), cA + hstepA, voffA);
        if (wr == 1) PG8_BAR;
        PG8_WAIT_V(4); PG8_BAR;
        PG8_STAGE(PG8_SB(1, 0), cB + kstep, voffB); PG8_STAGE(PG8_SA(1, 0), cA + kstep, voffA); PG8_STAGE(PG8_SB(1, 1), cB + hstepB + kstep, voffB);
        PG8_WAIT_V(6); PG8_BAR;
    }
    for (;;) {
        const bool has_next = S.next(ui + 1, nxt);
        const char* nA = has_next ? (const char*)g.A + (size_t)nxt.pm * tstepA : cA; const char* nB = has_next ? (const char*)g.Bt + (size_t)nxt.pn * tstepB : cB;
        for (int t = 0; t < nt; t += 2) {
            const bool last = (t == nt - 2);
            const char* a1 = cA + (size_t)(t + 1) * kstep;
            const char* a2 = last ? nA : cA + (size_t)(t + 2) * kstep; const char* b2 = last ? nB : cB + (size_t)(t + 2) * kstep;
            const char* a3 = a2 + kstep; const char* b3 = b2 + kstep;
            if (last && has_next) S.a_ready(nxt);
            if constexpr (SP2) {
            PG8_LDB(B0, 0, 0); PG8_LDB(B1, 0, 1); PG8_SCHED; PG8_LDA(At, 0, 0); PG8_STAGE(PG8_SA(1, 1), a1 + hstepA, voffA);
            PG8_WAIT_V(8); PG8_WAIT_L(0); PG8_BAR; PG8_MMA(0, 0, At, B0); PG8_MMA(0, 1, At, B1); PG8_BAR; PG8_SCHED;
            PG8_LDA(At, 0, 1); PG8_STAGE(PG8_SB(0, 0), b2, voffB); PG8_STAGE(PG8_SB(0, 1), b2 + hstepB, voffB); PG8_STAGE(PG8_SA(0, 0), a2, voffA);
            PG8_WAIT_V(8); PG8_WAIT_L(0); PG8_BAR; PG8_MMA(1, 0, At, B0); PG8_MMA(1, 1, At, B1); PG8_BAR; PG8_SCHED;
            PG8_LDB(B0, 1, 0); PG8_LDB(B1, 1, 1); PG8_SCHED; PG8_LDA(At, 1, 0); PG8_STAGE(PG8_SA(0, 1), a2 + hstepA, voffA);
            PG8_WAIT_V(8); PG8_WAIT_L(0); PG8_BAR; PG8_MMA(0, 0, At, B0); PG8_MMA(0, 1, At, B1); PG8_BAR; PG8_SCHED;
            PG8_LDA(At, 1, 1); PG8_STAGE(PG8_SB(1, 0), b3, voffB); PG8_STAGE(PG8_SB(1, 1), b3 + hstepB, voffB); PG8_STAGE(PG8_SA(1, 0), a3, voffA);
            PG8_WAIT_V(8); PG8_WAIT_L(0); PG8_BAR; PG8_MMA(1, 0, At, B0); PG8_MMA(1, 1, At, B1); PG8_BAR; PG8_SCHED;
            } else {
            PG8_LDB(B0, 0, 0); PG8_SCHED; PG8_LDA(At, 0, 0); PG8_STAGE(PG8_SA(1, 1), a1 + hstepA, voffA);
            PG8_WAIT_L(8); PG8_BAR; PG8_WAIT_L(0); PG8_MMA(0, 0, At, B0); PG8_BAR; PG8_SCHED;
            PG8_LDB(B1, 0, 1); PG8_STAGE(PG8_SB(0, 0), b2, voffB);
            PG8_BAR; PG8_WAIT_L(0); PG8_MMA(0, 1, At, B1); PG8_BAR;
            PG8_LDA(At, 0, 1); PG8_STAGE(PG8_SA(0, 0), a2, voffA);
            PG8_BAR; PG8_WAIT_L(0); PG8_MMA(1, 0, At, B0); PG8_BAR; PG8_SCHED;
            PG8_STAGE(PG8_SB(0, 1), b2 + hstepB, voffB);
            PG8_WAIT_V(6); PG8_BAR; PG8_MMA(1, 1, At, B1); PG8_BAR;
            PG8_LDB(B0, 1, 0); PG8_SCHED; PG8_LDA(At, 1, 0); PG8_STAGE(PG8_SA(0, 1), a2 + hstepA, voffA);
            PG8_WAIT_L(8); PG8_BAR; PG8_WAIT_L(0); PG8_MMA(0, 0, At, B0); PG8_BAR; PG8_SCHED;
            PG8_LDB(B1, 1, 1); PG8_STAGE(PG8_SB(1, 0), b3, voffB);
            PG8_BAR; PG8_WAIT_L(0); PG8_MMA(0, 1, At, B1); PG8_BAR;
            PG8_LDA(At, 1, 1); PG8_STAGE(PG8_SA(1, 0), a3, voffA);
            PG8_BAR; PG8_WAIT_L(0); PG8_MMA(1, 0, At, B0); PG8_BAR; PG8_SCHED;
            PG8_STAGE(PG8_SB(1, 1), b3 + hstepB, voffB);
            PG8_WAIT_V(6); PG8_BAR; PG8_MMA(1, 1, At, B1); PG8_BAR;
            }
        }
        if constexpr (ALIGN_EPI) { if (wr == 0) PG8_BAR; }
        if constexpr (!Epi::AFTER_DRAIN) { E(acc, cur, wr, wc, fr, fq); S.done(cur); }
        if (!has_next) break;
#pragma unroll
        for (int a = 0; a < 2; ++a)
#pragma unroll
            for (int b = 0; b < 2; ++b)
#pragma unroll
                for (int m = 0; m < 4; ++m)
#pragma unroll
                    for (int n = 0; n < 2; ++n) acc[a][b][m][n] = (f32x4){0.f, 0.f, 0.f, 0.f};
        cur = nxt; cA = nA; cB = nB; ++ui;
        if constexpr (ALIGN_EPI) { if (wr == 1) PG8_BAR; }
    }
    PG8_WAIT_V(0);
    if constexpr (!ALIGN_EPI) { if (wr == 0) PG8_BAR; }
    PG8_BAR;
    if constexpr (Epi::AFTER_DRAIN) { E.fused(acc, cur, wr, wc, fr, fq, lds, wid, lane); S.done(cur); }
#undef PG8_SA
#undef PG8_SB
#undef PG8_STAGE
#undef PG8_LDA
#undef PG8_LDB
#undef PG8_MMA
#undef PG8_WAIT_V
#undef PG8_WAIT_L
#undef PG8_BAR
#undef PG8_SCHED
}
}

#ifndef ONE_LAUNCH
#define ONE_LAUNCH 1
#endif
#define LAS __attribute__((address_space(3)))
typedef unsigned short bf16;
typedef unsigned u32x4 __attribute__((ext_vector_type(4)));
typedef unsigned u32x2 __attribute__((ext_vector_type(2)));
typedef float f32x4 __attribute__((ext_vector_type(4)));
typedef float f32x2 __attribute__((ext_vector_type(2)));
typedef short bf16x8 __attribute__((ext_vector_type(8)));
typedef __bf16 bf16x2_t __attribute__((ext_vector_type(2)));
typedef LAS unsigned char* ldsp;

constexpr int M = 49152, M0 = 32768, D = 1024, DIN = 4096;
constexpr float EPS = 1e-6f;
constexpr int PC_YA = 0, PC_YB = 256, PC_YC = 512;
constexpr int NSEG = 192, SEGC = 4;
constexpr size_t MiB = 1u << 20;
constexpr size_t WS_PART = 0, WS_LOGD = 3 * MiB, WS_BT1 = 4 * MiB, WS_BT2 = 20 * MiB, WS_PWT = 24 * MiB, WS_SGW = 24 * MiB + 256 * 1024;
constexpr size_t OUT_ST = 96 * MiB;
constexpr size_t WS_XB = 26 * MiB, WS_Y = 122 * MiB, WS_GLU = 218 * MiB, WS_BU = 242 * MiB, WS_BV = 266 * MiB, WS_HQ = 290 * MiB, WS_END = 482 * MiB;
constexpr unsigned HARR = 48u << 20, HHEAD = (unsigned)M * 256u;
constexpr int LDS_BYTES = 147456, LDS_BARST = 145408;
constexpr size_t WS_BAR = 3 * MiB + 896 * 1024;
constexpr int NPH = 12;

struct Params {
    const float *xp, *xs, *norm_g, *w_in, *conv_w, *conv_b, *conv_ln_g, *conv_ln_b, *conv_pw, *sgu_ln_g, *sgu_ln_b, *sgu_w, *sgu_b, *lb_f, *lb_b, *hgrn_g, *w_out, *final_g;
    float* out; unsigned char* ws; int ph_lo, ph_hi;
};

__device__ __forceinline__ float bf2f(bf16 b) { return __uint_as_float((unsigned)b << 16); }
__device__ __forceinline__ float bflo(unsigned w) { return __uint_as_float(w << 16); }
__device__ __forceinline__ float bfhi(unsigned w) { return __uint_as_float(w & 0xffff0000u); }
__device__ __forceinline__ unsigned pk2(float lo, float hi) { f32x2 v = {lo, hi}; bf16x2_t b = __builtin_convertvector(v, bf16x2_t); return __builtin_bit_cast(unsigned, b); }
__device__ __forceinline__ bf16 f2bf(float x) { return (bf16)(pk2(x, 0.f) & 0xffffu); }
__device__ __forceinline__ float sigmoidf_(float x) { return __builtin_amdgcn_rcpf(1.f + __expf(-x)); }
__device__ __forceinline__ float siluf_(float x) { return x * sigmoidf_(x); }
__device__ __forceinline__ float wave_sum(float v) {
#pragma unroll
    for (int o = 1; o < 64; o <<= 1) v += __shfl_xor(v, o);
    return v;
}
__device__ __forceinline__ bf16x8 mk8(unsigned a, unsigned b, unsigned c, unsigned d) { u32x4 v = {a, b, c, d}; return __builtin_bit_cast(bf16x8, v); }
#define LBAR() asm volatile("s_waitcnt lgkmcnt(0)\n\ts_barrier" ::: "memory")
#define MFMA16(a, b, c) __builtin_amdgcn_mfma_f32_16x16x32_bf16((a), (b), (c), 0, 0, 0)

struct Epi1 {
    static constexpr bool PERM = true, AFTER_DRAIN = false;
    unsigned char* ws; const float* part;
    __device__ __forceinline__ void operator()(const pg8::f32x4 (&acc)[2][2][4][2], const pg8::Unit& u, int wr, int wc, int fr, int fq) const {
        const int row0 = u.pm * 256 + wr * 64 + fr; const int pn = u.pn;
        const int cw = wc * 32 + 8 * fq;
#pragma unroll
        for (int ai = 0; ai < 2; ++ai)
#pragma unroll
            for (int m = 0; m < 4; ++m) {
                const int r = row0 + ai * 128 + m * 16;
                float s = 0.f;
#pragma unroll
                for (int q = 0; q < 4; ++q) s += part[(size_t)(4 * fq + q) * M + r];
                s += __shfl_xor(s, 16); s += __shfl_xor(s, 32);
                const float rs = __builtin_amdgcn_rsqf(s * (1.f / D) + EPS);
                if (pn < 2) {
                    f32x4 a0 = acc[ai][0][m][0] * rs, a1 = acc[ai][0][m][1] * rs, g0 = acc[ai][1][m][0] * rs, g1 = acc[ai][1][m][1] * rs;
                    u32x4 w;
                    w.x = pk2(a0[0] * sigmoidf_(g0[0]), a0[1] * sigmoidf_(g0[1])); w.y = pk2(a0[2] * sigmoidf_(g0[2]), a0[3] * sigmoidf_(g0[3]));
                    w.z = pk2(a1[0] * sigmoidf_(g1[0]), a1[1] * sigmoidf_(g1[1])); w.w = pk2(a1[2] * sigmoidf_(g1[2]), a1[3] * sigmoidf_(g1[3]));
                    *(u32x4*)((bf16*)(ws + WS_GLU) + (size_t)r * 256 + 128 * pn + cw) = w;
                } else {
#pragma unroll
                    for (int bj = 0; bj < 2; ++bj) {
                        f32x4 v0 = acc[ai][bj][m][0] * rs, v1 = acc[ai][bj][m][1] * rs;
                        if (pn < 6) {
#pragma unroll
                            for (int e = 0; e < 4; ++e) { v0[e] = siluf_(v0[e]); v1[e] = siluf_(v1[e]); }
                        } else if (pn < 8) {
                            f32x2 a = pg8::gelu_pk((f32x2){v0[0], v0[1]}), b = pg8::gelu_pk((f32x2){v0[2], v0[3]}), c = pg8::gelu_pk((f32x2){v1[0], v1[1]}), d = pg8::gelu_pk((f32x2){v1[2], v1[3]});
                            v0 = (f32x4){a.x, a.y, b.x, b.y}; v1 = (f32x4){c.x, c.y, d.x, d.y};
                        }
                        u32x4 w; w.x = pk2(v0[0], v0[1]); w.y = pk2(v0[2], v0[3]); w.z = pk2(v1[0], v1[1]); w.w = pk2(v1[2], v1[3]);
                        bf16* dst;
                        if (pn < 6) dst = (bf16*)(ws + WS_Y) + (size_t)r * 1024 + 256 * (pn - 2) + 128 * bj + cw;
                        else if (pn < 8) dst = (bf16*)(ws + (pn == 6 ? WS_BU : WS_BV)) + (size_t)r * 256 + 128 * bj + cw;
                        else dst = (bf16*)(ws + WS_HQ + (size_t)((pn - 8) >> 1) * HARR + (size_t)(2 * ((pn - 8) & 1) + bj) * HHEAD) + (size_t)r * 128 + cw;
                        *(u32x4*)dst = w;
                    }
                }
            }
    }
};
struct Epi2 {
    static constexpr bool PERM = true, AFTER_DRAIN = false;
    const float* xin0; const float* xin1; int split; const bf16* xinb; float* xout; bf16* XB; float* part;
    __device__ __forceinline__ void operator()(const pg8::f32x4 (&acc)[2][2][4][2], const pg8::Unit& u, int wr, int wc, int fr, int fq) const {
        const int row0 = u.pm * 256 + wr * 64 + fr; const int pn = u.pn;
        const int cw = pn * 256 + wc * 32 + 8 * fq;
#pragma unroll
        for (int ai = 0; ai < 2; ++ai)
#pragma unroll
            for (int m = 0; m < 4; ++m) {
                const int r = row0 + ai * 128 + m * 16;
                const float* src = (r < split) ? xin0 + (size_t)r * D : xin1 + (size_t)(r - split) * D;
                float ss = 0.f;
#pragma unroll
                for (int bj = 0; bj < 2; ++bj) {
                    const int col = cw + 128 * bj;
                    f32x4 v0, v1;
                    if (xinb) { const u32x4 t = *(const u32x4*)(xinb + (size_t)r * D + col); v0 = (f32x4){bflo(t.x), bfhi(t.x), bflo(t.y), bfhi(t.y)}; v1 = (f32x4){bflo(t.z), bfhi(t.z), bflo(t.w), bfhi(t.w)}; }
                    else { v0 = *(const f32x4*)(src + col); v1 = *(const f32x4*)(src + col + 4); }
                    v0 = v0 + acc[ai][bj][m][0]; v1 = v1 + acc[ai][bj][m][1];
                    if (xout) { *(f32x4*)(xout + (size_t)r * D + col) = v0; *(f32x4*)(xout + (size_t)r * D + col + 4) = v1; }
                    ss += (v0[0] * v0[0] + v0[1] * v0[1]) + (v0[2] * v0[2] + v0[3] * v0[3]) + (v1[0] * v1[0] + v1[1] * v1[1]) + (v1[2] * v1[2] + v1[3] * v1[3]);
                    { u32x4 w; w.x = pk2(v0[0], v0[1]); w.y = pk2(v0[2], v0[3]); w.z = pk2(v1[0], v1[1]); w.w = pk2(v1[2], v1[3]); *(u32x4*)(XB + (size_t)r * D + col) = w; }
                }
                ss += __shfl_xor(ss, 16); ss += __shfl_xor(ss, 32);
                if (fq == 0) part[(size_t)(pn * 4 + wc) * M + r] = ss;
            }
    }
};

__device__ __forceinline__ int srcmap128(int b) {
    if (b < 4) return ((b & 1) ? 256 : 0) + 128 * (b >> 1);
    if (b < 6) return 512 + 128 * (b - 4);
    if (b < 8) return 1280 + 128 * (b - 6);
    if (b < 12) return 3584 + 128 * (b - 8);
    if (b < 14) return 768 + 128 * (b - 12);
    if (b < 16) return 1024 + 128 * (b - 14);
    if (b < 20) return 1536 + 128 * (b - 16);
    if (b < 24) return 2048 + 128 * (b - 20);
    if (b < 28) return 2560 + 128 * (b - 24);
    return 3072 + 128 * (b - 28);
}
__device__ __forceinline__ void tr_item(const float* W, int N, int sc0, const float* gk, int k0, bf16* WT, int K, int drow0, LAS float* scr, int lane) {
    float v[64];
#pragma unroll
    for (int kk = 0; kk < 64; ++kk) v[kk] = W[(size_t)(k0 + kk) * N + sc0 + lane];
    if (gk) {
#pragma unroll
        for (int kk = 0; kk < 64; ++kk) v[kk] *= gk[k0 + kk]; }
#pragma unroll
    for (int kk = 0; kk < 64; ++kk) scr[kk * 65 + lane] = v[kk];
    asm volatile("s_waitcnt lgkmcnt(0)" ::: "memory");
    const int c = lane & 7;
#pragma unroll
    for (int j = 0; j < 8; ++j) { const int n = (lane >> 3) + 8 * j; const LAS float* s = scr + (8 * c) * 65 + n;
        u32x4 o; o.x = pk2(s[0 * 65], s[1 * 65]); o.y = pk2(s[2 * 65], s[3 * 65]); o.z = pk2(s[4 * 65], s[5 * 65]); o.w = pk2(s[6 * 65], s[7 * 65]);
        *(u32x4*)(WT + (size_t)(drow0 + n) * K + k0 + 8 * c) = o; }
    asm volatile("s_waitcnt lgkmcnt(0)" ::: "memory");
}
__device__ __forceinline__ void prologue(ldsp lds, const Params& p) {
    const int tid = ltid(), lane = tid & 63, wave = __builtin_amdgcn_readfirstlane(tid >> 6);
    const int gw = blockIdx.x * 8 + wave, NGW = gridDim.x * 8;
    LAS float* scr = (LAS float*)(lds + wave * 16640);
    unsigned char* ws = p.ws;
    constexpr int I_IN = 16 * 64, I_OUT = 16 * 16, I_PW = 4 * 4, I_L = I_IN + I_OUT + I_PW;
    for (int it = gw; it < 2 * I_L; it += NGW) {
        const int l = it / I_L; int r = it - l * I_L;
        if (r < I_IN) { const int kb = r >> 6, nb = r & 63; tr_item(p.w_in + (size_t)l * D * DIN, DIN, srcmap128(nb >> 1) + 64 * (nb & 1), p.norm_g + l * D, 64 * kb, (bf16*)(ws + WS_BT1) + (size_t)l * DIN * D, D, 64 * nb, scr, lane); continue; }
        r -= I_IN;
        if (r < I_OUT) { const int kb = r >> 4, nb = r & 15; tr_item(p.w_out + (size_t)l * D * D, D, 64 * nb, nullptr, 64 * kb, (bf16*)(ws + WS_BT2) + (size_t)l * D * D, D, 64 * nb, scr, lane); continue; }
        r -= I_OUT;
        { const int kb = r >> 2, nb = r & 3; tr_item(p.conv_pw + (size_t)l * 65536, 256, 64 * nb, nullptr, 64 * kb, (bf16*)(ws + WS_PWT) + (size_t)l * 65536, 256, 64 * nb, scr, lane); }
    }
    { const int gt = blockIdx.x * 512 + tid, NT = gridDim.x * 512; bf16* o = (bf16*)(ws + WS_SGW);
      for (int i = gt; i < 2 * 4 * 128 * 128 / 4; i += NT) { const f32x4 v = *(const f32x4*)(p.sgu_w + 4 * (size_t)i); u32x2 w; w.x = pk2(v[0], v[1]); w.y = pk2(v[2], v[3]); *(u32x2*)(o + 4 * (size_t)i) = w; } }
    bf16* XB = (bf16*)(ws + WS_XB); float* part = (float*)(ws + WS_PART);
    for (int r = gw; r < M; r += 4 * NGW) {
        f32x4 v[4][4];
#pragma unroll
        for (int u = 0; u < 4; ++u) { const int rr = r + u * NGW; if (rr < M) { const float* src = (rr < M0) ? p.xp + (size_t)rr * D : p.xs + (size_t)(rr - M0) * D;
#pragma unroll
            for (int j = 0; j < 4; ++j) v[u][j] = ((const f32x4*)src)[lane + 64 * j]; } }
#pragma unroll
        for (int u = 0; u < 4; ++u) { const int rr = r + u * NGW; if (rr < M) { float s = 0.f;
            unsigned long long* o8 = (unsigned long long*)(XB + (size_t)rr * D) + lane;
#pragma unroll
            for (int j = 0; j < 4; ++j) { const f32x4 t = v[u][j]; s += (t[0] * t[0] + t[1] * t[1]) + (t[2] * t[2] + t[3] * t[3]); o8[64 * j] = (unsigned long long)pk2(t[0], t[1]) | ((unsigned long long)pk2(t[2], t[3]) << 32); }
            s = wave_sum(s);
            if (lane < 16) part[(size_t)lane * M + rr] = lane == 0 ? s : 0.f; } }
    }
}

__device__ __forceinline__ void final_norm(const Params& p) {
    const int tid = ltid(), lane = tid & 63, wave = tid >> 6;
    const int gw = blockIdx.x * 8 + wave, NGW = gridDim.x * 8;
    const float* part = (const float*)(p.ws + WS_PART);
    f32x4 g[4];
#pragma unroll
    for (int j = 0; j < 4; ++j) g[j] = *((const f32x4*)p.final_g + lane + 64 * j);
    const bf16* XB = (const bf16*)(p.ws + WS_XB);
    for (int r = gw; r < M; r += 4 * NGW) {
        u32x2 v[4][4]; float s[4];
#pragma unroll
        for (int u = 0; u < 4; ++u) { const int rr = r + u * NGW; if (rr < M) { s[u] = lane < 16 ? part[(size_t)lane * M + rr] : 0.f;
#pragma unroll
            for (int j = 0; j < 4; ++j) v[u][j] = ((const u32x2*)(XB + (size_t)rr * D))[lane + 64 * j]; } }
#pragma unroll
        for (int u = 0; u < 4; ++u) { const int rr = r + u * NGW; if (rr < M) { const float rs = __builtin_amdgcn_rsqf(wave_sum(s[u]) * (1.f / D) + EPS);
#pragma unroll
            for (int j = 0; j < 4; ++j) { const f32x4 x = {bflo(v[u][j].x), bfhi(v[u][j].x), bflo(v[u][j].y), bfhi(v[u][j].y)}; ((f32x4*)(p.out + (size_t)rr * D))[lane + 64 * j] = x * rs * g[j]; } } }
    }
}

constexpr int L_LNP = 122880;
__device__ __forceinline__ void conv_item(ldsp lds, int item, int layer, const Params& p, const f32x2 (&w2)[31], const f32x2 bb2) {
    const int tid = ltid(), lane = tid & 63, w = __builtin_amdgcn_readfirstlane(tid >> 6), r16 = lane & 15, quad = lane >> 4;
    const int r0 = item * 64;
    int s0, s1; if (r0 < M0) { s0 = r0 & ~8191; s1 = s0 + 8192; } else { s0 = M0 + ((r0 - M0) & ~4095); s1 = s0 + 4096; }
    const bf16* pwT = (const bf16*)(p.ws + WS_PWT) + (size_t)layer * 65536;
    ldsp IN = lds;
    LAS float* CV = (LAS float*)(lds + 49152);
    ldsp AO = lds;
    for (int idx = tid; idx < 94 * 32; idx += 512) { const int row = idx >> 5, c16 = idx & 31, gr = r0 - 15 + row;
        u32x4 v = {0u, 0u, 0u, 0u}; if (gr >= s0 && gr < s1) v = *(const u32x4*)((const bf16*)(p.ws + WS_GLU) + (size_t)gr * 256 + c16 * 8);
        *(LAS u32x4*)(IN + row * 512 + c16 * 16) = v; }
    u32x2 gpre[4][2];
#pragma unroll
    for (int m = 0; m < 4; ++m)
#pragma unroll
        for (int nt = 0; nt < 2; ++nt) gpre[m][nt] = *(const u32x2*)((const bf16*)(p.ws + WS_Y) + (size_t)(r0 + 16 * m + r16) * 1024 + PC_YA + 32 * w + 16 * nt + 4 * quad);
    LBAR();
    {
        const int cp = tid & 127, qtr = tid >> 7;
#pragma unroll 1
        for (int ob = 0; ob < 2; ++ob) {
            const int t0 = 16 * qtr + 8 * ob;
            f32x2 x[38];
#pragma unroll
            for (int i = 0; i < 38; ++i) { const unsigned u = *(LAS unsigned*)(IN + (t0 + i) * 512 + cp * 4); x[i] = (f32x2){bflo(u), bfhi(u)}; }
            f32x2 a0[8];
#pragma unroll
            for (int o = 0; o < 8; ++o) a0[o] = bb2;
#pragma unroll
            for (int j = 0; j < 31; ++j)
#pragma unroll
                for (int o = 0; o < 8; ++o) a0[o] = x[o + j] * w2[j] + a0[o];
#pragma unroll
            for (int o = 0; o < 8; ++o) *(LAS f32x2*)(CV + (t0 + o) * 288 + 2 * cp) = a0[o];
        }
    }
    LBAR();
    bf16x8 pwf[8][2];
#pragma unroll
    for (int kk = 0; kk < 8; ++kk) { pwf[kk][0] = *(const bf16x8*)(pwT + (size_t)(32 * w + r16) * 256 + 32 * kk + 8 * quad); pwf[kk][1] = *(const bf16x8*)(pwT + (size_t)(32 * w + 16 + r16) * 256 + 32 * kk + 8 * quad); }
    {
        const int tok = tid >> 3, part = tid & 7;
        f32x4 v[8]; float s = 0.f;
#pragma unroll
        for (int i = 0; i < 8; ++i) { v[i] = *(LAS f32x4*)(CV + tok * 288 + 32 * i + 4 * part); s += (v[i][0] + v[i][1]) + (v[i][2] + v[i][3]); }
        s += __shfl_xor(s, 1); s += __shfl_xor(s, 2); s += __shfl_xor(s, 4);
        const float mean = s * (1.f / 256.f); float q = 0.f;
#pragma unroll
        for (int i = 0; i < 8; ++i) { v[i] = v[i] - mean; q += (v[i][0] * v[i][0] + v[i][1] * v[i][1]) + (v[i][2] * v[i][2] + v[i][3] * v[i][3]); }
        q += __shfl_xor(q, 1); q += __shfl_xor(q, 2); q += __shfl_xor(q, 4);
        const float rstd = __builtin_amdgcn_rsqf(q * (1.f / 256.f) + EPS);
#pragma unroll
        for (int i = 0; i < 8; ++i) { const int c = 32 * i + 4 * part; const f32x4 gg = *(LAS f32x4*)(lds + L_LNP + c * 4), bb = *(LAS f32x4*)(lds + L_LNP + 1024 + c * 4);
            f32x4 y = v[i] * rstd * gg + bb;
            u32x2 o; o.x = pk2(siluf_(y[0]), siluf_(y[1])); o.y = pk2(siluf_(y[2]), siluf_(y[3]));
            *(LAS u32x2*)(AO + tok * 528 + c * 2) = o; }
    }
    LBAR();
    {
        f32x4 acc[4][2];
#pragma unroll
        for (int m = 0; m < 4; ++m) { acc[m][0] = (f32x4){0.f, 0.f, 0.f, 0.f}; acc[m][1] = (f32x4){0.f, 0.f, 0.f, 0.f}; }
#pragma unroll
        for (int kk = 0; kk < 8; ++kk) {
            const bf16x8 b0 = pwf[kk][0], b1 = pwf[kk][1]; bf16x8 af[4];
#pragma unroll
            for (int m = 0; m < 4; ++m) af[m] = *(LAS bf16x8*)(AO + (16 * m + r16) * 528 + (32 * kk + 8 * quad) * 2);
#pragma unroll
            for (int m = 0; m < 4; ++m) { acc[m][0] = MFMA16(b0, af[m], acc[m][0]); acc[m][1] = MFMA16(b1, af[m], acc[m][1]); }
        }
#pragma unroll
        for (int m = 0; m < 4; ++m)
#pragma unroll
            for (int nt = 0; nt < 2; ++nt) { bf16* gp = (bf16*)(p.ws + WS_Y) + (size_t)(r0 + 16 * m + r16) * 1024 + PC_YA + 32 * w + 16 * nt + 4 * quad;
                const u32x2 g = gpre[m][nt]; u32x2 o; o.x = pk2(acc[m][nt][0] * bflo(g.x), acc[m][nt][1] * bfhi(g.x)); o.y = pk2(acc[m][nt][2] * bflo(g.y), acc[m][nt][3] * bfhi(g.y));
                *(u32x2*)gp = o; }
    }
    LBAR();
}

__device__ __forceinline__ void sgu_item(ldsp lds, int item, int layer, const Params& p) {
    const int tid = ltid(), lane = tid & 63, w = __builtin_amdgcn_readfirstlane(tid >> 6), r16 = lane & 15, quad = lane >> 4;
    const int r0 = (item >> 1) * 128, hp = item & 1;
    const bf16* SW = (const bf16*)(p.ws + WS_SGW) + (size_t)layer * 65536; const float* sb = p.sgu_b + layer * 512;
    ldsp VT = lds;
    u32x2 upre[2][4], gpre[2][4];
    bf16x8 wfp[2][4];
    { const int h = 2 * hp + (w >> 2), tq = w & 3;
#pragma unroll
      for (int tti = 0; tti < 2; ++tti)
#pragma unroll
          for (int kk = 0; kk < 4; ++kk) wfp[tti][kk] = *(const bf16x8*)(SW + (size_t)(h * 128 + 16 * (2 * tq + tti) + r16) * 128 + 32 * kk + 8 * quad);
#pragma unroll
      for (int tti = 0; tti < 2; ++tti)
#pragma unroll
          for (int dt = 0; dt < 4; ++dt) { const size_t row = (size_t)(r0 + 16 * (2 * tq + tti) + r16); const int ch = h * 64 + 16 * dt + 4 * quad;
              upre[tti][dt] = *(const u32x2*)((const bf16*)(p.ws + WS_BU) + row * 256 + ch); gpre[tti][dt] = *(const u32x2*)((const bf16*)(p.ws + WS_Y) + row * 1024 + PC_YB + ch); } }
    {
        const int tok = tid >> 2, part = tid & 3;
        const bf16* src = (const bf16*)(p.ws + WS_BV) + (size_t)(r0 + tok) * 256;
        float v[64]; float s = 0.f;
#pragma unroll
        for (int i = 0; i < 8; ++i) { const u32x4 t = *(const u32x4*)(src + 32 * i + 8 * part);
            v[8 * i + 0] = bflo(t.x); v[8 * i + 1] = bfhi(t.x); v[8 * i + 2] = bflo(t.y); v[8 * i + 3] = bfhi(t.y); v[8 * i + 4] = bflo(t.z); v[8 * i + 5] = bfhi(t.z); v[8 * i + 6] = bflo(t.w); v[8 * i + 7] = bfhi(t.w); }
#pragma unroll
        for (int i = 0; i < 64; ++i) s += v[i];
        s += __shfl_xor(s, 1); s += __shfl_xor(s, 2);
        const float mean = s * (1.f / 256.f); float q = 0.f;
#pragma unroll
        for (int i = 0; i < 64; ++i) { v[i] -= mean; q += v[i] * v[i]; }
        q += __shfl_xor(q, 1); q += __shfl_xor(q, 2);
        const float rstd = __builtin_amdgcn_rsqf(q * (1.f / 256.f) + EPS);
        const bool odd = tok & 1;
#pragma unroll
        for (int i = 0; i < 8; ++i) {
            if ((i >> 2) != hp) continue;
            const int cb = 32 * i + 8 * part;
#pragma unroll
            for (int e = 0; e < 8; e += 2) {
                const f32x2 gg = *(LAS f32x2*)(lds + L_LNP + 2048 + (cb + e) * 4), bb = *(LAS f32x2*)(lds + L_LNP + 3072 + (cb + e) * 4);
                const unsigned own = pk2(v[8 * i + e] * rstd * gg.x + bb.x, v[8 * i + e + 1] * rstd * gg.y + bb.y);
                const unsigned oth = (unsigned)__shfl_xor((int)own, 4);
                const unsigned val = odd ? ((oth >> 16) | (own & 0xffff0000u)) : ((own & 0xffffu) | (oth << 16));
                const int ch = cb + e + (odd ? 1 : 0), t0 = tok & ~1;
                *(LAS unsigned*)(VT + ch * 272 + t0 * 2) = val;
            }
        }
    }
    LBAR();
    {
        const int h = 2 * hp + (w >> 2), tq = w & 3;
        bf16x8 vf[4][4];
#pragma unroll
        for (int dt = 0; dt < 4; ++dt)
#pragma unroll
            for (int kk = 0; kk < 4; ++kk) vf[dt][kk] = *(LAS bf16x8*)(VT + (h * 64 + 16 * dt + r16) * 272 + (32 * kk + 8 * quad) * 2);
#pragma unroll
        for (int tti = 0; tti < 2; ++tti) {
            const int tt = 2 * tq + tti;
            bf16x8 wf[4];
#pragma unroll
            for (int kk = 0; kk < 4; ++kk) wf[kk] = wfp[tti][kk];
            f32x4 acc[4];
#pragma unroll
            for (int dt = 0; dt < 4; ++dt) { acc[dt] = (f32x4){0.f, 0.f, 0.f, 0.f};
#pragma unroll
                for (int kk = 0; kk < 4; ++kk) acc[dt] = MFMA16(vf[dt][kk], wf[kk], acc[dt]); }
            const float bias = sb[h * 128 + 16 * tt + r16];
            bf16* rowy = (bf16*)(p.ws + WS_Y) + (size_t)(r0 + 16 * tt + r16) * 1024; const bf16* rowu = (const bf16*)(p.ws + WS_BU) + (size_t)(r0 + 16 * tt + r16) * 256;
#pragma unroll
            for (int dt = 0; dt < 4; ++dt) { const int ch = h * 64 + 16 * dt + 4 * quad;
                const u32x2 uu = upre[tti][dt], g = gpre[tti][dt]; u32x2 o;
                o.x = pk2(bflo(uu.x) * (acc[dt][0] + bias) * bflo(g.x), bfhi(uu.x) * (acc[dt][1] + bias) * bfhi(g.x));
                o.y = pk2(bflo(uu.y) * (acc[dt][2] + bias) * bflo(g.y), bfhi(uu.y) * (acc[dt][3] + bias) * bfhi(g.y));
                *(u32x2*)(rowy + PC_YB + ch) = o; }
        }
    }
    LBAR();
}

constexpr int H_QD = 0, H_KD = 17408, H_KO = 34816, H_Q3 = 52224, H_K0 = 56576, H_KST = 60928, H_VT = 79360, H_SC = 97792, H_TT = 107008, H_ER = 109056, H_DEC = 111104, H_OS = 111616;

__device__ __forceinline__ void score_tile(ldsp lds, int qoff, int koff, int ti, int sj, bool diag, int r16, int quad) {
    f32x4 acc = {0.f, 0.f, 0.f, 0.f};
    bf16x8 ka[4], qa[4];
#pragma unroll
    for (int kk = 0; kk < 4; ++kk) { ka[kk] = *(LAS bf16x8*)(lds + koff + r16 * 272 + (32 * kk + 8 * quad) * 2); qa[kk] = *(LAS bf16x8*)(lds + qoff + r16 * 272 + (32 * kk + 8 * quad) * 2); }
#pragma unroll
    for (int kk = 0; kk < 4; ++kk) acc = MFMA16(ka[kk], qa[kk], acc);
    if (diag) {
#pragma unroll
        for (int e = 0; e < 4; ++e) if (4 * quad + e > r16) acc[e] = 0.f;
    }
    u32x2 o; o.x = pk2(acc[0], acc[1]); o.y = pk2(acc[2], acc[3]);
    *(LAS u32x2*)(lds + H_SC + (16 * ti + r16) * 144 + (16 * sj + 4 * quad) * 2) = o;
}

__device__ __forceinline__ void gate_fk(float z, float lbv, float oml, float& f, float& kk) {
    z = fmaxf(z, -30.f);
    const float e = __expf(-z), s = __builtin_amdgcn_rcpf(1.f + e);
    f = oml * s + lbv; kk = oml * e * s;
}
constexpr int H_T8 = 113664, H_QS = 117760;
#define HG_TOK(c0_, i_) (dir ? (c0_) + 63 - 8 * w - (i_) : (c0_) + 8 * w + (i_))
#define HG_LD(arr_, c0_, i_) (*(const unsigned*)(Pb + ((unsigned)HG_TOK(c0_, i_) * 256u + (arr_))))

constexpr int A_KST = 0, A_VT = 34816, A_T8 = 69632, A_DEC = 73728;
#define HGA_LD(arr_, c0_, i_) (*(const unsigned*)(Pb + ((unsigned)(dir ? (c0_) + 127 - 16 * w - (i_) : (c0_) + 16 * w + (i_)) * 256u + (arr_))))
template <int DIR> __device__ __forceinline__ void hgrn_passA_dir(ldsp lds, int item, int layer, const Params& p) {
    const int tid = ltid(), lane = tid & 63, w = __builtin_amdgcn_readfirstlane(tid >> 6), r16 = lane & 15, quad = lane >> 4;
    constexpr int dir = DIR; const int h = (item >> 1) & 3, sg = item >> 3; const int slot = item;
    const int kp = lane;
    float lb0 = 0.f, lb1 = 0.f;
    if (layer) { const float* lp = dir ? p.lb_b : p.lb_f; const f32x2 a = *(const f32x2*)(lp + 512 + h * 128 + 2 * kp), b = *(const f32x2*)(lp + h * 128 + 2 * kp); lb0 = sigmoidf_(a.x - b.x); lb1 = sigmoidf_(a.y - b.y); }
    const float om0 = 1.f - lb0, om1 = 1.f - lb1;
    f32x4 S[8];
#pragma unroll
    for (int m = 0; m < 8; ++m) S[m] = (f32x4){0.f, 0.f, 0.f, 0.f};
    float pd0 = 1.f, pd1 = 1.f;
    const unsigned char* Pb = p.ws + WS_HQ; const unsigned az = (dir ? 3u : 2u) * HARR + (unsigned)h * HHEAD + kp * 4u, av = HARR + (unsigned)h * HHEAD + kp * 4u;
    unsigned zr[16];
    { const int c0 = sg * 256 + (dir ? 128 : 0);
#pragma unroll
      for (int i = 0; i < 16; ++i) zr[i] = HGA_LD(az, c0, i); }
#pragma unroll 1
    for (int cc = 0; cc < 2; ++cc) {
        unsigned vr[16];
        { const int c0 = sg * 256 + ((dir != 0) == (cc == 0) ? 128 : 0);
#pragma unroll
          for (int i = 0; i < 16; ++i) vr[i] = HGA_LD(av, c0, i); }
        float ks0[16], ks1[16]; float E0 = 1.f, E1 = 1.f;
#pragma unroll
        for (int i = 15; i >= 0; --i) { float f0, f1, k0, k1; gate_fk(bflo(zr[i]), lb0, om0, f0, k0); gate_fk(bfhi(zr[i]), lb1, om1, f1, k1); ks0[i] = k0 * E0; ks1[i] = k1 * E1; E0 *= f0; E1 *= f1; }
        *(LAS f32x2*)(lds + A_T8 + (w * 128 + 2 * kp) * 4) = (f32x2){E0, E1};
#pragma unroll
        for (int hf = 0; hf < 2; ++hf) {
            *(LAS u32x4*)(lds + A_VT + (2 * kp) * 272 + 32 * w + 16 * hf) = (u32x4){__builtin_amdgcn_perm(vr[8 * hf + 1], vr[8 * hf + 0], 0x05040100u), __builtin_amdgcn_perm(vr[8 * hf + 3], vr[8 * hf + 2], 0x05040100u), __builtin_amdgcn_perm(vr[8 * hf + 5], vr[8 * hf + 4], 0x05040100u), __builtin_amdgcn_perm(vr[8 * hf + 7], vr[8 * hf + 6], 0x05040100u)};
            *(LAS u32x4*)(lds + A_VT + (2 * kp + 1) * 272 + 32 * w + 16 * hf) = (u32x4){__builtin_amdgcn_perm(vr[8 * hf + 1], vr[8 * hf + 0], 0x07060302u), __builtin_amdgcn_perm(vr[8 * hf + 3], vr[8 * hf + 2], 0x07060302u), __builtin_amdgcn_perm(vr[8 * hf + 5], vr[8 * hf + 4], 0x07060302u), __builtin_amdgcn_perm(vr[8 * hf + 7], vr[8 * hf + 6], 0x07060302u)}; }
        if (cc == 0) { const int c0 = sg * 256 + (dir ? 0 : 128);
#pragma unroll
            for (int i = 0; i < 16; ++i) zr[i] = HGA_LD(az, c0, i); }
        LBAR();
        float fa0 = 1.f, fa1 = 1.f, d0 = 1.f, d1 = 1.f;
#pragma unroll
        for (int g = 0; g < 8; ++g) { const f32x2 t = *(LAS f32x2*)(lds + A_T8 + (g * 128 + 2 * kp) * 4); d0 *= t.x; d1 *= t.y; if (g > w) { fa0 *= t.x; fa1 *= t.y; } }
#pragma unroll
        for (int hf = 0; hf < 2; ++hf) {
            *(LAS u32x4*)(lds + A_KST + (2 * kp) * 272 + 32 * w + 16 * hf) = (u32x4){pk2(ks0[8 * hf + 0] * fa0, ks0[8 * hf + 1] * fa0), pk2(ks0[8 * hf + 2] * fa0, ks0[8 * hf + 3] * fa0), pk2(ks0[8 * hf + 4] * fa0, ks0[8 * hf + 5] * fa0), pk2(ks0[8 * hf + 6] * fa0, ks0[8 * hf + 7] * fa0)};
            *(LAS u32x4*)(lds + A_KST + (2 * kp + 1) * 272 + 32 * w + 16 * hf) = (u32x4){pk2(ks1[8 * hf + 0] * fa1, ks1[8 * hf + 1] * fa1), pk2(ks1[8 * hf + 2] * fa1, ks1[8 * hf + 3] * fa1), pk2(ks1[8 * hf + 4] * fa1, ks1[8 * hf + 5] * fa1), pk2(ks1[8 * hf + 6] * fa1, ks1[8 * hf + 7] * fa1)}; }
        if (w == 0) { *(LAS f32x2*)(lds + A_DEC + 2 * kp * 4) = (f32x2){d0, d1}; pd0 *= d0; pd1 *= d1; }
        LBAR();
        bf16x8 vf[4];
#pragma unroll
        for (int kk = 0; kk < 4; ++kk) vf[kk] = *(LAS bf16x8*)(lds + A_VT + (16 * w + r16) * 272 + (32 * kk + 8 * quad) * 2);
#pragma unroll
        for (int mh = 0; mh < 4; ++mh) {
            bf16x8 af[2][4]; f32x4 dd[2];
#pragma unroll
            for (int mi = 0; mi < 2; ++mi) { const int m = 2 * mh + mi; dd[mi] = *(LAS f32x4*)(lds + A_DEC + (16 * m + 4 * quad) * 4);
#pragma unroll
                for (int kk = 0; kk < 4; ++kk) af[mi][kk] = *(LAS bf16x8*)(lds + A_KST + (16 * m + r16) * 272 + (32 * kk + 8 * quad) * 2); }
#pragma unroll
            for (int mi = 0; mi < 2; ++mi) { const int m = 2 * mh + mi; S[m] = S[m] * dd[mi];
#pragma unroll
                for (int kk = 0; kk < 4; ++kk) S[m] = MFMA16(af[mi][kk], vf[kk], S[m]); } }
        LBAR();
    }
    u32x4* sp = (u32x4*)((unsigned char*)p.out + OUT_ST + (size_t)slot * 32768) + (w * 64 + lane) * 4;
#pragma unroll
    for (int i = 0; i < 4; ++i) sp[i] = (u32x4){pk2(S[2 * i][0], S[2 * i][1]), pk2(S[2 * i][2], S[2 * i][3]), pk2(S[2 * i + 1][0], S[2 * i + 1][1]), pk2(S[2 * i + 1][2], S[2 * i + 1][3])};
    if (w == 0) *(f32x2*)((float*)(p.ws + WS_LOGD) + slot * 128 + 2 * kp) = (f32x2){pd0, pd1};
}
__device__ __forceinline__ void hgrn_passA_item(ldsp lds, int item, int layer, const Params& p) { if (item & 1) hgrn_passA_dir<1>(lds, item, layer, p); else hgrn_passA_dir<0>(lds, item, layer, p); }

__device__ __forceinline__ void hgrn_passB(const Params& p) {
    unsigned char* ST = (unsigned char*)p.out + OUT_ST; const float* LD = (const float*)(p.ws + WS_LOGD);
    const int gt = blockIdx.x * 512 + ltid(), NT = gridDim.x * 512;
#pragma unroll 1
    for (int e = gt; e < 64 * 4096; e += NT) {
        const int chain = e >> 12, q = e & 4095, m = q & 7, ln = (q >> 3) & 63, sq = chain >> 3, h = (chain >> 1) & 3, dir = chain & 1;
        const int kd = 16 * m + 4 * (ln >> 4);
        const int seg0 = sq < 4 ? sq * 32 : 128 + (sq - 4) * 16, n = sq < 4 ? 32 : 16;
        const int sgf = dir ? seg0 + n - 1 : seg0, step = dir ? -1 : 1;
        f32x4 carry = {0.f, 0.f, 0.f, 0.f};
#pragma unroll 1
        for (int s0 = 0; s0 < n; s0 += 16) {
            u32x2 loc[16]; f32x4 dd[16];
#pragma unroll
            for (int s = 0; s < 16; ++s) { const int slot = ((sgf + step * (s0 + s)) * 4 + h) * 2 + dir; loc[s] = *(const u32x2*)(ST + (size_t)slot * 32768 + q * 8); dd[s] = *(const f32x4*)(LD + slot * 128 + kd); }
#pragma unroll
            for (int s = 0; s < 16; ++s) { const int slot = ((sgf + step * (s0 + s)) * 4 + h) * 2 + dir;
                *(u32x2*)(ST + (size_t)slot * 32768 + q * 8) = (u32x2){pk2(carry[0], carry[1]), pk2(carry[2], carry[3])};
                carry = dd[s] * carry + (f32x4){bflo(loc[s].x), bfhi(loc[s].x), bflo(loc[s].y), bfhi(loc[s].y)}; }
        }
    }
}

template <int DIR> __device__ __forceinline__ void hgrn_passC_dir(ldsp lds, int item, int layer, const Params& p) {
    const int tid = ltid(), lane = tid & 63, w = __builtin_amdgcn_readfirstlane(tid >> 6), r16 = lane & 15, quad = lane >> 4;
    const int h = item & 3, sg = item >> 2;
    const int kp = lane;
    const f32x4 gn = *(const f32x4*)(p.hgrn_g + layer * 128 + 16 * w + 4 * quad);
    constexpr int dir = DIR;
    {
        const int slot = (sg * 4 + h) * 2 + dir;
        float lb0 = 0.f, lb1 = 0.f;
        if (layer) { const float* lp = dir ? p.lb_b : p.lb_f; const f32x2 a = *(const f32x2*)(lp + 512 + h * 128 + 2 * kp), b = *(const f32x2*)(lp + h * 128 + 2 * kp); lb0 = sigmoidf_(a.x - b.x); lb1 = sigmoidf_(a.y - b.y); }
        const float om0 = 1.f - lb0, om1 = 1.f - lb1;
        f32x4 S[8];
        { const u32x4* sp = (const u32x4*)((const unsigned char*)p.out + OUT_ST + (size_t)slot * 32768) + (w * 64 + lane) * 4;
#pragma unroll
          for (int i = 0; i < 4; ++i) { const u32x4 t = sp[i]; S[2 * i] = (f32x4){bflo(t.x), bfhi(t.x), bflo(t.y), bfhi(t.y)}; S[2 * i + 1] = (f32x4){bflo(t.z), bfhi(t.z), bflo(t.w), bfhi(t.w)}; } }
        unsigned char* Pb = p.ws + WS_HQ; bf16* Y = (bf16*)(p.ws + WS_Y);
        const unsigned aq = (unsigned)h * HHEAD + kp * 4u, az = (dir ? 3u : 2u) * HARR + (unsigned)h * HHEAD + kp * 4u, av = HARR + (unsigned)h * HHEAD + kp * 4u;
        const unsigned colo = 2u * HARR + (unsigned)h * HHEAD + (16 * w + 4 * quad) * 2u;
        unsigned zr[8], qr[8], vr[8];
        { const int c0 = sg * 256 + (dir ? (SEGC - 1) : 0) * 64;
#pragma unroll
          for (int i = 0; i < 8; ++i) { zr[i] = HG_LD(az, c0, i); qr[i] = HG_LD(aq, c0, i); vr[i] = HG_LD(av, c0, i); } }
#pragma unroll 1
        for (int cc = 0; cc < SEGC; ++cc) {
            const int c0 = sg * 256 + (dir ? (SEGC - 1 - cc) : cc) * 64;
            u32x2 ofr[4], ggr[4];
            {
                float el0[8], el1[8], kk0[8], kk1[8], q0[8], q1[8]; float E0 = 1.f, E1 = 1.f;
#pragma unroll
                for (int i = 0; i < 8; ++i) { float f0, f1; gate_fk(bflo(zr[i]), lb0, om0, f0, kk0[i]); gate_fk(bfhi(zr[i]), lb1, om1, f1, kk1[i]); E0 *= f0; E1 *= f1; el0[i] = E0; el1[i] = E1; q0[i] = bflo(qr[i]); q1[i] = bfhi(qr[i]); }
                *(LAS f32x2*)(lds + H_T8 + (w * 128 + 2 * kp) * 4) = (f32x2){E0, E1};
                *(LAS u32x4*)(lds + H_VT + (2 * kp) * 144 + 16 * w) = (u32x4){__builtin_amdgcn_perm(vr[1], vr[0], 0x05040100u), __builtin_amdgcn_perm(vr[3], vr[2], 0x05040100u), __builtin_amdgcn_perm(vr[5], vr[4], 0x05040100u), __builtin_amdgcn_perm(vr[7], vr[6], 0x05040100u)};
                *(LAS u32x4*)(lds + H_VT + (2 * kp + 1) * 144 + 16 * w) = (u32x4){__builtin_amdgcn_perm(vr[1], vr[0], 0x07060302u), __builtin_amdgcn_perm(vr[3], vr[2], 0x07060302u), __builtin_amdgcn_perm(vr[5], vr[4], 0x07060302u), __builtin_amdgcn_perm(vr[7], vr[6], 0x07060302u)};
                if (cc + 1 < SEGC) { const int c1 = sg * 256 + (dir ? (SEGC - 2 - cc) : cc + 1) * 64;
#pragma unroll
                    for (int i = 0; i < 8; ++i) { zr[i] = HG_LD(az, c1, i); qr[i] = HG_LD(aq, c1, i); vr[i] = HG_LD(av, c1, i); } }
                if (dir == 1) {
#pragma unroll
                    for (int tt = 0; tt < 4; ++tt) { const int tok = c0 + 63 - (16 * tt + r16); ofr[tt] = *(const u32x2*)(Pb + ((unsigned)tok * 256u + colo)); ggr[tt] = *(const u32x2*)(Y + (size_t)tok * 1024 + PC_YC + h * 128 + 16 * w + 4 * quad); } }
                LBAR();
                f32x2 T[8], PF[9];
#pragma unroll
                for (int g = 0; g < 8; ++g) T[g] = *(LAS f32x2*)(lds + H_T8 + (g * 128 + 2 * kp) * 4);
                PF[0] = (f32x2){1.f, 1.f};
#pragma unroll
                for (int g = 0; g < 8; ++g) PF[g + 1] = PF[g] * T[g];
                f32x2 pf;
                switch (w) { case 0: pf = PF[0]; break; case 1: pf = PF[1]; break; case 2: pf = PF[2]; break; case 3: pf = PF[3]; break; case 4: pf = PF[4]; break; case 5: pf = PF[5]; break; case 6: pf = PF[6]; break; default: pf = PF[7]; break; }
                float bt0[8], bt1[8];
#pragma unroll
                for (int i = 0; i < 8; ++i) { const int tau = 8 * w + i;
                    const float e0 = pf.x * el0[i], e1 = pf.y * el1[i];
                    bt0[i] = kk0[i] * __builtin_amdgcn_rcpf(fmaxf(e0, 1e-34f)); bt1[i] = kk1[i] * __builtin_amdgcn_rcpf(fmaxf(e1, 1e-34f));
                    *(LAS unsigned*)(lds + H_QS + tau * 272 + kp * 4) = pk2(q0[i] * e0, q1[i] * e1);
                    *(LAS unsigned*)(lds + H_KD + tau * 272 + kp * 4) = pk2(bt0[i], bt1[i]); }
                *(LAS u32x4*)(lds + H_KST + (2 * kp) * 144 + 16 * w) = (u32x4){pk2(bt0[0], bt0[1]), pk2(bt0[2], bt0[3]), pk2(bt0[4], bt0[5]), pk2(bt0[6], bt0[7])};
                *(LAS u32x4*)(lds + H_KST + (2 * kp + 1) * 144 + 16 * w) = (u32x4){pk2(bt1[0], bt1[1]), pk2(bt1[2], bt1[3]), pk2(bt1[4], bt1[5]), pk2(bt1[6], bt1[7])};
                if (w == 4) *(LAS f32x2*)(lds + H_DEC + 2 * kp * 4) = PF[8];
                LBAR();
            }
            if (w < 4) score_tile(lds, H_QS + 16 * w * 272, H_KD + 16 * w * 272, w, w, true, r16, quad);
            else if (w < 7) score_tile(lds, H_QS + 16 * (w - 3) * 272, H_KD + 16 * (w - 4) * 272, w - 3, w - 4, false, r16, quad);
            else score_tile(lds, H_QS + 32 * 272, H_KD, 2, 0, false, r16, quad);
            if (w == 0) score_tile(lds, H_QS + 48 * 272, H_KD + 16 * 272, 3, 1, false, r16, quad);
            if (w == 1) score_tile(lds, H_QS + 48 * 272, H_KD, 3, 0, false, r16, quad);
            if (w == 2) *(LAS u32x2*)(lds + H_SC + (r16) * 144 + (16 + 4 * quad) * 2) = (u32x2){0u, 0u};
            if (w == 3) *(LAS u32x2*)(lds + H_SC + (32 + r16) * 144 + (48 + 4 * quad) * 2) = (u32x2){0u, 0u};
            f32x4 o[4];
            bf16x8 sa[4];
#pragma unroll
            for (int pp = 0; pp < 4; ++pp) sa[pp] = mk8(pk2(S[2 * pp][0], S[2 * pp][1]), pk2(S[2 * pp][2], S[2 * pp][3]), pk2(S[2 * pp + 1][0], S[2 * pp + 1][1]), pk2(S[2 * pp + 1][2], S[2 * pp + 1][3]));
#pragma unroll
            for (int tt = 0; tt < 4; ++tt) { o[tt] = (f32x4){0.f, 0.f, 0.f, 0.f};
                u32x2 qb[4][2];
#pragma unroll
                for (int pp = 0; pp < 4; ++pp) { qb[pp][0] = *(LAS u32x2*)(lds + H_QS + (16 * tt + r16) * 272 + (32 * pp + 4 * quad) * 2); qb[pp][1] = *(LAS u32x2*)(lds + H_QS + (16 * tt + r16) * 272 + (32 * pp + 16 + 4 * quad) * 2); }
#pragma unroll
                for (int pp = 0; pp < 4; ++pp) o[tt] = MFMA16(sa[pp], mk8(qb[pp][0].x, qb[pp][0].y, qb[pp][1].x, qb[pp][1].y), o[tt]); }
            LBAR();
            bf16x8 vf[2];
#pragma unroll
            for (int kk = 0; kk < 2; ++kk) vf[kk] = *(LAS bf16x8*)(lds + H_VT + (16 * w + r16) * 144 + (32 * kk + 8 * quad) * 2);
            bf16x8 scf[4][2];
#pragma unroll
            for (int tt = 0; tt < 4; ++tt)
#pragma unroll
                for (int kk = 0; kk < 2; ++kk) { if (kk == 1 && tt < 2) continue; scf[tt][kk] = *(LAS bf16x8*)(lds + H_SC + (16 * tt + r16) * 144 + (32 * kk + 8 * quad) * 2); }
#pragma unroll
            for (int tt = 0; tt < 4; ++tt)
#pragma unroll
                for (int kk = 0; kk < 2; ++kk) { if (kk == 1 && tt < 2) continue; o[tt] = MFMA16(vf[kk], scf[tt][kk], o[tt]); }
#pragma unroll
            for (int mh = 0; mh < 2; ++mh) {
                bf16x8 af[4][2]; f32x4 dd[4];
#pragma unroll
                for (int mi = 0; mi < 4; ++mi) { const int m = 4 * mh + mi;
#pragma unroll
                    for (int kk = 0; kk < 2; ++kk) af[mi][kk] = *(LAS bf16x8*)(lds + H_KST + (16 * m + r16) * 144 + (32 * kk + 8 * quad) * 2);
                    dd[mi] = *(LAS f32x4*)(lds + H_DEC + (16 * m + 4 * quad) * 4); }
#pragma unroll
                for (int mi = 0; mi < 4; ++mi) { const int m = 4 * mh + mi;
#pragma unroll
                    for (int kk = 0; kk < 2; ++kk) S[m] = MFMA16(af[mi][kk], vf[kk], S[m]);
                    S[m] = S[m] * dd[mi]; } }
            if (dir == 0) {
#pragma unroll
                for (int tt = 0; tt < 4; ++tt) { const int tok = c0 + 16 * tt + r16; u32x2 ov; ov.x = pk2(o[tt][0], o[tt][1]); ov.y = pk2(o[tt][2], o[tt][3]);
                    *(u32x2*)(Pb + ((unsigned)tok * 256u + colo)) = ov; }
                LBAR();
            } else {
#pragma unroll
                for (int tt = 0; tt < 4; ++tt) { const int tok = c0 + 63 - (16 * tt + r16);
                    const u32x2 of = ofr[tt];
                    o[tt][0] += bflo(of.x); o[tt][1] += bfhi(of.x); o[tt][2] += bflo(of.y); o[tt][3] += bfhi(of.y);
                    float ss = (o[tt][0] * o[tt][0] + o[tt][1] * o[tt][1]) + (o[tt][2] * o[tt][2] + o[tt][3] * o[tt][3]);
                    ss += __shfl_xor(ss, 16); ss += __shfl_xor(ss, 32);
                    if (quad == 0) *(LAS float*)(lds + H_OS + (w * 64 + 16 * tt + r16) * 4) = ss; }
                LBAR();
#pragma unroll
                for (int tt = 0; tt < 4; ++tt) { const int tau = 16 * tt + r16, tok = c0 + 63 - tau; float tot = 0.f;
#pragma unroll
                    for (int ww = 0; ww < 8; ++ww) tot += *(LAS float*)(lds + H_OS + (ww * 64 + tau) * 4);
                    const float rs = __builtin_amdgcn_rsqf(tot * (1.f / 128.f) + EPS);
                    bf16* gp = Y + (size_t)tok * 1024 + PC_YC + h * 128 + 16 * w + 4 * quad; const u32x2 g = ggr[tt]; u32x2 ov;
                    ov.x = pk2(o[tt][0] * rs * gn[0] * bflo(g.x), o[tt][1] * rs * gn[1] * bfhi(g.x)); ov.y = pk2(o[tt][2] * rs * gn[2] * bflo(g.y), o[tt][3] * rs * gn[3] * bfhi(g.y));
                    *(u32x2*)gp = ov; }
            }
        }
        __syncthreads();
    }
}
__device__ __forceinline__ void hgrn_passC_item(ldsp lds, int item, int layer, const Params& p) { hgrn_passC_dir<0>(lds, item, layer, p); hgrn_passC_dir<1>(lds, item, layer, p); }

#define XB_TMO      128
#define XB_XCNT(j)  (256  + 64 * (j))
#define XB_XSUB(j)  (1280 + 64 * (j))
#define XB_XGEN(j)  (2304 + 64 * (j))
#define XB_TOP      3328
#define XB_TOPGEN   3392
#define XCD_BAR_WORDS 3456
#define XB_SPIN_CAP (1u << 18)

__device__ __forceinline__ unsigned xb_ld(unsigned* p)              { return __hip_atomic_load(p, __ATOMIC_RELAXED, __HIP_MEMORY_SCOPE_AGENT); }
__device__ __forceinline__ unsigned xb_add(unsigned* p, unsigned v) { return __hip_atomic_fetch_add(p, v, __ATOMIC_RELAXED, __HIP_MEMORY_SCOPE_AGENT); }
__device__ __forceinline__ unsigned xb_xcc_id() { return (unsigned)__builtin_amdgcn_s_getreg((3 << 11) | 20) & 0xFu; }
#define XB_SPIN(cond, bar) do { unsigned _sp = 0; while (cond) { __builtin_amdgcn_s_sleep(1); \
    if ((++_sp & 255u) == 0u) { if (xb_ld(&(bar)[XB_TMO])) break; if (_sp > XB_SPIN_CAP) { atomicAdd(&(bar)[XB_TMO], 1u); break; } } } } while (0)

struct XcdBarrier {
    unsigned* bar; unsigned x;
    volatile LAS unsigned* st;
};

__device__ __forceinline__ XcdBarrier xcd_barrier_post(unsigned* bar, volatile LAS unsigned* st) {
    XcdBarrier b; b.bar = bar; b.x = xb_xcc_id(); b.st = st;
    if (ltid() == 0) (void)xb_add(&bar[XB_XCNT(b.x)], 1u);
    return b;
}
__device__ __forceinline__ void xcd_barrier_complete(unsigned* bar, unsigned x, unsigned& nloc, unsigned& nx) {
    const unsigned G = gridDim.x * gridDim.y * gridDim.z;
    unsigned sum, cnt, mine, sp = 0u;
    for (;;) {
        sum = 0u; cnt = 0u; mine = 0u;
#pragma unroll
        for (unsigned j = 0; j < 16; ++j) { const unsigned c = xb_ld(&bar[XB_XCNT(j)]); sum += c; cnt += (c > 0u) ? 1u : 0u; mine = (j == x) ? c : mine; }
        if (sum == G) break;
        __builtin_amdgcn_s_sleep(1);
        if ((++sp & 255u) == 0u) { if (xb_ld(&bar[XB_TMO])) break; if (sp > XB_SPIN_CAP) { atomicAdd(&bar[XB_TMO], 1u); break; } }
    }
    nloc = mine > 0u ? mine : 1u; nx = cnt > 0u ? cnt : 1u;
}

__device__ __forceinline__ void xcd_barrier(const XcdBarrier& b) {
    asm volatile("s_waitcnt vmcnt(0)" ::: "memory");
    __syncthreads();
    if (ltid() == 0) {
        unsigned* bar = b.bar;
        __builtin_amdgcn_s_waitcnt(0);
        unsigned nloc = b.st[0], nx = b.st[1];
        if (nloc == 0u) { xcd_barrier_complete(bar, b.x, nloc, nx); b.st[0] = nloc; b.st[1] = nx; }
        const unsigned old = xb_add(&bar[XB_XSUB(b.x)], 1u);
        const unsigned gen = old / nloc;
        if (old + 1u == (gen + 1u) * nloc) {
            __builtin_amdgcn_fence(__ATOMIC_RELEASE, "agent");
            asm volatile("s_waitcnt vmcnt(0)" ::: "memory");
            const unsigned og = xb_add(&bar[XB_TOP], 1u);
            const unsigned tg = og / nx;
            if (og + 1u == (tg + 1u) * nx) xb_add(&bar[XB_TOPGEN], 1u);
            else XB_SPIN(xb_ld(&bar[XB_TOPGEN]) == tg, bar);
            __builtin_amdgcn_fence(__ATOMIC_ACQUIRE, "agent");
            xb_add(&bar[XB_XGEN(b.x)], 1u);
            asm volatile("s_waitcnt vmcnt(0)" ::: "memory");
        } else {
            XB_SPIN(xb_ld(&bar[XB_XGEN(b.x)]) == gen, bar);
            __builtin_amdgcn_fence(__ATOMIC_ACQUIRE, "agent");
            asm volatile("s_waitcnt vmcnt(0)" ::: "memory");
        }
    }
    __syncthreads();
}


__global__ void __launch_bounds__(512, 2) fwd_kernel(Params p) {
    extern __shared__ __attribute__((aligned(16))) unsigned char lds_raw[];
    ldsp lds = (ldsp)lds_raw;
    cg::grid_group grid = cg::this_grid();
    unsigned char* ws = p.ws;
    bf16* XB = (bf16*)(ws + WS_XB); float* part = (float*)(ws + WS_PART);
    const int G = gridDim.x, bx = blockIdx.x;
    const int vbx = (G & 7) == 0 ? (bx & 7) * (G >> 3) + (bx >> 3) : bx;
    if (ltid() < 2) *(LAS unsigned*)(lds + LDS_BARST + 4 * ltid()) = 0u;
    __syncthreads();
    const XcdBarrier xbar = xcd_barrier_post((unsigned*)(ws + WS_BAR), (volatile LAS unsigned*)(lds + LDS_BARST));
#pragma unroll 1
    for (int ph = p.ph_lo; ph < p.ph_hi; ++ph) {
        if (ph == 0) prologue(lds, p);
        else if (ph == NPH - 1) final_norm(p);
        else {
            const int layer = (ph - 1) / 5, sub = (ph - 1) % 5;
            if (sub == 0) {
                pg8::Gemm g{layer == 0 ? XB : (const bf16*)p.out, (const bf16*)(ws + WS_BT1) + (size_t)layer * DIN * D, M, DIN, D, D}; pg8::StaticOrder S; S.init(M, DIN, G, bx);
                Epi1 E{ws, part};
                pg8::gemm_phase<Epi1, pg8::StaticOrder, true, true>(lds, g, S, E);
            } else if (sub == 1) {
                for (int it = vbx; it < NSEG * 8; it += G) hgrn_passA_item(lds, it, layer, p);
            } else if (sub == 2) {
                hgrn_passB(p);
                { const int t_ = ltid(); if (t_ < 256) { *(LAS float*)(lds + L_LNP + 4 * t_) = p.conv_ln_g[layer * 256 + t_]; *(LAS float*)(lds + L_LNP + 1024 + 4 * t_) = p.conv_ln_b[layer * 256 + t_];
                      *(LAS float*)(lds + L_LNP + 2048 + 4 * t_) = p.sgu_ln_g[layer * 256 + t_]; *(LAS float*)(lds + L_LNP + 3072 + 4 * t_) = p.sgu_ln_b[layer * 256 + t_]; } }
                { f32x2 w2[31]; const int cp = ltid() & 127; const float* cw = p.conv_w + layer * 31 * 256;
#pragma unroll
                  for (int j = 0; j < 31; ++j) w2[j] = *(const f32x2*)(cw + j * 256 + 2 * cp);
                  const f32x2 bb2 = *(const f32x2*)(p.conv_b + layer * 256 + 2 * cp);
                  for (int it = vbx; it < 768; it += G) conv_item(lds, it, layer, p, w2, bb2); }
                for (int it = vbx; it < 768; it += G) sgu_item(lds, it, layer, p);
            } else if (sub == 3) {
                for (int it = bx; it < NSEG * 4; it += G) hgrn_passC_item(lds, it, layer, p);
            } else {
                pg8::Gemm g{(const bf16*)(ws + WS_Y), (const bf16*)(ws + WS_BT2) + (size_t)layer * D * D, M, D, D, D}; pg8::StaticOrder S; S.init(M, D, G, bx);
                Epi2 E{p.xp, p.xs, M0, layer == 0 ? (const bf16*)XB : (const bf16*)p.out, nullptr, layer == 0 ? (bf16*)p.out : XB, part};
                pg8::gemm_phase<Epi2, pg8::StaticOrder, true, true>(lds, g, S, E);
            }
        }
        if (ph + 1 < p.ph_hi) { if (p.ph_hi > NPH) grid.sync();
                                xcd_barrier(xbar); }
    }
}

extern "C" void kernel_launch(void* const* d_in, const int* in_sizes, int n_in, void* d_out, int out_size, void* d_ws, size_t ws_size, hipStream_t stream) {
    static int grid = 0;
    if (grid == 0) {
        if (n_in != 18 || out_size != M * D || ws_size < WS_END) { fprintf(stderr, "kernel_launch: unexpected shapes (n_in %d out %d ws %zu)\n", n_in, out_size, ws_size); grid = -1; return; }
        int dev = 0, cus = 0, per_cu = 0;
        hipGetDevice(&dev); hipDeviceGetAttribute(&cus, hipDeviceAttributeMultiprocessorCount, dev);
        hipFuncSetAttribute((const void*)fwd_kernel, hipFuncAttributeMaxDynamicSharedMemorySize, LDS_BYTES);
        if (hipOccupancyMaxActiveBlocksPerMultiprocessor(&per_cu, (const void*)fwd_kernel, 512, LDS_BYTES) != hipSuccess || per_cu < 1) per_cu = 1;
        (void)hipGetLastError();
        grid = cus * per_cu;
    }
    if (grid < 0) return;
    Params p{};
    const float** pp = (const float**)&p;
    for (int i = 0; i < 18; ++i) pp[i] = (const float*)d_in[i];
    p.out = (float*)d_out; p.ws = (unsigned char*)d_ws;
    if (hipMemsetAsync((char*)d_ws + WS_BAR, 0, 16384, stream) != hipSuccess) { fprintf(stderr, "kernel_launch: memset of the barrier words failed\n"); return; }
#if ONE_LAUNCH
    p.ph_lo = 0; p.ph_hi = NPH;
    void* args[] = {&p};
    hipError_t e = hipLaunchCooperativeKernel((const void*)fwd_kernel, dim3(grid), dim3(512), args, LDS_BYTES, stream);
    if (e != hipSuccess) fprintf(stderr, "cooperative launch failed: %s (grid %d)\n", hipGetErrorString(e), grid);
#else
    for (int ph = 0; ph < NPH; ++ph) { p.ph_lo = ph; p.ph_hi = ph + 1; hipLaunchKernelGGL(fwd_kernel, dim3(grid), dim3(512), LDS_BYTES, stream, p); }
#endif
}
```

```cpp
#include <hip/hip_runtime.h>
#include <hip/hip_cooperative_groups.h>
#include <cstdio>
#include <cstdint>
namespace cg = cooperative_groups;

__device__ __forceinline__ int ltid() { int t = threadIdx.x; asm volatile("" : "+v"(t)); return t; }
namespace pg8 {
#define PG8_LAS __attribute__((address_space(3)))
typedef unsigned short bf16_t;
typedef short bf16x8 __attribute__((ext_vector_type(8)));
typedef float f32x4 __attribute__((ext_vector_type(4)));
typedef unsigned u32x4 __attribute__((ext_vector_type(4)));
constexpr int BM = 256, BK = 64, HALF = 128, HTB = HALF * BK * 2  , STAGE_BYTES = 8 * HTB, NXCD = 8, WGM = 8;

__host__ __device__ __forceinline__ int lds_byte(int r, int c) { const int st = (r >> 4) * 2 + (c >> 5), rr = r & 15, cc = c & 31, ob = rr * 64 + cc * 2; return st * 1024 + (ob ^ (((ob >> 9) & 1) << 5)); }
__host__ __device__ __forceinline__ void stage_rc(int b, int& R, int& C) { const int st = b / 1024, sb = b % 1024, swz = sb ^ (((sb >> 9) & 1) << 5); R = (st >> 1) * 16 + swz / 64; C = (st & 1) * 32 + (swz % 64) / 2; }
__host__ __device__ __forceinline__ int perm32(int rho) { const int n = rho >> 4, i = rho & 15; return 8 * (i >> 2) + 4 * n + (i & 3); }

struct Unit { int pm, pn; };
struct Gemm { const bf16_t* A; const bf16_t* Bt; int M, N, K, lda; };

struct StaticOrder {
    int nM, nN, nwg, G, c;
    __host__ __device__ void init(int M, int N, int G_, int c_) { nM = M / BM; nN = N / BM; nwg = nM * nN; G = G_; c = c_; }
    __host__ __device__ bool next(int i, Unit& u) const {
        const long L = (long)i * G + c; if (L >= nwg) return false;
        int wgid = (int)L; { const int q = nwg / NXCD, r = nwg % NXCD, xcd = wgid % NXCD, off = wgid / NXCD; wgid = (xcd < r ? xcd * (q + 1) : r * (q + 1) + (xcd - r) * q) + off; }
        const int nig = WGM * nN, gid = wgid / nig, fm = gid * WGM, gsz = (nM - fm) < WGM ? (nM - fm) : WGM;
        u.pm = fm + ((wgid % nig) % gsz); u.pn = (wgid % nig) / gsz; return true;
    }
    __device__ __forceinline__ void a_ready(const Unit&) const {}
    __device__ __forceinline__ void done(const Unit&) const {}
};

typedef float f32x2 __attribute__((ext_vector_type(2)));
__device__ __forceinline__ f32x2 gelu_pk(f32x2 v) {
    const f32x2 av = __builtin_elementwise_abs(v), d = av * 0.2316418882f + 1.0f;
    f32x2 t; t.x = __builtin_amdgcn_rcpf(d.x); t.y = __builtin_amdgcn_rcpf(d.y);
    f32x2 q = t * 0.5307027145f + (-0.7265760135f); q = q * t + 0.7107068705f; q = q * t + (-0.142248368f); q = q * t + 0.127414796f; q = q * t;
    const f32x2 s = (v * v) * (-0.72134752044f);
    f32x2 e; e.x = __builtin_amdgcn_exp2f(s.x); e.y = __builtin_amdgcn_exp2f(s.y);
    const f32x2 m = v * (q * e), r = v - m;
    f32x2 o; o.x = v.x < 0.f ? m.x : r.x; o.y = v.y < 0.f ? m.y : r.y; return o;
}

template <class Epi, class Sched, bool ALIGN_EPI = false, bool SP2 = false>
__device__ __forceinline__ void gemm_phase(PG8_LAS unsigned char* lds, const Gemm g, const Sched& S, const Epi& E) {
    const int tid = ltid(), wid = __builtin_amdgcn_readfirstlane(tid >> 6), lane = tid & 63, wr = wid >> 2, wc = wid & 3, fr = lane & 15, fq = lane >> 4;
    const int K = g.K, nt = K / BK;
    unsigned voffA[2], voffB[2];
#pragma unroll
    for (int i = 0; i < 2; ++i) { int R, C; stage_rc(tid * 16 + i * 8192, R, C); const int Rb = Epi::PERM ? ((R & ~31) + perm32(R & 31)) : R;
        voffA[i] = (unsigned)(R * g.lda + C) * 2u; voffB[i] = (unsigned)(Rb * K + C) * 2u; }
    const size_t kstep = (size_t)(BK * 2);
    const size_t hstepB = (size_t)HALF * K * 2, hstepA = (size_t)HALF * g.lda * 2;
    const size_t tstepA = 2 * hstepA, tstepB = 2 * hstepB;
    const unsigned ldsw = (unsigned)wid * 1024u;
    const int aoff = lds_byte(wr * 64 + fr, fq * 8), boff = lds_byte(wc * 32 + fr, fq * 8);
#define PG8_SA(b, h) (((b) * 2 + (h)) * HTB)
#define PG8_SB(b, h) ((4 + (b) * 2 + (h)) * HTB)
#define PG8_STAGE(bufoff, gbase, voff) do { _Pragma("unroll") for (int _i = 0; _i < 2; ++_i) \
        __builtin_amdgcn_global_load_lds((const unsigned*)((const char*)(gbase) + (voff)[_i]), (PG8_LAS unsigned*)(lds + (bufoff) + ldsw + _i * 8192), 16, 0, 0); } while (0)
#define PG8_LDA(dst, b, h) do { _Pragma("unroll") for (int m = 0; m < 4; ++m) _Pragma("unroll") for (int k = 0; k < 2; ++k) dst[m][k] = *(const PG8_LAS bf16x8*)(lds + PG8_SA(b, h) + aoff + m * 2048 + k * 1024); } while (0)
#define PG8_LDB(dst, b, h) do { _Pragma("unroll") for (int n = 0; n < 2; ++n) _Pragma("unroll") for (int k = 0; k < 2; ++k) dst[n][k] = *(const PG8_LAS bf16x8*)(lds + PG8_SB(b, h) + boff + n * 2048 + k * 1024); } while (0)
#define PG8_MMA(ai, bj, At, Bt) do { __builtin_amdgcn_s_setprio(1); _Pragma("unroll") for (int m = 0; m < 4; ++m) _Pragma("unroll") for (int n = 0; n < 2; ++n) _Pragma("unroll") for (int k = 0; k < 2; ++k) \
        acc[ai][bj][m][n] = __builtin_amdgcn_mfma_f32_16x16x32_bf16(Bt[n][k], At[m][k], acc[ai][bj][m][n], 0, 0, 0); __builtin_amdgcn_s_setprio(0); } while (0)
#define PG8_WAIT_V(n) asm volatile("s_waitcnt vmcnt(" #n ")" ::: "memory")
#define PG8_WAIT_L(n) asm volatile("s_waitcnt lgkmcnt(" #n ")" ::: "memory")
#define PG8_BAR __builtin_amdgcn_s_barrier()
#define PG8_SCHED __builtin_amdgcn_sched_barrier(0)
    Unit cur, nxt; int ui = 0;
    if (!S.next(0, cur)) return;
    f32x4 acc[2][2][4][2];
#pragma unroll
    for (int a = 0; a < 2; ++a)
#pragma unroll
        for (int b = 0; b < 2; ++b)
#pragma unroll
            for (int m = 0; m < 4; ++m)
#pragma unroll
                for (int n = 0; n < 2; ++n) acc[a][b][m][n] = (f32x4){0.f, 0.f, 0.f, 0.f};
    bf16x8 At[4][2], B0[2][2], B1[2][2];
    const char* cA = (const char*)g.A + (size_t)cur.pm * tstepA; const char* cB = (const char*)g.Bt + (size_t)cur.pn * tstepB;
    S.a_ready(cur);
    if constexpr (SP2) {
        PG8_STAGE(PG8_SB(0, 0), cB, voffB); PG8_STAGE(PG8_SB(0, 1), cB + hstepB, voffB); PG8_STAGE(PG8_SA(0, 0), cA, voffA); PG8_STAGE(PG8_SA(0, 1), cA + hstepA, voffA);
        if (wr == 1) PG8_BAR;
        PG8_WAIT_V(2); PG8_BAR;
        PG8_STAGE(PG8_SB(1, 0), cB + kstep, voffB); PG8_STAGE(PG8_SA(1, 0), cA + kstep, voffA); PG8_STAGE(PG8_SB(1, 1), cB + hstepB + kstep, voffB);
        PG8_WAIT_V(6); PG8_BAR;
    } else {
        PG8_STAGE(PG8_SB(0, 0), cB, voffB); PG8_STAGE(PG8_SA(0, 0), cA, voffA); PG8_STAGE(PG8_SB(0, 1), cB + hstepB, voffB); PG8_STAGE(PG8_SA(0, 1), cA + hstepA, voffA);
        if (wr == 1) PG8_BAR;
        PG8_WAIT_V(4); PG8_BAR;
        PG8_STAGE(PG8_SB(1, 0), cB + kstep, voffB); PG8_STAGE(PG8_SA(1, 0), cA + kstep, voffA); PG8_STAGE(PG8_SB(1, 1), cB + hstepB + kstep, voffB);
        PG8_WAIT_V(6); PG8_BAR;
    }
    for (;;) {
        const bool has_next = S.next(ui + 1, nxt);
        const char* nA = has_next ? (const char*)g.A + (size_t)nxt.pm * tstepA : cA; const char* nB = has_next ? (const char*)g.Bt + (size_t)nxt.pn * tstepB : cB;
        for (int t = 0; t < nt; t += 2) {
            const bool last = (t == nt - 2);
            const char* a1 = cA + (size_t)(t + 1) * kstep;
            const char* a2 = last ? nA : cA + (size_t)(t + 2) * kstep; const char* b2 = last ? nB : cB + (size_t)(t + 2) * kstep;
            const char* a3 = a2 + kstep; const char* b3 = b2 + kstep;
            if (last && has_next) S.a_ready(nxt);
            if constexpr (SP2) {
            PG8_LDB(B0, 0, 0); PG8_LDB(B1, 0, 1); PG8_SCHED; PG8_LDA(At, 0, 0); PG8_STAGE(PG8_SA(1, 1), a1 + hstepA, voffA);
            PG8_WAIT_V(8); PG8_WAIT_L(0); PG8_BAR; PG8_MMA(0, 0, At, B0); PG8_MMA(0, 1, At, B1); PG8_BAR; PG8_SCHED;
            PG8_LDA(At, 0, 1); PG8_STAGE(PG8_SB(0, 0), b2, voffB); PG8_STAGE(PG8_SB(0, 1), b2 + hstepB, voffB); PG8_STAGE(PG8_SA(0, 0), a2, voffA);
            PG8_WAIT_V(8); PG8_WAIT_L(0); PG8_BAR; PG8_MMA(1, 0, At, B0); PG8_MMA(1, 1, At, B1); PG8_BAR; PG8_SCHED;
            PG8_LDB(B0, 1, 0); PG8_LDB(B1, 1, 1); PG8_SCHED; PG8_LDA(At, 1, 0); PG8_STAGE(PG8_SA(0, 1), a2 + hstepA, voffA);
            PG8_WAIT_V(8); PG8_WAIT_L(0); PG8_BAR; PG8_MMA(0, 0, At, B0); PG8_MMA(0, 1, At, B1); PG8_BAR; PG8_SCHED;
            PG8_LDA(At, 1, 1); PG8_STAGE(PG8_SB(1, 0), b3, voffB); PG8_STAGE(PG8_SB(1, 1), b3 + hstepB, voffB); PG8_STAGE(PG8_SA(1, 0), a3, voffA);
            PG8_WAIT_V(8); PG8_WAIT_L(0); PG8_BAR; PG8_MMA(1, 0, At, B0); PG8_MMA(1, 1, At, B1); PG8_BAR; PG8_SCHED;
            } else {
            PG8_LDB(B0, 0, 0); PG8_SCHED; PG8_LDA(At, 0, 0); PG8_STAGE(PG8_SA(1, 1), a1 + hstepA, voffA);
            PG8_WAIT_L(8); PG8_BAR; PG8_WAIT_L(0); PG8_MMA(0, 0, At, B0); PG8_BAR; PG8_SCHED;
            PG8_LDB(B1, 0, 1); PG8_STAGE(PG8_SB(0, 0), b2, voffB);
            PG8_BAR; PG8_WAIT_L(0); PG8_MMA(0, 1, At, B1); PG8_BAR;
            PG8_LDA(At, 0, 1); PG8_STAGE(PG8_SA(0, 0), a2, voffA);
            PG8_BAR; PG8_WAIT_L(0); PG8_MMA(1, 0, At, B0); PG8_BAR; PG8_SCHED;
            PG8_STAGE(PG8_SB(0, 1), b2 + hstepB, voffB);
            PG8_WAIT_V(6); PG8_BAR; PG8_MMA(1, 1, At, B1); PG8_BAR;
            PG8_LDB(B0, 1, 0); PG8_SCHED; PG8_LDA(At, 1, 0); PG8_STAGE(PG8_SA(0, 1), a2 + hstepA, voffA);
            PG8_WAIT_L(8); PG8_BAR; PG8_WAIT_L(0); PG8_MMA(0, 0, At, B0); PG8_BAR; PG8_SCHED;
            PG8_LDB(B1, 1, 1); PG8_STAGE(PG8_SB(1, 0), b3, voffB);
            PG8_BAR; PG8_WAIT_L(0); PG8_MMA(0, 1, At, B1); PG8_BAR;
            PG8_LDA(At, 1, 1); PG8_STAGE(PG8_SA(1, 0), a3, voffA);
            PG8_BAR; PG8_WAIT_L(0); PG8_MMA(1, 0, At, B0); PG8_BAR; PG8_SCHED;
            PG8_STAGE(PG8_SB(1, 1), b3 + hstepB, voffB);
            PG8_WAIT_V(6); PG8_BAR; PG8_MMA(1, 1, At, B1); PG8_BAR;
            }
        }
        if constexpr (ALIGN_EPI) { if (wr == 0) PG8_BAR; }
        if constexpr (!Epi::AFTER_DRAIN) { E(acc, cur, wr, wc, fr, fq); S.done(cur); }
        if (!has_next) break;
#pragma unroll
        for (int a = 0; a < 2; ++a)
#pragma unroll
            for (int b = 0; b < 2; ++b)
#pragma unroll
                for (int m = 0; m < 4; ++m)
#pragma unroll
                    for (int n = 0; n < 2; ++n) acc[a][b][m][n] = (f32x4){0.f, 0.f, 0.f, 0.f};
        cur = nxt; cA = nA; cB = nB; ++ui;
        if constexpr (ALIGN_EPI) { if (wr == 1) PG8_BAR; }
    }
    PG8_WAIT_V(0);
    if constexpr (!ALIGN_EPI) { if (wr == 0) PG8_BAR; }
    PG8_BAR;
    if constexpr (Epi::AFTER_DRAIN) { E.fused(acc, cur, wr, wc, fr, fq, lds, wid, lane); S.done(cur); }
#undef PG8_SA
#undef PG8_SB
#undef PG8_STAGE
#undef PG8_LDA
#undef PG8_LDB
#undef PG8_MMA
#undef PG8_WAIT_V
#undef PG8_WAIT_L
#undef PG8_BAR
#undef PG8_SCHED
}
}

#ifndef ONE_LAUNCH
#define ONE_LAUNCH 1
#endif
#define LAS __attribute__((address_space(3)))
typedef unsigned short bf16;
typedef unsigned u32x4 __attribute__((ext_vector_type(4)));
typedef unsigned u32x2 __attribute__((ext_vector_type(2)));
typedef float f32x4 __attribute__((ext_vector_type(4)));
typedef float f32x2 __attribute__((ext_vector_type(2)));
typedef short bf16x8 __attribute__((ext_vector_type(8)));
typedef __bf16 bf16x2_t __attribute__((ext_vector_type(2)));
typedef LAS unsigned char* ldsp;

constexpr int M = 49152, M0 = 32768, D = 1024, DIN = 4096;
constexpr float EPS = 1e-6f;
constexpr int PC_YA = 0, PC_YB = 256, PC_YC = 512;
constexpr int NSEG = 192, SEGC = 4;
constexpr size_t MiB = 1u << 20;
constexpr size_t WS_PART = 0, WS_LOGD = 3 * MiB, WS_BT1 = 4 * MiB, WS_BT2 = 20 * MiB, WS_PWT = 24 * MiB, WS_SGW = 24 * MiB + 256 * 1024;
constexpr size_t OUT_ST = 96 * MiB;
constexpr size_t WS_XB = 26 * MiB, WS_Y = 122 * MiB, WS_GLU = 218 * MiB, WS_BU = 242 * MiB, WS_BV = 266 * MiB, WS_HQ = 290 * MiB, WS_END = 482 * MiB;
constexpr unsigned HARR = 48u << 20, HHEAD = (unsigned)M * 256u;
constexpr int LDS_BYTES = 147456, LDS_BARST = 145408;
constexpr size_t WS_BAR = 3 * MiB + 896 * 1024;
constexpr int NPH = 12;

struct Params {
    const float *xp, *xs, *norm_g, *w_in, *conv_w, *conv_b, *conv_ln_g, *conv_ln_b, *conv_pw, *sgu_ln_g, *sgu_ln_b, *sgu_w, *sgu_b, *lb_f, *lb_b, *hgrn_g, *w_out, *final_g;
    float* out; unsigned char* ws; int ph_lo, ph_hi;
};

__device__ __forceinline__ float bf2f(bf16 b) { return __uint_as_float((unsigned)b << 16); }
__device__ __forceinline__ float bflo(unsigned w) { return __uint_as_float(w << 16); }
__device__ __forceinline__ float bfhi(unsigned w) { return __uint_as_float(w & 0xffff0000u); }
__device__ __forceinline__ unsigned pk2(float lo, float hi) { f32x2 v = {lo, hi}; bf16x2_t b = __builtin_convertvector(v, bf16x2_t); return __builtin_bit_cast(unsigned, b); }
__device__ __forceinline__ bf16 f2bf(float x) { return (bf16)(pk2(x, 0.f) & 0xffffu); }
__device__ __forceinline__ float sigmoidf_(float x) { return __builtin_amdgcn_rcpf(1.f + __expf(-x)); }
__device__ __forceinline__ float siluf_(float x) { return x * sigmoidf_(x); }
__device__ __forceinline__ float wave_sum(float v) {
#pragma unroll
    for (int o = 1; o < 64; o <<= 1) v += __shfl_xor(v, o);
    return v;
}
__device__ __forceinline__ bf16x8 mk8(unsigned a, unsigned b, unsigned c, unsigned d) { u32x4 v = {a, b, c, d}; return __builtin_bit_cast(bf16x8, v); }
#define LBAR() asm volatile("s_waitcnt lgkmcnt(0)\n\ts_barrier" ::: "memory")
#define MFMA16(a, b, c) __builtin_amdgcn_mfma_f32_16x16x32_bf16((a), (b), (c), 0, 0, 0)

struct Epi1 {
    static constexpr bool PERM = true, AFTER_DRAIN = false;
    unsigned char* ws; const float* part;
    __device__ __forceinline__ void operator()(const pg8::f32x4 (&acc)[2][2][4][2], const pg8::Unit& u, int wr, int wc, int fr, int fq) const {
        const int row0 = u.pm * 256 + wr * 64 + fr; const int pn = u.pn;
        const int cw = wc * 32 + 8 * fq;
#pragma unroll
        for (int ai = 0; ai < 2; ++ai)
#pragma unroll
            for (int m = 0; m < 4; ++m) {
                const int r = row0 + ai * 128 + m * 16;
                float s = 0.f;
#pragma unroll
                for (int q = 0; q < 4; ++q) s += part[(size_t)(4 * fq + q) * M + r];
                s += __shfl_xor(s, 16); s += __shfl_xor(s, 32);
                const float rs = __builtin_amdgcn_rsqf(s * (1.f / D) + EPS);
                if (pn < 2) {
                    f32x4 a0 = acc[ai][0][m][0] * rs, a1 = acc[ai][0][m][1] * rs, g0 = acc[ai][1][m][0] * rs, g1 = acc[ai][1][m][1] * rs;
                    u32x4 w;
                    w.x = pk2(a0[0] * sigmoidf_(g0[0]), a0[1] * sigmoidf_(g0[1])); w.y = pk2(a0[2] * sigmoidf_(g0[2]), a0[3] * sigmoidf_(g0[3]));
                    w.z = pk2(a1[0] * sigmoidf_(g1[0]), a1[1] * sigmoidf_(g1[1])); w.w = pk2(a1[2] * sigmoidf_(g1[2]), a1[3] * sigmoidf_(g1[3]));
                    *(u32x4*)((bf16*)(ws + WS_GLU) + (size_t)r * 256 + 128 * pn + cw) = w;
                } else {
#pragma unroll
                    for (int bj = 0; bj < 2; ++bj) {
                        f32x4 v0 = acc[ai][bj][m][0] * rs, v1 = acc[ai][bj][m][1] * rs;
                        if (pn < 6) {
#pragma unroll
                            for (int e = 0; e < 4; ++e) { v0[e] = siluf_(v0[e]); v1[e] = siluf_(v1[e]); }
                        } else if (pn < 8) {
                            f32x2 a = pg8::gelu_pk((f32x2){v0[0], v0[1]}), b = pg8::gelu_pk((f32x2){v0[2], v0[3]}), c = pg8::gelu_pk((f32x2){v1[0], v1[1]}), d = pg8::gelu_pk((f32x2){v1[2], v1[3]});
                            v0 = (f32x4){a.x, a.y, b.x, b.y}; v1 = (f32x4){c.x, c.y, d.x, d.y};
                        }
                        u32x4 w; w.x = pk2(v0[0], v0[1]); w.y = pk2(v0[2], v0[3]); w.z = pk2(v1[0], v1[1]); w.w = pk2(v1[2], v1[3]);
                        bf16* dst;
                        if (pn < 6) dst = (bf16*)(ws + WS_Y) + (size_t)r * 1024 + 256 * (pn - 2) + 128 * bj + cw;
                        else if (pn < 8) dst = (bf16*)(ws + (pn == 6 ? WS_BU : WS_BV)) + (size_t)r * 256 + 128 * bj + cw;
                        else dst = (bf16*)(ws + WS_HQ + (size_t)((pn - 8) >> 1) * HARR + (size_t)(2 * ((pn - 8) & 1) + bj) * HHEAD) + (size_t)r * 128 + cw;
                        *(u32x4*)dst = w;
                    }
                }
            }
    }
};
struct Epi2 {
    static constexpr bool PERM = true, AFTER_DRAIN = false;
    const float* xin0; const float* xin1; int split; const bf16* xinb; float* xout; bf16* XB; float* part;
    __device__ __forceinline__ void operator()(const pg8::f32x4 (&acc)[2][2][4][2], const pg8::Unit& u, int wr, int wc, int fr, int fq) const {
        const int row0 = u.pm * 256 + wr * 64 + fr; const int pn = u.pn;
        const int cw = pn * 256 + wc * 32 + 8 * fq;
#pragma unroll
        for (int ai = 0; ai < 2; ++ai)
#pragma unroll
            for (int m = 0; m < 4; ++m) {
                const int r = row0 + ai * 128 + m * 16;
                const float* src = (r < split) ? xin0 + (size_t)r * D : xin1 + (size_t)(r - split) * D;
                float ss = 0.f;
#pragma unroll
                for (int bj = 0; bj < 2; ++bj) {
                    const int col = cw + 128 * bj;
                    f32x4 v0, v1;
                    if (xinb) { const u32x4 t = *(const u32x4*)(xinb + (size_t)r * D + col); v0 = (f32x4){bflo(t.x), bfhi(t.x), bflo(t.y), bfhi(t.y)}; v1 = (f32x4){bflo(t.z), bfhi(t.z), bflo(t.w), bfhi(t.w)}; }
                    else { v0 = *(const f32x4*)(src + col); v1 = *(const f32x4*)(src + col + 4); }
                    v0 = v0 + acc[ai][bj][m][0]; v1 = v1 + acc[ai][bj][m][1];
                    if (xout) { *(f32x4*)(xout + (size_t)r * D + col) = v0; *(f32x4*)(xout + (size_t)r * D + col + 4) = v1; }
                    ss += (v0[0] * v0[0] + v0[1] * v0[1]) + (v0[2] * v0[2] + v0[3] * v0[3]) + (v1[0] * v1[0] + v1[1] * v1[1]) + (v1[2] * v1[2] + v1[3] * v1[3]);
                    { u32x4 w; w.x = pk2(v0[0], v0[1]); w.y = pk2(v0[2], v0[3]); w.z = pk2(v1[0], v1[1]); w.w = pk2(v1[2], v1[3]); *(u32x4*)(XB + (size_t)r * D + col) = w; }
                }
                ss += __shfl_xor(ss, 16); ss += __shfl_xor(ss, 32);
                if (fq == 0) part[(size_t)(pn * 4 + wc) * M + r] = ss;
            }
    }
};

__device__ __forceinline__ int srcmap128(int b) {
    if (b < 4) return ((b & 1) ? 256 : 0) + 128 * (b >> 1);
    if (b < 6) return 512 + 128 * (b - 4);
    if (b < 8) return 1280 + 128 * (b - 6);
    if (b < 12) return 3584 + 128 * (b - 8);
    if (b < 14) return 768 + 128 * (b - 12);
    if (b < 16) return 1024 + 128 * (b - 14);
    if (b < 20) return 1536 + 128 * (b - 16);
    if (b < 24) return 2048 + 128 * (b - 20);
    if (b < 28) return 2560 + 128 * (b - 24);
    return 3072 + 128 * (b - 28);
}
__device__ __forceinline__ void tr_item(const float* W, int N, int sc0, const float* gk, int k0, bf16* WT, int K, int drow0, LAS float* scr, int lane) {
    float v[64];
#pragma unroll
    for (int kk = 0; kk < 64; ++kk) v[kk] = W[(size_t)(k0 + kk) * N + sc0 + lane];
    if (gk) {
#pragma unroll
        for (int kk = 0; kk < 64; ++kk) v[kk] *= gk[k0 + kk]; }
#pragma unroll
    for (int kk = 0; kk < 64; ++kk) scr[kk * 65 + lane] = v[kk];
    asm volatile("s_waitcnt lgkmcnt(0)" ::: "memory");
    const int c = lane & 7;
#pragma unroll
    for (int j = 0; j < 8; ++j) { const int n = (lane >> 3) + 8 * j; const LAS float* s = scr + (8 * c) * 65 + n;
        u32x4 o; o.x = pk2(s[0 * 65], s[1 * 65]); o.y = pk2(s[2 * 65], s[3 * 65]); o.z = pk2(s[4 * 65], s[5 * 65]); o.w = pk2(s[6 * 65], s[7 * 65]);
        *(u32x4*)(WT + (size_t)(drow0 + n) * K + k0 + 8 * c) = o; }
    asm volatile("s_waitcnt lgkmcnt(0)" ::: "memory");
}
__device__ __forceinline__ void prologue(ldsp lds, const Params& p) {
    const int tid = ltid(), lane = tid & 63, wave = __builtin_amdgcn_readfirstlane(tid >> 6);
    const int gw = blockIdx.x * 8 + wave, NGW = gridDim.x * 8;
    LAS float* scr = (LAS float*)(lds + wave * 16640);
    unsigned char* ws = p.ws;
    constexpr int I_IN = 16 * 64, I_OUT = 16 * 16, I_PW = 4 * 4, I_L = I_IN + I_OUT + I_PW;
    for (int it = gw; it < 2 * I_L; it += NGW) {
        const int l = it / I_L; int r = it - l * I_L;
        if (r < I_IN) { const int kb = r >> 6, nb = r & 63; tr_item(p.w_in + (size_t)l * D * DIN, DIN, srcmap128(nb >> 1) + 64 * (nb & 1), p.norm_g + l * D, 64 * kb, (bf16*)(ws + WS_BT1) + (size_t)l * DIN * D, D, 64 * nb, scr, lane); continue; }
        r -= I_IN;
        if (r < I_OUT) { const int kb = r >> 4, nb = r & 15; tr_item(p.w_out + (size_t)l * D * D, D, 64 * nb, nullptr, 64 * kb, (bf16*)(ws + WS_BT2) + (size_t)l * D * D, D, 64 * nb, scr, lane); continue; }
        r -= I_OUT;
        { const int kb = r >> 2, nb = r & 3; tr_item(p.conv_pw + (size_t)l * 65536, 256, 64 * nb, nullptr, 64 * kb, (bf16*)(ws + WS_PWT) + (size_t)l * 65536, 256, 64 * nb, scr, lane); }
    }
    { const int gt = blockIdx.x * 512 + tid, NT = gridDim.x * 512; bf16* o = (bf16*)(ws + WS_SGW);
      for (int i = gt; i < 2 * 4 * 128 * 128 / 4; i += NT) { const f32x4 v = *(const f32x4*)(p.sgu_w + 4 * (size_t)i); u32x2 w; w.x = pk2(v[0], v[1]); w.y = pk2(v[2], v[3]); *(u32x2*)(o + 4 * (size_t)i) = w; } }
    bf16* XB = (bf16*)(ws + WS_XB); float* part = (float*)(ws + WS_PART);
    for (int r = gw; r < M; r += 4 * NGW) {
        f32x4 v[4][4];
#pragma unroll
        for (int u = 0; u < 4; ++u) { const int rr = r + u * NGW; if (rr < M) { const float* src = (rr < M0) ? p.xp + (size_t)rr * D : p.xs + (size_t)(rr - M0) * D;
#pragma unroll
            for (int j = 0; j < 4; ++j) v[u][j] = ((const f32x4*)src)[lane + 64 * j]; } }
#pragma unroll
        for (int u = 0; u < 4; ++u) { const int rr = r + u * NGW; if (rr < M) { float s = 0.f;
            unsigned long long* o8 = (unsigned long long*)(XB + (size_t)rr * D) + lane;
#pragma unroll
            for (int j = 0; j < 4; ++j) { const f32x4 t = v[u][j]; s += (t[0] * t[0] + t[1] * t[1]) + (t[2] * t[2] + t[3] * t[3]); o8[64 * j] = (unsigned long long)pk2(t[0], t[1]) | ((unsigned long long)pk2(t[2], t[3]) << 32); }
            s = wave_sum(s);
            if (lane < 16) part[(size_t)lane * M + rr] = lane == 0 ? s : 0.f; } }
    }
}

__device__ __forceinline__ void final_norm(const Params& p) {
    const int tid = ltid(), lane = tid & 63, wave = tid >> 6;
    const int gw = blockIdx.x * 8 + wave, NGW = gridDim.x * 8;
    const float* part = (const float*)(p.ws + WS_PART);
    f32x4 g[4];
#pragma unroll
    for (int j = 0; j < 4; ++j) g[j] = *((const f32x4*)p.final_g + lane + 64 * j);
    const bf16* XB = (const bf16*)(p.ws + WS_XB);
    for (int r = gw; r < M; r += 4 * NGW) {
        u32x2 v[4][4]; float s[4];
#pragma unroll
        for (int u = 0; u < 4; ++u) { const int rr = r + u * NGW; if (rr < M) { s[u] = lane < 16 ? part[(size_t)lane * M + rr] : 0.f;
#pragma unroll
            for (int j = 0; j < 4; ++j) v[u][j] = ((const u32x2*)(XB + (size_t)rr * D))[lane + 64 * j]; } }
#pragma unroll
        for (int u = 0; u < 4; ++u) { const int rr = r + u * NGW; if (rr < M) { const float rs = __builtin_amdgcn_rsqf(wave_sum(s[u]) * (1.f / D) + EPS);
#pragma unroll
            for (int j = 0; j < 4; ++j) { const f32x4 x = {bflo(v[u][j].x), bfhi(v[u][j].x), bflo(v[u][j].y), bfhi(v[u][j].y)}; ((f32x4*)(p.out + (size_t)rr * D))[lane + 64 * j] = x * rs * g[j]; } } }
    }
}

constexpr int L_LNP = 122880;
__device__ __forceinline__ void conv_item(ldsp lds, int item, int layer, const Params& p, const f32x2 (&w2)[31], const f32x2 bb2) {
    const int tid = ltid(), lane = tid & 63, w = __builtin_amdgcn_readfirstlane(tid >> 6), r16 = lane & 15, quad = lane >> 4;
    const int r0 = item * 64;
    int s0, s1; if (r0 < M0) { s0 = r0 & ~8191; s1 = s0 + 8192; } else { s0 = M0 + ((r0 - M0) & ~4095); s1 = s0 + 4096; }
    const bf16* pwT = (const bf16*)(p.ws + WS_PWT) + (size_t)layer * 65536;
    ldsp IN = lds;
    LAS float* CV = (LAS float*)(lds + 49152);
    ldsp AO = lds;
    for (int idx = tid; idx < 94 * 32; idx += 512) { const int row = idx >> 5, c16 = idx & 31, gr = r0 - 15 + row;
        u32x4 v = {0u, 0u, 0u, 0u}; if (gr >= s0 && gr < s1) v = *(const u32x4*)((const bf16*)(p.ws + WS_GLU) + (size_t)gr * 256 + c16 * 8);
        *(LAS u32x4*)(IN + row * 512 + c16 * 16) = v; }
    u32x2 gpre[4][2];
#pragma unroll
    for (int m = 0; m < 4; ++m)
#pragma unroll
        for (int nt = 0; nt < 2; ++nt) gpre[m][nt] = *(const u32x2*)((const bf16*)(p.ws + WS_Y) + (size_t)(r0 + 16 * m + r16) * 1024 + PC_YA + 32 * w + 16 * nt + 4 * quad);
    LBAR();
    {
        const int cp = tid & 127, qtr = tid >> 7;
#pragma unroll 1
        for (int ob = 0; ob < 2; ++ob) {
            const int t0 = 16 * qtr + 8 * ob;
            f32x2 x[38];
#pragma unroll
            for (int i = 0; i < 38; ++i) { const unsigned u = *(LAS unsigned*)(IN + (t0 + i) * 512 + cp * 4); x[i] = (f32x2){bflo(u), bfhi(u)}; }
            f32x2 a0[8];
#pragma unroll
            for (int o = 0; o < 8; ++o) a0[o] = bb2;
#pragma unroll
            for (int j = 0; j < 31; ++j)
#pragma unroll
                for (int o = 0; o < 8; ++o) a0[o] = x[o + j] * w2[j] + a0[o];
#pragma unroll
            for (int o = 0; o < 8; ++o) *(LAS f32x2*)(CV + (t0 + o) * 288 + 2 * cp) = a0[o];
        }
    }
    LBAR();
    bf16x8 pwf[8][2];
#pragma unroll
    for (int kk = 0; kk < 8; ++kk) { pwf[kk][0] = *(const bf16x8*)(pwT + (size_t)(32 * w + r16) * 256 + 32 * kk + 8 * quad); pwf[kk][1] = *(const bf16x8*)(pwT + (size_t)(32 * w + 16 + r16) * 256 + 32 * kk + 8 * quad); }
    {
        const int tok = tid >> 3, part = tid & 7;
        f32x4 v[8]; float s = 0.f;
#pragma unroll
        for (int i = 0; i < 8; ++i) { v[i] = *(LAS f32x4*)(CV + tok * 288 + 32 * i + 4 * part); s += (v[i][0] + v[i][1]) + (v[i][2] + v[i][3]); }
        s += __shfl_xor(s, 1); s += __shfl_xor(s, 2); s += __shfl_xor(s, 4);
        const float mean = s * (1.f / 256.f); float q = 0.f;
#pragma unroll
        for (int i = 0; i < 8; ++i) { v[i] = v[i] - mean; q += (v[i][0] * v[i][0] + v[i][1] * v[i][1]) + (v[i][2] * v[i][2] + v[i][3] * v[i][3]); }
        q += __shfl_xor(q, 1); q += __shfl_xor(q, 2); q += __shfl_xor(q, 4);
        const float rstd = __builtin_amdgcn_rsqf(q * (1.f / 256.f) + EPS);
#pragma unroll
        for (int i = 0; i < 8; ++i) { const int c = 32 * i + 4 * part; const f32x4 gg = *(LAS f32x4*)(lds + L_LNP + c * 4), bb = *(LAS f32x4*)(lds + L_LNP + 1024 + c * 4);
            f32x4 y = v[i] * rstd * gg + bb;
            u32x2 o; o.x = pk2(siluf_(y[0]), siluf_(y[1])); o.y = pk2(siluf_(y[2]), siluf_(y[3]));
            *(LAS u32x2*)(AO + tok * 528 + c * 2) = o; }
    }
    LBAR();
    {
        f32x4 acc[4][2];
#pragma unroll
        for (int m = 0; m < 4; ++m) { acc[m][0] = (f32x4){0.f, 0.f, 0.f, 0.f}; acc[m][1] = (f32x4){0.f, 0.f, 0.f, 0.f}; }
#pragma unroll
        for (int kk = 0; kk < 8; ++kk) {
            const bf16x8 b0 = pwf[kk][0], b1 = pwf[kk][1]; bf16x8 af[4];
#pragma unroll
            for (int m = 0; m < 4; ++m) af[m] = *(LAS bf16x8*)(AO + (16 * m + r16) * 528 + (32 * kk + 8 * quad) * 2);
#pragma unroll
            for (int m = 0; m < 4; ++m) { acc[m][0] = MFMA16(b0, af[m], acc[m][0]); acc[m][1] = MFMA16(b1, af[m], acc[m][1]); }
        }
#pragma unroll
        for (int m = 0; m < 4; ++m)
#pragma unroll
            for (int nt = 0; nt < 2; ++nt) { bf16* gp = (bf16*)(p.ws + WS_Y) + (size_t)(r0 + 16 * m + r16) * 1024 + PC_YA + 32 * w + 16 * nt + 4 * quad;
                const u32x2 g = gpre[m][nt]; u32x2 o; o.x = pk2(acc[m][nt][0] * bflo(g.x), acc[m][nt][1] * bfhi(g.x)); o.y = pk2(acc[m][nt][2] * bflo(g.y), acc[m][nt][3] * bfhi(g.y));
                *(u32x2*)gp = o; }
    }
    LBAR();
}

__device__ __forceinline__ void sgu_item(ldsp lds, int item, int layer, const Params& p) {
    const int tid = ltid(), lane = tid & 63, w = __builtin_amdgcn_readfirstlane(tid >> 6), r16 = lane & 15, quad = lane >> 4;
    const int r0 = (item >> 1) * 128, hp = item & 1;
    const bf16* SW = (const bf16*)(p.ws + WS_SGW) + (size_t)layer * 65536; const float* sb = p.sgu_b + layer * 512;
    ldsp VT = lds;
    u32x2 upre[2][4], gpre[2][4];
    bf16x8 wfp[2][4];
    { const int h = 2 * hp + (w >> 2), tq = w & 3;
#pragma unroll
      for (int tti = 0; tti < 2; ++tti)
#pragma unroll
          for (int kk = 0; kk < 4; ++kk) wfp[tti][kk] = *(const bf16x8*)(SW + (size_t)(h * 128 + 16 * (2 * tq + tti) + r16) * 128 + 32 * kk + 8 * quad);
#pragma unroll
      for (int tti = 0; tti < 2; ++tti)
#pragma unroll
          for (int dt = 0; dt < 4; ++dt) { const size_t row = (size_t)(r0 + 16 * (2 * tq + tti) + r16); const int ch = h * 64 + 16 * dt + 4 * quad;
              upre[tti][dt] = *(const u32x2*)((const bf16*)(p.ws + WS_BU) + row * 256 + ch); gpre[tti][dt] = *(const u32x2*)((const bf16*)(p.ws + WS_Y) + row * 1024 + PC_YB + ch); } }
    {
        const int tok = tid >> 2, part = tid & 3;
        const bf16* src = (const bf16*)(p.ws + WS_BV) + (size_t)(r0 + tok) * 256;
        float v[64]; float s = 0.f;
#pragma unroll
        for (int i = 0; i < 8; ++i) { const u32x4 t = *(const u32x4*)(src + 32 * i + 8 * part);
            v[8 * i + 0] = bflo(t.x); v[8 * i + 1] = bfhi(t.x); v[8 * i + 2] = bflo(t.y); v[8 * i + 3] = bfhi(t.y); v[8 * i + 4] = bflo(t.z); v[8 * i + 5] = bfhi(t.z); v[8 * i + 6] = bflo(t.w); v[8 * i + 7] = bfhi(t.w); }
#pragma unroll
        for (int i = 0; i < 64; ++i) s += v[i];
        s += __shfl_xor(s, 1); s += __shfl_xor(s, 2);
        const float mean = s * (1.f / 256.f); float q = 0.f;
#pragma unroll
        for (int i = 0; i < 64; ++i) { v[i] -= mean; q += v[i] * v[i]; }
        q += __shfl_xor(q, 1); q += __shfl_xor(q, 2);
        const float rstd = __builtin_amdgcn_rsqf(q * (1.f / 256.f) + EPS);
        const bool odd = tok & 1;
        unsigned own[16];
#pragma unroll
        for (int i = 0; i < 8; ++i) {
            if ((i >> 2) != hp) continue;
            const int cbp = (32 * i + 8 * part) * 4;
            const f32x4 g0 = *(LAS f32x4*)(lds + L_LNP + 2048 + cbp), g1 = *(LAS f32x4*)(lds + L_LNP + 2048 + cbp + 16), b0 = *(LAS f32x4*)(lds + L_LNP + 3072 + cbp), b1 = *(LAS f32x4*)(lds + L_LNP + 3072 + cbp + 16);
            own[(i & 3) * 4 + 0] = pk2(v[8 * i + 0] * rstd * g0[0] + b0[0], v[8 * i + 1] * rstd * g0[1] + b0[1]);
            own[(i & 3) * 4 + 1] = pk2(v[8 * i + 2] * rstd * g0[2] + b0[2], v[8 * i + 3] * rstd * g0[3] + b0[3]);
            own[(i & 3) * 4 + 2] = pk2(v[8 * i + 4] * rstd * g1[0] + b1[0], v[8 * i + 5] * rstd * g1[1] + b1[1]);
            own[(i & 3) * 4 + 3] = pk2(v[8 * i + 6] * rstd * g1[2] + b1[2], v[8 * i + 7] * rstd * g1[3] + b1[3]);
        }
        unsigned oth[16];
#pragma unroll
        for (int k = 0; k < 16; ++k) oth[k] = (unsigned)__shfl_xor((int)own[k], 4);
#pragma unroll
        for (int k = 0; k < 16; ++k) {
            const int cb = 32 * (4 * hp + (k >> 2)) + 8 * part, e2 = 2 * (k & 3);
            const unsigned val = odd ? ((oth[k] >> 16) | (own[k] & 0xffff0000u)) : ((own[k] & 0xffffu) | (oth[k] << 16));
            const int ch = cb + e2 + (odd ? 1 : 0), t0 = tok & ~1;
            *(LAS unsigned*)(VT + ch * 272 + t0 * 2) = val;
        }
    }
    LBAR();
    {
        const int h = 2 * hp + (w >> 2), tq = w & 3;
        bf16x8 vf[4][4];
#pragma unroll
        for (int dt = 0; dt < 4; ++dt)
#pragma unroll
            for (int kk = 0; kk < 4; ++kk) vf[dt][kk] = *(LAS bf16x8*)(VT + (h * 64 + 16 * dt + r16) * 272 + (32 * kk + 8 * quad) * 2);
#pragma unroll
        for (int tti = 0; tti < 2; ++tti) {
            const int tt = 2 * tq + tti;
            bf16x8 wf[4];
#pragma unroll
            for (int kk = 0; kk < 4; ++kk) wf[kk] = wfp[tti][kk];
            f32x4 acc[4];
#pragma unroll
            for (int dt = 0; dt < 4; ++dt) { acc[dt] = (f32x4){0.f, 0.f, 0.f, 0.f};
#pragma unroll
                for (int kk = 0; kk < 4; ++kk) acc[dt] = MFMA16(vf[dt][kk], wf[kk], acc[dt]); }
            const float bias = sb[h * 128 + 16 * tt + r16];
            bf16* rowy = (bf16*)(p.ws + WS_Y) + (size_t)(r0 + 16 * tt + r16) * 1024; const bf16* rowu = (const bf16*)(p.ws + WS_BU) + (size_t)(r0 + 16 * tt + r16) * 256;
#pragma unroll
            for (int dt = 0; dt < 4; ++dt) { const int ch = h * 64 + 16 * dt + 4 * quad;
                const u32x2 uu = upre[tti][dt], g = gpre[tti][dt]; u32x2 o;
                o.x = pk2(bflo(uu.x) * (acc[dt][0] + bias) * bflo(g.x), bfhi(uu.x) * (acc[dt][1] + bias) * bfhi(g.x));
                o.y = pk2(bflo(uu.y) * (acc[dt][2] + bias) * bflo(g.y), bfhi(uu.y) * (acc[dt][3] + bias) * bfhi(g.y));
                *(u32x2*)(rowy + PC_YB + ch) = o; }
        }
    }
    LBAR();
}

constexpr int H_QD = 0, H_KD = 17408, H_KO = 34816, H_Q3 = 52224, H_K0 = 56576, H_KST = 60928, H_VT = 79360, H_SC = 97792, H_TT = 107008, H_ER = 109056, H_DEC = 111104, H_OS = 111616;

__device__ __forceinline__ void score_tile(ldsp lds, int qoff, int koff, int ti, int sj, bool diag, int r16, int quad) {
    f32x4 acc = {0.f, 0.f, 0.f, 0.f};
    bf16x8 ka[4], qa[4];
#pragma unroll
    for (int kk = 0; kk < 4; ++kk) { ka[kk] = *(LAS bf16x8*)(lds + koff + r16 * 272 + (32 * kk + 8 * quad) * 2); qa[kk] = *(LAS bf16x8*)(lds + qoff + r16 * 272 + (32 * kk + 8 * quad) * 2); }
#pragma unroll
    for (int kk = 0; kk < 4; ++kk) acc = MFMA16(ka[kk], qa[kk], acc);
    if (diag) {
#pragma unroll
        for (int e = 0; e < 4; ++e) if (4 * quad + e > r16) acc[e] = 0.f;
    }
    u32x2 o; o.x = pk2(acc[0], acc[1]); o.y = pk2(acc[2], acc[3]);
    *(LAS u32x2*)(lds + H_SC + (16 * ti + r16) * 144 + (16 * sj + 4 * quad) * 2) = o;
}

__device__ __forceinline__ void gate_fk(float z, float lbv, float oml, float& f, float& kk) {
    z = fmaxf(z, -30.f);
    const float e = __expf(-z), s = __builtin_amdgcn_rcpf(1.f + e);
    f = oml * s + lbv; kk = oml * e * s;
}
constexpr int H_T8 = 113664, H_QS = 117760;
#define HG_TOK(c0_, i_) (dir ? (c0_) + 63 - 8 * w - (i_) : (c0_) + 8 * w + (i_))
#define HG_LD(arr_, c0_, i_) (*(const unsigned*)(Pb + ((unsigned)HG_TOK(c0_, i_) * 256u + (arr_))))

constexpr int A_KST = 0, A_VT = 34816, A_T8 = 69632, A_DEC = 73728;
#define HGA_LD(arr_, c0_, i_) (*(const unsigned*)(Pb + ((unsigned)(dir ? (c0_) + 127 - 16 * w - (i_) : (c0_) + 16 * w + (i_)) * 256u + (arr_))))
template <int DIR> __device__ __forceinline__ void hgrn_passA_dir(ldsp lds, int item, int layer, const Params& p) {
    const int tid = ltid(), lane = tid & 63, w = __builtin_amdgcn_readfirstlane(tid >> 6), r16 = lane & 15, quad = lane >> 4;
    constexpr int dir = DIR; const int h = (item >> 1) & 3, sg = item >> 3; const int slot = item;
    const int kp = lane;
    float lb0 = 0.f, lb1 = 0.f;
    if (layer) { const float* lp = dir ? p.lb_b : p.lb_f; const f32x2 a = *(const f32x2*)(lp + 512 + h * 128 + 2 * kp), b = *(const f32x2*)(lp + h * 128 + 2 * kp); lb0 = sigmoidf_(a.x - b.x); lb1 = sigmoidf_(a.y - b.y); }
    const float om0 = 1.f - lb0, om1 = 1.f - lb1;
    f32x4 S[8];
#pragma unroll
    for (int m = 0; m < 8; ++m) S[m] = (f32x4){0.f, 0.f, 0.f, 0.f};
    float pd0 = 1.f, pd1 = 1.f;
    const unsigned char* Pb = p.ws + WS_HQ; const unsigned az = (dir ? 3u : 2u) * HARR + (unsigned)h * HHEAD + kp * 4u, av = HARR + (unsigned)h * HHEAD + kp * 4u;
    unsigned zr[16];
    { const int c0 = sg * 256 + (dir ? 128 : 0);
#pragma unroll
      for (int i = 0; i < 16; ++i) zr[i] = HGA_LD(az, c0, i); }
#pragma unroll 1
    for (int cc = 0; cc < 2; ++cc) {
        unsigned vr[16];
        { const int c0 = sg * 256 + ((dir != 0) == (cc == 0) ? 128 : 0);
#pragma unroll
          for (int i = 0; i < 16; ++i) vr[i] = HGA_LD(av, c0, i); }
        float ks0[16], ks1[16]; float E0 = 1.f, E1 = 1.f;
#pragma unroll
        for (int i = 15; i >= 0; --i) { float f0, f1, k0, k1; gate_fk(bflo(zr[i]), lb0, om0, f0, k0); gate_fk(bfhi(zr[i]), lb1, om1, f1, k1); ks0[i] = k0 * E0; ks1[i] = k1 * E1; E0 *= f0; E1 *= f1; }
        *(LAS f32x2*)(lds + A_T8 + (w * 128 + 2 * kp) * 4) = (f32x2){E0, E1};
#pragma unroll
        for (int hf = 0; hf < 2; ++hf) {
            *(LAS u32x4*)(lds + A_VT + (2 * kp) * 272 + 32 * w + 16 * hf) = (u32x4){__builtin_amdgcn_perm(vr[8 * hf + 1], vr[8 * hf + 0], 0x05040100u), __builtin_amdgcn_perm(vr[8 * hf + 3], vr[8 * hf + 2], 0x05040100u), __builtin_amdgcn_perm(vr[8 * hf + 5], vr[8 * hf + 4], 0x05040100u), __builtin_amdgcn_perm(vr[8 * hf + 7], vr[8 * hf + 6], 0x05040100u)};
            *(LAS u32x4*)(lds + A_VT + (2 * kp + 1) * 272 + 32 * w + 16 * hf) = (u32x4){__builtin_amdgcn_perm(vr[8 * hf + 1], vr[8 * hf + 0], 0x07060302u), __builtin_amdgcn_perm(vr[8 * hf + 3], vr[8 * hf + 2], 0x07060302u), __builtin_amdgcn_perm(vr[8 * hf + 5], vr[8 * hf + 4], 0x07060302u), __builtin_amdgcn_perm(vr[8 * hf + 7], vr[8 * hf + 6], 0x07060302u)}; }
        if (cc == 0) { const int c0 = sg * 256 + (dir ? 0 : 128);
#pragma unroll
            for (int i = 0; i < 16; ++i) zr[i] = HGA_LD(az, c0, i); }
        LBAR();
        float fa0 = 1.f, fa1 = 1.f, d0 = 1.f, d1 = 1.f;
#pragma unroll
        for (int g = 0; g < 8; ++g) { const f32x2 t = *(LAS f32x2*)(lds + A_T8 + (g * 128 + 2 * kp) * 4); d0 *= t.x; d1 *= t.y; if (g > w) { fa0 *= t.x; fa1 *= t.y; } }
#pragma unroll
        for (int hf = 0; hf < 2; ++hf) {
            *(LAS u32x4*)(lds + A_KST + (2 * kp) * 272 + 32 * w + 16 * hf) = (u32x4){pk2(ks0[8 * hf + 0] * fa0, ks0[8 * hf + 1] * fa0), pk2(ks0[8 * hf + 2] * fa0, ks0[8 * hf + 3] * fa0), pk2(ks0[8 * hf + 4] * fa0, ks0[8 * hf + 5] * fa0), pk2(ks0[8 * hf + 6] * fa0, ks0[8 * hf + 7] * fa0)};
            *(LAS u32x4*)(lds + A_KST + (2 * kp + 1) * 272 + 32 * w + 16 * hf) = (u32x4){pk2(ks1[8 * hf + 0] * fa1, ks1[8 * hf + 1] * fa1), pk2(ks1[8 * hf + 2] * fa1, ks1[8 * hf + 3] * fa1), pk2(ks1[8 * hf + 4] * fa1, ks1[8 * hf + 5] * fa1), pk2(ks1[8 * hf + 6] * fa1, ks1[8 * hf + 7] * fa1)}; }
        if (w == 0) { *(LAS f32x2*)(lds + A_DEC + 2 * kp * 4) = (f32x2){d0, d1}; pd0 *= d0; pd1 *= d1; }
        LBAR();
        bf16x8 vf[4];
#pragma unroll
        for (int kk = 0; kk < 4; ++kk) vf[kk] = *(LAS bf16x8*)(lds + A_VT + (16 * w + r16) * 272 + (32 * kk + 8 * quad) * 2);
#pragma unroll
        for (int mh = 0; mh < 4; ++mh) {
            bf16x8 af[2][4]; f32x4 dd[2];
#pragma unroll
            for (int mi = 0; mi < 2; ++mi) { const int m = 2 * mh + mi; dd[mi] = *(LAS f32x4*)(lds + A_DEC + (16 * m + 4 * quad) * 4);
#pragma unroll
                for (int kk = 0; kk < 4; ++kk) af[mi][kk] = *(LAS bf16x8*)(lds + A_KST + (16 * m + r16) * 272 + (32 * kk + 8 * quad) * 2); }
#pragma unroll
            for (int mi = 0; mi < 2; ++mi) { const int m = 2 * mh + mi; S[m] = S[m] * dd[mi];
#pragma unroll
                for (int kk = 0; kk < 4; ++kk) S[m] = MFMA16(af[mi][kk], vf[kk], S[m]); } }
        LBAR();
    }
    u32x4* sp = (u32x4*)((unsigned char*)p.out + OUT_ST + (size_t)slot * 32768) + (w * 64 + lane) * 4;
#pragma unroll
    for (int i = 0; i < 4; ++i) sp[i] = (u32x4){pk2(S[2 * i][0], S[2 * i][1]), pk2(S[2 * i][2], S[2 * i][3]), pk2(S[2 * i + 1][0], S[2 * i + 1][1]), pk2(S[2 * i + 1][2], S[2 * i + 1][3])};
    if (w == 0) *(f32x2*)((float*)(p.ws + WS_LOGD) + slot * 128 + 2 * kp) = (f32x2){pd0, pd1};
}
__device__ __forceinline__ void hgrn_passA_item(ldsp lds, int item, int layer, const Params& p) { if (item & 1) hgrn_passA_dir<1>(lds, item, layer, p); else hgrn_passA_dir<0>(lds, item, layer, p); }

__device__ __forceinline__ void hgrn_passB(const Params& p) {
    unsigned char* ST = (unsigned char*)p.out + OUT_ST; const float* LD = (const float*)(p.ws + WS_LOGD);
    const int gt = blockIdx.x * 512 + ltid(), NT = gridDim.x * 512;
#pragma unroll 1
    for (int e = gt; e < 64 * 4096; e += NT) {
        const int chain = e >> 12, q = e & 4095, m = q & 7, ln = (q >> 3) & 63, sq = chain >> 3, h = (chain >> 1) & 3, dir = chain & 1;
        const int kd = 16 * m + 4 * (ln >> 4);
        const int seg0 = sq < 4 ? sq * 32 : 128 + (sq - 4) * 16, n = sq < 4 ? 32 : 16;
        const int sgf = dir ? seg0 + n - 1 : seg0, step = dir ? -1 : 1;
        f32x4 carry = {0.f, 0.f, 0.f, 0.f};
#pragma unroll 1
        for (int s0 = 0; s0 < n; s0 += 16) {
            u32x2 loc[16]; f32x4 dd[16];
#pragma unroll
            for (int s = 0; s < 16; ++s) { const int slot = ((sgf + step * (s0 + s)) * 4 + h) * 2 + dir; loc[s] = *(const u32x2*)(ST + (size_t)slot * 32768 + q * 8); dd[s] = *(const f32x4*)(LD + slot * 128 + kd); }
#pragma unroll
            for (int s = 0; s < 16; ++s) { const int slot = ((sgf + step * (s0 + s)) * 4 + h) * 2 + dir;
                *(u32x2*)(ST + (size_t)slot * 32768 + q * 8) = (u32x2){pk2(carry[0], carry[1]), pk2(carry[2], carry[3])};
                carry = dd[s] * carry + (f32x4){bflo(loc[s].x), bfhi(loc[s].x), bflo(loc[s].y), bfhi(loc[s].y)}; }
        }
    }
}

template <int DIR> __device__ __forceinline__ void hgrn_passC_dir(ldsp lds, int item, int layer, const Params& p) {
    const int tid = ltid(), lane = tid & 63, w = __builtin_amdgcn_readfirstlane(tid >> 6), r16 = lane & 15, quad = lane >> 4;
    const int h = item & 3, sg = item >> 2;
    const int kp = lane;
    const f32x4 gn = *(const f32x4*)(p.hgrn_g + layer * 128 + 16 * w + 4 * quad);
    constexpr int dir = DIR;
    {
        const int slot = (sg * 4 + h) * 2 + dir;
        float lb0 = 0.f, lb1 = 0.f;
        if (layer) { const float* lp = dir ? p.lb_b : p.lb_f; const f32x2 a = *(const f32x2*)(lp + 512 + h * 128 + 2 * kp), b = *(const f32x2*)(lp + h * 128 + 2 * kp); lb0 = sigmoidf_(a.x - b.x); lb1 = sigmoidf_(a.y - b.y); }
        const float om0 = 1.f - lb0, om1 = 1.f - lb1;
        f32x4 S[8];
        { const u32x4* sp = (const u32x4*)((const unsigned char*)p.out + OUT_ST + (size_t)slot * 32768) + (w * 64 + lane) * 4;
#pragma unroll
          for (int i = 0; i < 4; ++i) { const u32x4 t = sp[i]; S[2 * i] = (f32x4){bflo(t.x), bfhi(t.x), bflo(t.y), bfhi(t.y)}; S[2 * i + 1] = (f32x4){bflo(t.z), bfhi(t.z), bflo(t.w), bfhi(t.w)}; } }
        unsigned char* Pb = p.ws + WS_HQ; bf16* Y = (bf16*)(p.ws + WS_Y);
        const unsigned aq = (unsigned)h * HHEAD + kp * 4u, az = (dir ? 3u : 2u) * HARR + (unsigned)h * HHEAD + kp * 4u, av = HARR + (unsigned)h * HHEAD + kp * 4u;
        const unsigned colo = 2u * HARR + (unsigned)h * HHEAD + (16 * w + 4 * quad) * 2u;
        unsigned zr[8], qr[8], vr[8];
        { const int c0 = sg * 256 + (dir ? (SEGC - 1) : 0) * 64;
#pragma unroll
          for (int i = 0; i < 8; ++i) { zr[i] = HG_LD(az, c0, i); qr[i] = HG_LD(aq, c0, i); vr[i] = HG_LD(av, c0, i); } }
#pragma unroll 1
        for (int cc = 0; cc < SEGC; ++cc) {
            const int c0 = sg * 256 + (dir ? (SEGC - 1 - cc) : cc) * 64;
            u32x2 ofr[4], ggr[4];
            {
                float el0[8], el1[8], kk0[8], kk1[8], q0[8], q1[8]; float E0 = 1.f, E1 = 1.f;
#pragma unroll
                for (int i = 0; i < 8; ++i) { float f0, f1; gate_fk(bflo(zr[i]), lb0, om0, f0, kk0[i]); gate_fk(bfhi(zr[i]), lb1, om1, f1, kk1[i]); E0 *= f0; E1 *= f1; el0[i] = E0; el1[i] = E1; q0[i] = bflo(qr[i]); q1[i] = bfhi(qr[i]); }
                *(LAS f32x2*)(lds + H_T8 + (w * 128 + 2 * kp) * 4) = (f32x2){E0, E1};
                *(LAS u32x4*)(lds + H_VT + (2 * kp) * 144 + 16 * w) = (u32x4){__builtin_amdgcn_perm(vr[1], vr[0], 0x05040100u), __builtin_amdgcn_perm(vr[3], vr[2], 0x05040100u), __builtin_amdgcn_perm(vr[5], vr[4], 0x05040100u), __builtin_amdgcn_perm(vr[7], vr[6], 0x05040100u)};
                *(LAS u32x4*)(lds + H_VT + (2 * kp + 1) * 144 + 16 * w) = (u32x4){__builtin_amdgcn_perm(vr[1], vr[0], 0x07060302u), __builtin_amdgcn_perm(vr[3], vr[2], 0x07060302u), __builtin_amdgcn_perm(vr[5], vr[4], 0x07060302u), __builtin_amdgcn_perm(vr[7], vr[6], 0x07060302u)};
                if (cc + 1 < SEGC) { const int c1 = sg * 256 + (dir ? (SEGC - 2 - cc) : cc + 1) * 64;
#pragma unroll
                    for (int i = 0; i < 8; ++i) { zr[i] = HG_LD(az, c1, i); qr[i] = HG_LD(aq, c1, i); vr[i] = HG_LD(av, c1, i); } }
                if (dir == 1) {
#pragma unroll
                    for (int tt = 0; tt < 4; ++tt) { const int tok = c0 + 63 - (16 * tt + r16); ofr[tt] = *(const u32x2*)(Pb + ((unsigned)tok * 256u + colo)); ggr[tt] = *(const u32x2*)(Y + (size_t)tok * 1024 + PC_YC + h * 128 + 16 * w + 4 * quad); } }
                LBAR();
                f32x2 T[8], PF[9];
#pragma unroll
                for (int g = 0; g < 8; ++g) T[g] = *(LAS f32x2*)(lds + H_T8 + (g * 128 + 2 * kp) * 4);
                PF[0] = (f32x2){1.f, 1.f};
#pragma unroll
                for (int g = 0; g < 8; ++g) PF[g + 1] = PF[g] * T[g];
                f32x2 pf;
                switch (w) { case 0: pf = PF[0]; break; case 1: pf = PF[1]; break; case 2: pf = PF[2]; break; case 3: pf = PF[3]; break; case 4: pf = PF[4]; break; case 5: pf = PF[5]; break; case 6: pf = PF[6]; break; default: pf = PF[7]; break; }
                float bt0[8], bt1[8];
#pragma unroll
                for (int i = 0; i < 8; ++i) { const int tau = 8 * w + i;
                    const float e0 = pf.x * el0[i], e1 = pf.y * el1[i];
                    bt0[i] = kk0[i] * __builtin_amdgcn_rcpf(fmaxf(e0, 1e-34f)); bt1[i] = kk1[i] * __builtin_amdgcn_rcpf(fmaxf(e1, 1e-34f));
                    *(LAS unsigned*)(lds + H_QS + tau * 272 + kp * 4) = pk2(q0[i] * e0, q1[i] * e1);
                    *(LAS unsigned*)(lds + H_KD + tau * 272 + kp * 4) = pk2(bt0[i], bt1[i]); }
                *(LAS u32x4*)(lds + H_KST + (2 * kp) * 144 + 16 * w) = (u32x4){pk2(bt0[0], bt0[1]), pk2(bt0[2], bt0[3]), pk2(bt0[4], bt0[5]), pk2(bt0[6], bt0[7])};
                *(LAS u32x4*)(lds + H_KST + (2 * kp + 1) * 144 + 16 * w) = (u32x4){pk2(bt1[0], bt1[1]), pk2(bt1[2], bt1[3]), pk2(bt1[4], bt1[5]), pk2(bt1[6], bt1[7])};
                if (w == 4) *(LAS f32x2*)(lds + H_DEC + 2 * kp * 4) = PF[8];
                LBAR();
            }
            if (w < 4) score_tile(lds, H_QS + 16 * w * 272, H_KD + 16 * w * 272, w, w, true, r16, quad);
            else if (w < 7) score_tile(lds, H_QS + 16 * (w - 3) * 272, H_KD + 16 * (w - 4) * 272, w - 3, w - 4, false, r16, quad);
            else score_tile(lds, H_QS + 32 * 272, H_KD, 2, 0, false, r16, quad);
            if (w == 0) score_tile(lds, H_QS + 48 * 272, H_KD + 16 * 272, 3, 1, false, r16, quad);
            if (w == 1) score_tile(lds, H_QS + 48 * 272, H_KD, 3, 0, false, r16, quad);
            if (w == 2) *(LAS u32x2*)(lds + H_SC + (r16) * 144 + (16 + 4 * quad) * 2) = (u32x2){0u, 0u};
            if (w == 3) *(LAS u32x2*)(lds + H_SC + (32 + r16) * 144 + (48 + 4 * quad) * 2) = (u32x2){0u, 0u};
            f32x4 o[4];
            bf16x8 sa[4];
#pragma unroll
            for (int pp = 0; pp < 4; ++pp) sa[pp] = mk8(pk2(S[2 * pp][0], S[2 * pp][1]), pk2(S[2 * pp][2], S[2 * pp][3]), pk2(S[2 * pp + 1][0], S[2 * pp + 1][1]), pk2(S[2 * pp + 1][2], S[2 * pp + 1][3]));
#pragma unroll
            for (int tt = 0; tt < 4; ++tt) { o[tt] = (f32x4){0.f, 0.f, 0.f, 0.f};
                u32x2 qb[4][2];
#pragma unroll
                for (int pp = 0; pp < 4; ++pp) { qb[pp][0] = *(LAS u32x2*)(lds + H_QS + (16 * tt + r16) * 272 + (32 * pp + 4 * quad) * 2); qb[pp][1] = *(LAS u32x2*)(lds + H_QS + (16 * tt + r16) * 272 + (32 * pp + 16 + 4 * quad) * 2); }
#pragma unroll
                for (int pp = 0; pp < 4; ++pp) o[tt] = MFMA16(sa[pp], mk8(qb[pp][0].x, qb[pp][0].y, qb[pp][1].x, qb[pp][1].y), o[tt]); }
            LBAR();
            bf16x8 vf[2];
#pragma unroll
            for (int kk = 0; kk < 2; ++kk) vf[kk] = *(LAS bf16x8*)(lds + H_VT + (16 * w + r16) * 144 + (32 * kk + 8 * quad) * 2);
            bf16x8 scf[4][2];
#pragma unroll
            for (int tt = 0; tt < 4; ++tt)
#pragma unroll
                for (int kk = 0; kk < 2; ++kk) { if (kk == 1 && tt < 2) continue; scf[tt][kk] = *(LAS bf16x8*)(lds + H_SC + (16 * tt + r16) * 144 + (32 * kk + 8 * quad) * 2); }
#pragma unroll
            for (int tt = 0; tt < 4; ++tt)
#pragma unroll
                for (int kk = 0; kk < 2; ++kk) { if (kk == 1 && tt < 2) continue; o[tt] = MFMA16(vf[kk], scf[tt][kk], o[tt]); }
#pragma unroll
            for (int mh = 0; mh < 2; ++mh) {
                bf16x8 af[4][2]; f32x4 dd[4];
#pragma unroll
                for (int mi = 0; mi < 4; ++mi) { const int m = 4 * mh + mi;
#pragma unroll
                    for (int kk = 0; kk < 2; ++kk) af[mi][kk] = *(LAS bf16x8*)(lds + H_KST + (16 * m + r16) * 144 + (32 * kk + 8 * quad) * 2);
                    dd[mi] = *(LAS f32x4*)(lds + H_DEC + (16 * m + 4 * quad) * 4); }
#pragma unroll
                for (int mi = 0; mi < 4; ++mi) { const int m = 4 * mh + mi;
#pragma unroll
                    for (int kk = 0; kk < 2; ++kk) S[m] = MFMA16(af[mi][kk], vf[kk], S[m]);
                    S[m] = S[m] * dd[mi]; } }
            if (dir == 0) {
#pragma unroll
                for (int tt = 0; tt < 4; ++tt) { const int tok = c0 + 16 * tt + r16; u32x2 ov; ov.x = pk2(o[tt][0], o[tt][1]); ov.y = pk2(o[tt][2], o[tt][3]);
                    *(u32x2*)(Pb + ((unsigned)tok * 256u + colo)) = ov; }
                LBAR();
            } else {
#pragma unroll
                for (int tt = 0; tt < 4; ++tt) { const int tok = c0 + 63 - (16 * tt + r16);
                    const u32x2 of = ofr[tt];
                    o[tt][0] += bflo(of.x); o[tt][1] += bfhi(of.x); o[tt][2] += bflo(of.y); o[tt][3] += bfhi(of.y);
                    float ss = (o[tt][0] * o[tt][0] + o[tt][1] * o[tt][1]) + (o[tt][2] * o[tt][2] + o[tt][3] * o[tt][3]);
                    ss += __shfl_xor(ss, 16); ss += __shfl_xor(ss, 32);
                    if (quad == 0) *(LAS float*)(lds + H_OS + (w * 64 + 16 * tt + r16) * 4) = ss; }
                LBAR();
#pragma unroll
                for (int tt = 0; tt < 4; ++tt) { const int tau = 16 * tt + r16, tok = c0 + 63 - tau; float tot = 0.f;
#pragma unroll
                    for (int ww = 0; ww < 8; ++ww) tot += *(LAS float*)(lds + H_OS + (ww * 64 + tau) * 4);
                    const float rs = __builtin_amdgcn_rsqf(tot * (1.f / 128.f) + EPS);
                    bf16* gp = Y + (size_t)tok * 1024 + PC_YC + h * 128 + 16 * w + 4 * quad; const u32x2 g = ggr[tt]; u32x2 ov;
                    ov.x = pk2(o[tt][0] * rs * gn[0] * bflo(g.x), o[tt][1] * rs * gn[1] * bfhi(g.x)); ov.y = pk2(o[tt][2] * rs * gn[2] * bflo(g.y), o[tt][3] * rs * gn[3] * bfhi(g.y));
                    *(u32x2*)gp = ov; }
            }
        }
        __syncthreads();
    }
}
__device__ __forceinline__ void hgrn_passC_item(ldsp lds, int item, int layer, const Params& p) { hgrn_passC_dir<0>(lds, item, layer, p); hgrn_passC_dir<1>(lds, item, layer, p); }

#define XB_TMO      128
#define XB_XCNT(j)  (256  + 64 * (j))
#define XB_XSUB(j)  (1280 + 64 * (j))
#define XB_XGEN(j)  (2304 + 64 * (j))
#define XB_TOP      3328
#define XB_TOPGEN   3392
#define XCD_BAR_WORDS 3456
#define XB_SPIN_CAP (1u << 18)

__device__ __forceinline__ unsigned xb_ld(unsigned* p)              { return __hip_atomic_load(p, __ATOMIC_RELAXED, __HIP_MEMORY_SCOPE_AGENT); }
__device__ __forceinline__ unsigned xb_add(unsigned* p, unsigned v) { return __hip_atomic_fetch_add(p, v, __ATOMIC_RELAXED, __HIP_MEMORY_SCOPE_AGENT); }
__device__ __forceinline__ unsigned xb_xcc_id() { return (unsigned)__builtin_amdgcn_s_getreg((3 << 11) | 20) & 0xFu; }
#define XB_SPIN(cond, bar) do { unsigned _sp = 0; while (cond) { __builtin_amdgcn_s_sleep(1); \
    if ((++_sp & 255u) == 0u) { if (xb_ld(&(bar)[XB_TMO])) break; if (_sp > XB_SPIN_CAP) { atomicAdd(&(bar)[XB_TMO], 1u); break; } } } } while (0)

struct XcdBarrier {
    unsigned* bar; unsigned x;
    volatile LAS unsigned* st;
};

__device__ __forceinline__ XcdBarrier xcd_barrier_post(unsigned* bar, volatile LAS unsigned* st) {
    XcdBarrier b; b.bar = bar; b.x = xb_xcc_id(); b.st = st;
    if (ltid() == 0) (void)xb_add(&bar[XB_XCNT(b.x)], 1u);
    return b;
}
__device__ __forceinline__ void xcd_barrier_complete(unsigned* bar, unsigned x, unsigned& nloc, unsigned& nx) {
    const unsigned G = gridDim.x * gridDim.y * gridDim.z;
    unsigned sum, cnt, mine, sp = 0u;
    for (;;) {
        sum = 0u; cnt = 0u; mine = 0u;
#pragma unroll
        for (unsigned j = 0; j < 16; ++j) { const unsigned c = xb_ld(&bar[XB_XCNT(j)]); sum += c; cnt += (c > 0u) ? 1u : 0u; mine = (j == x) ? c : mine; }
        if (sum == G) break;
        __builtin_amdgcn_s_sleep(1);
        if ((++sp & 255u) == 0u) { if (xb_ld(&bar[XB_TMO])) break; if (sp > XB_SPIN_CAP) { atomicAdd(&bar[XB_TMO], 1u); break; } }
    }
    nloc = mine > 0u ? mine : 1u; nx = cnt > 0u ? cnt : 1u;
}

__device__ __forceinline__ void xcd_barrier(const XcdBarrier& b) {
    asm volatile("s_waitcnt vmcnt(0)" ::: "memory");
    __syncthreads();
    if (ltid() == 0) {
        unsigned* bar = b.bar;
        __builtin_amdgcn_s_waitcnt(0);
        unsigned nloc = b.st[0], nx = b.st[1];
        if (nloc == 0u) { xcd_barrier_complete(bar, b.x, nloc, nx); b.st[0] = nloc; b.st[1] = nx; }
        const unsigned old = xb_add(&bar[XB_XSUB(b.x)], 1u);
        const unsigned gen = old / nloc;
        if (old + 1u == (gen + 1u) * nloc) {
            __builtin_amdgcn_fence(__ATOMIC_RELEASE, "agent");
            asm volatile("s_waitcnt vmcnt(0)" ::: "memory");
            const unsigned og = xb_add(&bar[XB_TOP], 1u);
            const unsigned tg = og / nx;
            if (og + 1u == (tg + 1u) * nx) xb_add(&bar[XB_TOPGEN], 1u);
            else XB_SPIN(xb_ld(&bar[XB_TOPGEN]) == tg, bar);
            __builtin_amdgcn_fence(__ATOMIC_ACQUIRE, "agent");
            xb_add(&bar[XB_XGEN(b.x)], 1u);
            asm volatile("s_waitcnt vmcnt(0)" ::: "memory");
        } else {
            XB_SPIN(xb_ld(&bar[XB_XGEN(b.x)]) == gen, bar);
            __builtin_amdgcn_fence(__ATOMIC_ACQUIRE, "agent");
            asm volatile("s_waitcnt vmcnt(0)" ::: "memory");
        }
    }
    __syncthreads();
}


__global__ void __launch_bounds__(512, 2) fwd_kernel(Params p) {
    extern __shared__ __attribute__((aligned(16))) unsigned char lds_raw[];
    ldsp lds = (ldsp)lds_raw;
    cg::grid_group grid = cg::this_grid();
    unsigned char* ws = p.ws;
    bf16* XB = (bf16*)(ws + WS_XB); float* part = (float*)(ws + WS_PART);
    const int G = gridDim.x, bx = blockIdx.x;
    if (ltid() < 2) *(LAS unsigned*)(lds + LDS_BARST + 4 * ltid()) = 0u;
    __syncthreads();
    const XcdBarrier xbar = xcd_barrier_post((unsigned*)(ws + WS_BAR), (volatile LAS unsigned*)(lds + LDS_BARST));
#pragma unroll 1
    for (int ph = p.ph_lo; ph < p.ph_hi; ++ph) {
        if (ph == 0) prologue(lds, p);
        else if (ph == NPH - 1) final_norm(p);
        else {
            const int layer = (ph - 1) / 5, sub = (ph - 1) % 5;
            if (sub == 0) {
                pg8::Gemm g{layer == 0 ? XB : (const bf16*)p.out, (const bf16*)(ws + WS_BT1) + (size_t)layer * DIN * D, M, DIN, D, D}; pg8::StaticOrder S; S.init(M, DIN, G, bx);
                Epi1 E{ws, part};
                pg8::gemm_phase<Epi1, pg8::StaticOrder, true, true>(lds, g, S, E);
            } else if (sub == 1) {
                for (int it = bx; it < NSEG * 8; it += G) hgrn_passA_item(lds, it, layer, p);
            } else if (sub == 2) {
                hgrn_passB(p);
                { const int t_ = ltid(); if (t_ < 256) { *(LAS float*)(lds + L_LNP + 4 * t_) = p.conv_ln_g[layer * 256 + t_]; *(LAS float*)(lds + L_LNP + 1024 + 4 * t_) = p.conv_ln_b[layer * 256 + t_];
                      *(LAS float*)(lds + L_LNP + 2048 + 4 * t_) = p.sgu_ln_g[layer * 256 + t_]; *(LAS float*)(lds + L_LNP + 3072 + 4 * t_) = p.sgu_ln_b[layer * 256 + t_]; } }
                { f32x2 w2[31]; const int cp = ltid() & 127; const float* cw = p.conv_w + layer * 31 * 256;
#pragma unroll
                  for (int j = 0; j < 31; ++j) w2[j] = *(const f32x2*)(cw + j * 256 + 2 * cp);
                  const f32x2 bb2 = *(const f32x2*)(p.conv_b + layer * 256 + 2 * cp);
                  for (int it = bx; it < 768; it += G) conv_item(lds, it, layer, p, w2, bb2); }
                for (int it = bx; it < 768; it += G) sgu_item(lds, it, layer, p);
            } else if (sub == 3) {
                for (int it = bx; it < NSEG * 4; it += G) hgrn_passC_item(lds, it, layer, p);
            } else {
                pg8::Gemm g{(const bf16*)(ws + WS_Y), (const bf16*)(ws + WS_BT2) + (size_t)layer * D * D, M, D, D, D}; pg8::StaticOrder S; S.init(M, D, G, bx);
                Epi2 E{p.xp, p.xs, M0, layer == 0 ? (const bf16*)XB : (const bf16*)p.out, nullptr, layer == 0 ? (bf16*)p.out : XB, part};
                pg8::gemm_phase<Epi2, pg8::StaticOrder, true, true>(lds, g, S, E);
            }
        }
        if (ph + 1 < p.ph_hi) { if (p.ph_hi > NPH) grid.sync();
                                xcd_barrier(xbar); }
    }
}

extern "C" void kernel_launch(void* const* d_in, const int* in_sizes, int n_in, void* d_out, int out_size, void* d_ws, size_t ws_size, hipStream_t stream) {
    static int grid = 0;
    if (grid == 0) {
        if (n_in != 18 || out_size != M * D || ws_size < WS_END) { fprintf(stderr, "kernel_launch: unexpected shapes (n_in %d out %d ws %zu)\n", n_in, out_size, ws_size); grid = -1; return; }
        int dev = 0, cus = 0, per_cu = 0;
        hipGetDevice(&dev); hipDeviceGetAttribute(&cus, hipDeviceAttributeMultiprocessorCount, dev);
        hipFuncSetAttribute((const void*)fwd_kernel, hipFuncAttributeMaxDynamicSharedMemorySize, LDS_BYTES);
        if (hipOccupancyMaxActiveBlocksPerMultiprocessor(&per_cu, (const void*)fwd_kernel, 512, LDS_BYTES) != hipSuccess || per_cu < 1) per_cu = 1;
        (void)hipGetLastError();
        grid = cus * per_cu;
    }
    if (grid < 0) return;
    Params p{};
    const float** pp = (const float**)&p;
    for (int i = 0; i < 18; ++i) pp[i] = (const float*)d_in[i];
    p.out = (float*)d_out; p.ws = (unsigned char*)d_ws;
    if (hipMemsetAsync((char*)d_ws + WS_BAR, 0, 16384, stream) != hipSuccess) { fprintf(stderr, "kernel_launch: memset of the barrier words failed\n"); return; }
#if ONE_LAUNCH
    p.ph_lo = 0; p.ph_hi = NPH;
    void* args[] = {&p};
    hipError_t e = hipLaunchCooperativeKernel((const void*)fwd_kernel, dim3(grid), dim3(512), args, LDS_BYTES, stream);
    if (e != hipSuccess) fprintf(stderr, "cooperative launch failed: %s (grid %d)\n", hipGetErrorString(e), grid);
#else
    for (int ph = 0; ph < NPH; ++ph) { p.ph_lo = ph; p.ph_hi = ph + 1; hipLaunchKernelGGL(fwd_kernel, dim3(grid), dim3(512), LDS_BYTES, stream, p); }
#endif
}
```

```cpp
#include <hip/hip_runtime.h>
#include <hip/hip_cooperative_groups.h>
#include <cstdio>
#include <cstdint>
namespace cg = cooperative_groups;

__device__ __forceinline__ int ltid() { int t = threadIdx.x; asm volatile("" : "+v"(t)); return t; }
namespace pg8 {
#define PG8_LAS __attribute__((address_space(3)))
typedef unsigned short bf16_t;
typedef short bf16x8 __attribute__((ext_vector_type(8)));
typedef float f32x4 __attribute__((ext_vector_type(4)));
typedef unsigned u32x4 __attribute__((ext_vector_type(4)));
constexpr int BM = 256, BK = 64, HALF = 128, HTB = HALF * BK * 2  , STAGE_BYTES = 8 * HTB, NXCD = 8, WGM = 8;

__host__ __device__ __forceinline__ int lds_byte(int r, int c) { const int st = (r >> 4) * 2 + (c >> 5), rr = r & 15, cc = c & 31, ob = rr * 64 + cc * 2; return st * 1024 + (ob ^ (((ob >> 9) & 1) << 5)); }
__host__ __device__ __forceinline__ void stage_rc(int b, int& R, int& C) { const int st = b / 1024, sb = b % 1024, swz = sb ^ (((sb >> 9) & 1) << 5); R = (st >> 1) * 16 + swz / 64; C = (st & 1) * 32 + (swz % 64) / 2; }
__host__ __device__ __forceinline__ int perm32(int rho) { const int n = rho >> 4, i = rho & 15; return 8 * (i >> 2) + 4 * n + (i & 3); }

struct Unit { int pm, pn; };
struct Gemm { const bf16_t* A; const bf16_t* Bt; int M, N, K, lda; };

struct StaticOrder {
    int nM, nN, nwg, G, c;
    __host__ __device__ void init(int M, int N, int G_, int c_) { nM = M / BM; nN = N / BM; nwg = nM * nN; G = G_; c = c_; }
    __host__ __device__ bool next(int i, Unit& u) const {
        const long L = (long)i * G + c; if (L >= nwg) return false;
        int wgid = (int)L; { const int q = nwg / NXCD, r = nwg % NXCD, xcd = wgid % NXCD, off = wgid / NXCD; wgid = (xcd < r ? xcd * (q + 1) : r * (q + 1) + (xcd - r) * q) + off; }
        const int nig = WGM * nN, gid = wgid / nig, fm = gid * WGM, gsz = (nM - fm) < WGM ? (nM - fm) : WGM;
        u.pm = fm + ((wgid % nig) % gsz); u.pn = (wgid % nig) / gsz; return true;
    }
    __device__ __forceinline__ void a_ready(const Unit&) const {}
    __device__ __forceinline__ void done(const Unit&) const {}
};

typedef float f32x2 __attribute__((ext_vector_type(2)));
__device__ __forceinline__ f32x2 gelu_pk(f32x2 v) {
    const f32x2 av = __builtin_elementwise_abs(v), d = av * 0.2316418882f + 1.0f;
    f32x2 t; t.x = __builtin_amdgcn_rcpf(d.x); t.y = __builtin_amdgcn_rcpf(d.y);
    f32x2 q = t * 0.5307027145f + (-0.7265760135f); q = q * t + 0.7107068705f; q = q * t + (-0.142248368f); q = q * t + 0.127414796f; q = q * t;
    const f32x2 s = (v * v) * (-0.72134752044f);
    f32x2 e; e.x = __builtin_amdgcn_exp2f(s.x); e.y = __builtin_amdgcn_exp2f(s.y);
    const f32x2 m = v * (q * e), r = v - m;
    f32x2 o; o.x = v.x < 0.f ? m.x : r.x; o.y = v.y < 0.f ? m.y : r.y; return o;
}

template <class Epi, class Sched, bool ALIGN_EPI = false, bool SP2 = false>
__device__ __forceinline__ void gemm_phase(PG8_LAS unsigned char* lds, const Gemm g, const Sched& S, const Epi& E) {
    const int tid = ltid(), wid = __builtin_amdgcn_readfirstlane(tid >> 6), lane = tid & 63, wr = wid >> 2, wc = wid & 3, fr = lane & 15, fq = lane >> 4;
    const int K = g.K, nt = K / BK;
    unsigned voffA[2], voffB[2];
#pragma unroll
    for (int i = 0; i < 2; ++i) { int R, C; stage_rc(tid * 16 + i * 8192, R, C); const int Rb = Epi::PERM ? ((R & ~31) + perm32(R & 31)) : R;
        voffA[i] = (unsigned)(R * g.lda + C) * 2u; voffB[i] = (unsigned)(Rb * K + C) * 2u; }
    const size_t kstep = (size_t)(BK * 2);
    const size_t hstepB = (size_t)HALF * K * 2, hstepA = (size_t)HALF * g.lda * 2;
    const size_t tstepA = 2 * hstepA, tstepB = 2 * hstepB;
    const unsigned ldsw = (unsigned)wid * 1024u;
    const int aoff = lds_byte(wr * 64 + fr, fq * 8), boff = lds_byte(wc * 32 + fr, fq * 8);
#define PG8_SA(b, h) (((b) * 2 + (h)) * HTB)
#define PG8_SB(b, h) ((4 + (b) * 2 + (h)) * HTB)
#define PG8_STAGE(bufoff, gbase, voff) do { _Pragma("unroll") for (int _i = 0; _i < 2; ++_i) \
        __builtin_amdgcn_global_load_lds((const unsigned*)((const char*)(gbase) + (voff)[_i]), (PG8_LAS unsigned*)(lds + (bufoff) + ldsw + _i * 8192), 16, 0, 0); } while (0)
#define PG8_LDA(dst, b, h) do { _Pragma("unroll") for (int m = 0; m < 4; ++m) _Pragma("unroll") for (int k = 0; k < 2; ++k) dst[m][k] = *(const PG8_LAS bf16x8*)(lds + PG8_SA(b, h) + aoff + m * 2048 + k * 1024); } while (0)
#define PG8_LDB(dst, b, h) do { _Pragma("unroll") for (int n = 0; n < 2; ++n) _Pragma("unroll") for (int k = 0; k < 2; ++k) dst[n][k] = *(const PG8_LAS bf16x8*)(lds + PG8_SB(b, h) + boff + n * 2048 + k * 1024); } while (0)
#define PG8_MMA(ai, bj, At, Bt) do { __builtin_amdgcn_s_setprio(1); _Pragma("unroll") for (int m = 0; m < 4; ++m) _Pragma("unroll") for (int n = 0; n < 2; ++n) _Pragma("unroll") for (int k = 0; k < 2; ++k) \
        acc[ai][bj][m][n] = __builtin_amdgcn_mfma_f32_16x16x32_bf16(Bt[n][k], At[m][k], acc[ai][bj][m][n], 0, 0, 0); __builtin_amdgcn_s_setprio(0); } while (0)
#define PG8_WAIT_V(n) asm volatile("s_waitcnt vmcnt(" #n ")" ::: "memory")
#define PG8_WAIT_L(n) asm volatile("s_waitcnt lgkmcnt(" #n ")" ::: "memory")
#define PG8_BAR __builtin_amdgcn_s_barrier()
#define PG8_SCHED __builtin_amdgcn_sched_barrier(0)
    Unit cur, nxt; int ui = 0;
    if (!S.next(0, cur)) return;
    f32x4 acc[2][2][4][2];
#pragma unroll
    for (int a = 0; a < 2; ++a)
#pragma unroll
        for (int b = 0; b < 2; ++b)
#pragma unroll
            for (int m = 0; m < 4; ++m)
#pragma unroll
                for (int n = 0; n < 2; ++n) acc[a][b][m][n] = (f32x4){0.f, 0.f, 0.f, 0.f};
    bf16x8 At[4][2], B0[2][2], B1[2][2];
    const char* cA = (const char*)g.A + (size_t)cur.pm * tstepA; const char* cB = (const char*)g.Bt + (size_t)cur.pn * tstepB;
    S.a_ready(cur);
    if constexpr (SP2) {
        PG8_STAGE(PG8_SB(0, 0), cB, voffB); PG8_STAGE(PG8_SB(0, 1), cB + hstepB, voffB); PG8_STAGE(PG8_SA(0, 0), cA, voffA); PG8_STAGE(PG8_SA(0, 1), cA + hstepA, voffA);
        if (wr == 1) PG8_BAR;
        PG8_WAIT_V(2); PG8_BAR;
        PG8_STAGE(PG8_SB(1, 0), cB + kstep, voffB); PG8_STAGE(PG8_SA(1, 0), cA + kstep, voffA); PG8_STAGE(PG8_SB(1, 1), cB + hstepB + kstep, voffB);
        PG8_WAIT_V(6); PG8_BAR;
    } else {
        PG8_STAGE(PG8_SB(0, 0), cB, voffB); PG8_STAGE(PG8_SA(0, 0), cA, voffA); PG8_STAGE(PG8_SB(0, 1), cB + hstepB, voffB); PG8_STAGE(PG8_SA(0, 1), cA + hstepA, voffA);
        if (wr == 1) PG8_BAR;
        PG8_WAIT_V(4); PG8_BAR;
        PG8_STAGE(PG8_SB(1, 0), cB + kstep, voffB); PG8_STAGE(PG8_SA(1, 0), cA + kstep, voffA); PG8_STAGE(PG8_SB(1, 1), cB + hstepB + kstep, voffB);
        PG8_WAIT_V(6); PG8_BAR;
    }
    for (;;) {
        const bool has_next = S.next(ui + 1, nxt);
        const char* nA = has_next ? (const char*)g.A + (size_t)nxt.pm * tstepA : cA; const char* nB = has_next ? (const char*)g.Bt + (size_t)nxt.pn * tstepB : cB;
        for (int t = 0; t < nt; t += 2) {
            const bool last = (t == nt - 2);
            const char* a1 = cA + (size_t)(t + 1) * kstep;
            const char* a2 = last ? nA : cA + (size_t)(t + 2) * kstep; const char* b2 = last ? nB : cB + (size_t)(t + 2) * kstep;
            const char* a3 = a2 + kstep; const char* b3 = b2 + kstep;
            if (last && has_next) S.a_ready(nxt);
            if constexpr (SP2) {
            PG8_LDB(B0, 0, 0); PG8_LDB(B1, 0, 1); PG8_SCHED; PG8_LDA(At, 0, 0); PG8_STAGE(PG8_SA(1, 1), a1 + hstepA, voffA);
            PG8_WAIT_V(8); PG8_WAIT_L(0); PG8_BAR; PG8_MMA(0, 0, At, B0); PG8_MMA(0, 1, At, B1); PG8_BAR; PG8_SCHED;
            PG8_LDA(At, 0, 1); PG8_STAGE(PG8_SB(0, 0), b2, voffB); PG8_STAGE(PG8_SB(0, 1), b2 + hstepB, voffB); PG8_STAGE(PG8_SA(0, 0), a2, voffA);
            PG8_WAIT_V(8); PG8_WAIT_L(0); PG8_BAR; PG8_MMA(1, 0, At, B0); PG8_MMA(1, 1, At, B1); PG8_BAR; PG8_SCHED;
            PG8_LDB(B0, 1, 0); PG8_LDB(B1, 1, 1); PG8_SCHED; PG8_LDA(At, 1, 0); PG8_STAGE(PG8_SA(0, 1), a2 + hstepA, voffA);
            PG8_WAIT_V(8); PG8_WAIT_L(0); PG8_BAR; PG8_MMA(0, 0, At, B0); PG8_MMA(0, 1, At, B1); PG8_BAR; PG8_SCHED;
            PG8_LDA(At, 1, 1); PG8_STAGE(PG8_SB(1, 0), b3, voffB); PG8_STAGE(PG8_SB(1, 1), b3 + hstepB, voffB); PG8_STAGE(PG8_SA(1, 0), a3, voffA);
            PG8_WAIT_V(8); PG8_WAIT_L(0); PG8_BAR; PG8_MMA(1, 0, At, B0); PG8_MMA(1, 1, At, B1); PG8_BAR; PG8_SCHED;
            } else {
            PG8_LDB(B0, 0, 0); PG8_SCHED; PG8_LDA(At, 0, 0); PG8_STAGE(PG8_SA(1, 1), a1 + hstepA, voffA);
            PG8_WAIT_L(8); PG8_BAR; PG8_WAIT_L(0); PG8_MMA(0, 0, At, B0); PG8_BAR; PG8_SCHED;
            PG8_LDB(B1, 0, 1); PG8_STAGE(PG8_SB(0, 0), b2, voffB);
            PG8_BAR; PG8_WAIT_L(0); PG8_MMA(0, 1, At, B1); PG8_BAR;
            PG8_LDA(At, 0, 1); PG8_STAGE(PG8_SA(0, 0), a2, voffA);
            PG8_BAR; PG8_WAIT_L(0); PG8_MMA(1, 0, At, B0); PG8_BAR; PG8_SCHED;
            PG8_STAGE(PG8_SB(0, 1), b2 + hstepB, voffB);
            PG8_WAIT_V(6); PG8_BAR; PG8_MMA(1, 1, At, B1); PG8_BAR;
            PG8_LDB(B0, 1, 0); PG8_SCHED; PG8_LDA(At, 1, 0); PG8_STAGE(PG8_SA(0, 1), a2 + hstepA, voffA);
            PG8_WAIT_L(8); PG8_BAR; PG8_WAIT_L(0); PG8_MMA(0, 0, At, B0); PG8_BAR; PG8_SCHED;
            PG8_LDB(B1, 1, 1); PG8_STAGE(PG8_SB(1, 0), b3, voffB);
            PG8_BAR; PG8_WAIT_L(0); PG8_MMA(0, 1, At, B1); PG8_BAR;
            PG8_LDA(At, 1, 1); PG8_STAGE(PG8_SA(1, 0), a3, voffA);
            PG8_BAR; PG8_WAIT_L(0); PG8_MMA(1, 0, At, B0); PG8_BAR; PG8_SCHED;
            PG8_STAGE(PG8_SB(1, 1), b3 + hstepB, voffB);
            PG8_WAIT_V(6); PG8_BAR; PG8_MMA(1, 1, At, B1); PG8_BAR;
            }
        }
        if constexpr (ALIGN_EPI) { if (wr == 0) PG8_BAR; }
        if constexpr (!Epi::AFTER_DRAIN) { E(acc, cur, wr, wc, fr, fq); S.done(cur); }
        if (!has_next) break;
#pragma unroll
        for (int a = 0; a < 2; ++a)
#pragma unroll
            for (int b = 0; b < 2; ++b)
#pragma unroll
                for (int m = 0; m < 4; ++m)
#pragma unroll
                    for (int n = 0; n < 2; ++n) acc[a][b][m][n] = (f32x4){0.f, 0.f, 0.f, 0.f};
        cur = nxt; cA = nA; cB = nB; ++ui;
        if constexpr (ALIGN_EPI) { if (wr == 1) PG8_BAR; }
    }
    PG8_WAIT_V(0);
    if constexpr (!ALIGN_EPI) { if (wr == 0) PG8_BAR; }
    PG8_BAR;
    if constexpr (Epi::AFTER_DRAIN) { E.fused(acc, cur, wr, wc, fr, fq, lds, wid, lane); S.done(cur); }
#undef PG8_SA
#undef PG8_SB
#undef PG8_STAGE
#undef PG8_LDA
#undef PG8_LDB
#undef PG8_MMA
#undef PG8_WAIT_V
#undef PG8_WAIT_L
#undef PG8_BAR
#undef PG8_SCHED
}
}

#ifndef ONE_LAUNCH
#define ONE_LAUNCH 1
#endif
#define LAS __attribute__((address_space(3)))
typedef unsigned short bf16;
typedef unsigned u32x4 __attribute__((ext_vector_type(4)));
typedef unsigned u32x2 __attribute__((ext_vector_type(2)));
typedef float f32x4 __attribute__((ext_vector_type(4)));
typedef float f32x2 __attribute__((ext_vector_type(2)));
typedef short bf16x8 __attribute__((ext_vector_type(8)));
typedef __bf16 bf16x2_t __attribute__((ext_vector_type(2)));
typedef LAS unsigned char* ldsp;

constexpr int M = 49152, M0 = 32768, D = 1024, DIN = 4096;
constexpr float EPS = 1e-6f;
constexpr int PC_YA = 0, PC_YB = 256, PC_YC = 512;
constexpr int NSEG = 192, SEGC = 4;
constexpr size_t MiB = 1u << 20;
constexpr size_t WS_PART = 0, WS_LOGD = 3 * MiB, WS_BT1 = 4 * MiB, WS_BT2 = 20 * MiB, WS_PWT = 24 * MiB, WS_SGW = 24 * MiB + 256 * 1024;
constexpr size_t OUT_ST = 96 * MiB;
constexpr size_t WS_XB = 26 * MiB, WS_Y = 122 * MiB, WS_GLU = 218 * MiB, WS_BU = 242 * MiB, WS_BV = 266 * MiB, WS_HQ = 290 * MiB, WS_END = 482 * MiB;
constexpr unsigned HARR = 48u << 20, HHEAD = (unsigned)M * 256u;
constexpr int LDS_BYTES = 147456, LDS_BARST = 145408;
constexpr size_t WS_BAR = 3 * MiB + 896 * 1024;
constexpr int NPH = 12;

struct Params {
    const float *xp, *xs, *norm_g, *w_in, *conv_w, *conv_b, *conv_ln_g, *conv_ln_b, *conv_pw, *sgu_ln_g, *sgu_ln_b, *sgu_w, *sgu_b, *lb_f, *lb_b, *hgrn_g, *w_out, *final_g;
    float* out; unsigned char* ws; int ph_lo, ph_hi;
};

__device__ __forceinline__ float bf2f(bf16 b) { return __uint_as_float((unsigned)b << 16); }
__device__ __forceinline__ float bflo(unsigned w) { return __uint_as_float(w << 16); }
__device__ __forceinline__ float bfhi(unsigned w) { return __uint_as_float(w & 0xffff0000u); }
__device__ __forceinline__ unsigned pk2(float lo, float hi) { f32x2 v = {lo, hi}; bf16x2_t b = __builtin_convertvector(v, bf16x2_t); return __builtin_bit_cast(unsigned, b); }
__device__ __forceinline__ bf16 f2bf(float x) { return (bf16)(pk2(x, 0.f) & 0xffffu); }
__device__ __forceinline__ float sigmoidf_(float x) { return __builtin_amdgcn_rcpf(1.f + __expf(-x)); }
__device__ __forceinline__ float siluf_(float x) { return x * sigmoidf_(x); }
__device__ __forceinline__ float wave_sum(float v) {
#pragma unroll
    for (int o = 1; o < 64; o <<= 1) v += __shfl_xor(v, o);
    return v;
}
__device__ __forceinline__ bf16x8 mk8(unsigned a, unsigned b, unsigned c, unsigned d) { u32x4 v = {a, b, c, d}; return __builtin_bit_cast(bf16x8, v); }
#define LBAR() asm volatile("s_waitcnt lgkmcnt(0)\n\ts_barrier" ::: "memory")
#define MFMA16(a, b, c) __builtin_amdgcn_mfma_f32_16x16x32_bf16((a), (b), (c), 0, 0, 0)

struct Epi1 {
    static constexpr bool PERM = true, AFTER_DRAIN = false;
    unsigned char* ws; const float* part;
    __device__ __forceinline__ void operator()(const pg8::f32x4 (&acc)[2][2][4][2], const pg8::Unit& u, int wr, int wc, int fr, int fq) const {
        const int row0 = u.pm * 256 + wr * 64 + fr; const int pn = u.pn;
        const int cw = wc * 32 + 8 * fq;
#pragma unroll
        for (int ai = 0; ai < 2; ++ai)
#pragma unroll
            for (int m = 0; m < 4; ++m) {
                const int r = row0 + ai * 128 + m * 16;
                float s = 0.f;
#pragma unroll
                for (int q = 0; q < 4; ++q) s += part[(size_t)(4 * fq + q) * M + r];
                s += __shfl_xor(s, 16); s += __shfl_xor(s, 32);
                const float rs = __builtin_amdgcn_rsqf(s * (1.f / D) + EPS);
                if (pn < 2) {
                    f32x4 a0 = acc[ai][0][m][0] * rs, a1 = acc[ai][0][m][1] * rs, g0 = acc[ai][1][m][0] * rs, g1 = acc[ai][1][m][1] * rs;
                    u32x4 w;
                    w.x = pk2(a0[0] * sigmoidf_(g0[0]), a0[1] * sigmoidf_(g0[1])); w.y = pk2(a0[2] * sigmoidf_(g0[2]), a0[3] * sigmoidf_(g0[3]));
                    w.z = pk2(a1[0] * sigmoidf_(g1[0]), a1[1] * sigmoidf_(g1[1])); w.w = pk2(a1[2] * sigmoidf_(g1[2]), a1[3] * sigmoidf_(g1[3]));
                    *(u32x4*)((bf16*)(ws + WS_GLU) + (size_t)r * 256 + 128 * pn + cw) = w;
                } else {
#pragma unroll
                    for (int bj = 0; bj < 2; ++bj) {
                        f32x4 v0 = acc[ai][bj][m][0] * rs, v1 = acc[ai][bj][m][1] * rs;
                        if (pn < 6) {
#pragma unroll
                            for (int e = 0; e < 4; ++e) { v0[e] = siluf_(v0[e]); v1[e] = siluf_(v1[e]); }
                        } else if (pn < 8) {
                            f32x2 a = pg8::gelu_pk((f32x2){v0[0], v0[1]}), b = pg8::gelu_pk((f32x2){v0[2], v0[3]}), c = pg8::gelu_pk((f32x2){v1[0], v1[1]}), d = pg8::gelu_pk((f32x2){v1[2], v1[3]});
                            v0 = (f32x4){a.x, a.y, b.x, b.y}; v1 = (f32x4){c.x, c.y, d.x, d.y};
                        }
                        u32x4 w; w.x = pk2(v0[0], v0[1]); w.y = pk2(v0[2], v0[3]); w.z = pk2(v1[0], v1[1]); w.w = pk2(v1[2], v1[3]);
                        bf16* dst;
                        if (pn < 6) dst = (bf16*)(ws + WS_Y) + (size_t)r * 1024 + 256 * (pn - 2) + 128 * bj + cw;
                        else if (pn < 8) dst = (bf16*)(ws + (pn == 6 ? WS_BU : WS_BV)) + (size_t)r * 256 + 128 * bj + cw;
                        else dst = (bf16*)(ws + WS_HQ + (size_t)((pn - 8) >> 1) * HARR + (size_t)(2 * ((pn - 8) & 1) + bj) * HHEAD) + (size_t)r * 128 + cw;
                        *(u32x4*)dst = w;
                    }
                }
            }
    }
};
struct Epi2 {
    static constexpr bool PERM = true, AFTER_DRAIN = false;
    const float* xin0; const float* xin1; int split; const bf16* xinb; float* xout; bf16* XB; float* part;
    __device__ __forceinline__ void operator()(const pg8::f32x4 (&acc)[2][2][4][2], const pg8::Unit& u, int wr, int wc, int fr, int fq) const {
        const int row0 = u.pm * 256 + wr * 64 + fr; const int pn = u.pn;
        const int cw = pn * 256 + wc * 32 + 8 * fq;
#pragma unroll
        for (int ai = 0; ai < 2; ++ai)
#pragma unroll
            for (int m = 0; m < 4; ++m) {
                const int r = row0 + ai * 128 + m * 16;
                const float* src = (r < split) ? xin0 + (size_t)r * D : xin1 + (size_t)(r - split) * D;
                float ss = 0.f;
#pragma unroll
                for (int bj = 0; bj < 2; ++bj) {
                    const int col = cw + 128 * bj;
                    f32x4 v0, v1;
                    if (xinb) { const u32x4 t = *(const u32x4*)(xinb + (size_t)r * D + col); v0 = (f32x4){bflo(t.x), bfhi(t.x), bflo(t.y), bfhi(t.y)}; v1 = (f32x4){bflo(t.z), bfhi(t.z), bflo(t.w), bfhi(t.w)}; }
                    else { v0 = *(const f32x4*)(src + col); v1 = *(const f32x4*)(src + col + 4); }
                    v0 = v0 + acc[ai][bj][m][0]; v1 = v1 + acc[ai][bj][m][1];
                    if (xout) { *(f32x4*)(xout + (size_t)r * D + col) = v0; *(f32x4*)(xout + (size_t)r * D + col + 4) = v1; }
                    ss += (v0[0] * v0[0] + v0[1] * v0[1]) + (v0[2] * v0[2] + v0[3] * v0[3]) + (v1[0] * v1[0] + v1[1] * v1[1]) + (v1[2] * v1[2] + v1[3] * v1[3]);
                    { u32x4 w; w.x = pk2(v0[0], v0[1]); w.y = pk2(v0[2], v0[3]); w.z = pk2(v1[0], v1[1]); w.w = pk2(v1[2], v1[3]); *(u32x4*)(XB + (size_t)r * D + col) = w; }
                }
                ss += __shfl_xor(ss, 16); ss += __shfl_xor(ss, 32);
                if (fq == 0) part[(size_t)(pn * 4 + wc) * M + r] = ss;
            }
    }
};

__device__ __forceinline__ int srcmap128(int b) {
    if (b < 4) return ((b & 1) ? 256 : 0) + 128 * (b >> 1);
    if (b < 6) return 512 + 128 * (b - 4);
    if (b < 8) return 1280 + 128 * (b - 6);
    if (b < 12) return 3584 + 128 * (b - 8);
    if (b < 14) return 768 + 128 * (b - 12);
    if (b < 16) return 1024 + 128 * (b - 14);
    if (b < 20) return 1536 + 128 * (b - 16);
    if (b < 24) return 2048 + 128 * (b - 20);
    if (b < 28) return 2560 + 128 * (b - 24);
    return 3072 + 128 * (b - 28);
}
__device__ __forceinline__ void tr_item(const float* W, int N, int sc0, const float* gk, int k0, bf16* WT, int K, int drow0, LAS float* scr, int lane) {
    float v[64];
#pragma unroll
    for (int kk = 0; kk < 64; ++kk) v[kk] = W[(size_t)(k0 + kk) * N + sc0 + lane];
    if (gk) {
#pragma unroll
        for (int kk = 0; kk < 64; ++kk) v[kk] *= gk[k0 + kk]; }
#pragma unroll
    for (int kk = 0; kk < 64; ++kk) scr[kk * 65 + lane] = v[kk];
    asm volatile("s_waitcnt lgkmcnt(0)" ::: "memory");
    const int c = lane & 7;
#pragma unroll
    for (int j = 0; j < 8; ++j) { const int n = (lane >> 3) + 8 * j; const LAS float* s = scr + (8 * c) * 65 + n;
        u32x4 o; o.x = pk2(s[0 * 65], s[1 * 65]); o.y = pk2(s[2 * 65], s[3 * 65]); o.z = pk2(s[4 * 65], s[5 * 65]); o.w = pk2(s[6 * 65], s[7 * 65]);
        *(u32x4*)(WT + (size_t)(drow0 + n) * K + k0 + 8 * c) = o; }
    asm volatile("s_waitcnt lgkmcnt(0)" ::: "memory");
}
__device__ __forceinline__ void prologue(ldsp lds, const Params& p) {
    const int tid = ltid(), lane = tid & 63, wave = __builtin_amdgcn_readfirstlane(tid >> 6);
    const int gw = blockIdx.x * 8 + wave, NGW = gridDim.x * 8;
    LAS float* scr = (LAS float*)(lds + wave * 16640);
    unsigned char* ws = p.ws;
    constexpr int I_IN = 16 * 64, I_OUT = 16 * 16, I_PW = 4 * 4, I_L = I_IN + I_OUT + I_PW;
    for (int it = gw; it < 2 * I_L; it += NGW) {
        const int l = it / I_L; int r = it - l * I_L;
        if (r < I_IN) { const int kb = r >> 6, nb = r & 63; tr_item(p.w_in + (size_t)l * D * DIN, DIN, srcmap128(nb >> 1) + 64 * (nb & 1), p.norm_g + l * D, 64 * kb, (bf16*)(ws + WS_BT1) + (size_t)l * DIN * D, D, 64 * nb, scr, lane); continue; }
        r -= I_IN;
        if (r < I_OUT) { const int kb = r >> 4, nb = r & 15; tr_item(p.w_out + (size_t)l * D * D, D, 64 * nb, nullptr, 64 * kb, (bf16*)(ws + WS_BT2) + (size_t)l * D * D, D, 64 * nb, scr, lane); continue; }
        r -= I_OUT;
        { const int kb = r >> 2, nb = r & 3; tr_item(p.conv_pw + (size_t)l * 65536, 256, 64 * nb, nullptr, 64 * kb, (bf16*)(ws + WS_PWT) + (size_t)l * 65536, 256, 64 * nb, scr, lane); }
    }
    { const int gt = blockIdx.x * 512 + tid, NT = gridDim.x * 512; bf16* o = (bf16*)(ws + WS_SGW);
      for (int i = gt; i < 2 * 4 * 128 * 128 / 4; i += NT) { const f32x4 v = *(const f32x4*)(p.sgu_w + 4 * (size_t)i); u32x2 w; w.x = pk2(v[0], v[1]); w.y = pk2(v[2], v[3]); *(u32x2*)(o + 4 * (size_t)i) = w; } }
    bf16* XB = (bf16*)(ws + WS_XB); float* part = (float*)(ws + WS_PART);
    for (int r = gw; r < M; r += 4 * NGW) {
        f32x4 v[4][4];
#pragma unroll
        for (int u = 0; u < 4; ++u) { const int rr = r + u * NGW; if (rr < M) { const float* src = (rr < M0) ? p.xp + (size_t)rr * D : p.xs + (size_t)(rr - M0) * D;
#pragma unroll
            for (int j = 0; j < 4; ++j) v[u][j] = ((const f32x4*)src)[lane + 64 * j]; } }
#pragma unroll
        for (int u = 0; u < 4; ++u) { const int rr = r + u * NGW; if (rr < M) { float s = 0.f;
            unsigned long long* o8 = (unsigned long long*)(XB + (size_t)rr * D) + lane;
#pragma unroll
            for (int j = 0; j < 4; ++j) { const f32x4 t = v[u][j]; s += (t[0] * t[0] + t[1] * t[1]) + (t[2] * t[2] + t[3] * t[3]); o8[64 * j] = (unsigned long long)pk2(t[0], t[1]) | ((unsigned long long)pk2(t[2], t[3]) << 32); }
            s = wave_sum(s);
            if (lane < 16) part[(size_t)lane * M + rr] = lane == 0 ? s : 0.f; } }
    }
}

__device__ __forceinline__ void final_norm(const Params& p) {
    const int tid = ltid(), lane = tid & 63, wave = tid >> 6;
    const int gw = blockIdx.x * 8 + wave, NGW = gridDim.x * 8;
    const float* part = (const float*)(p.ws + WS_PART);
    f32x4 g[4];
#pragma unroll
    for (int j = 0; j < 4; ++j) g[j] = *((const f32x4*)p.final_g + lane + 64 * j);
    const bf16* XB = (const bf16*)(p.ws + WS_XB);
    for (int r = gw; r < M; r += 4 * NGW) {
        u32x2 v[4][4]; float s[4];
#pragma unroll
        for (int u = 0; u < 4; ++u) { const int rr = r + u * NGW; if (rr < M) { s[u] = lane < 16 ? part[(size_t)lane * M + rr] : 0.f;
#pragma unroll
            for (int j = 0; j < 4; ++j) v[u][j] = ((const u32x2*)(XB + (size_t)rr * D))[lane + 64 * j]; } }
#pragma unroll
        for (int u = 0; u < 4; ++u) { const int rr = r + u * NGW; if (rr < M) { const float rs = __builtin_amdgcn_rsqf(wave_sum(s[u]) * (1.f / D) + EPS);
#pragma unroll
            for (int j = 0; j < 4; ++j) { const f32x4 x = {bflo(v[u][j].x), bfhi(v[u][j].x), bflo(v[u][j].y), bfhi(v[u][j].y)}; ((f32x4*)(p.out + (size_t)rr * D))[lane + 64 * j] = x * rs * g[j]; } } }
    }
}

constexpr int L_LNP = 122880;
#define CONV_LOAD_IN(inr_, item_, tid_) do { const int r0_ = (item_) * 64; int s0_, s1_; if (r0_ < M0) { s0_ = r0_ & ~8191; s1_ = s0_ + 8192; } else { s0_ = M0 + ((r0_ - M0) & ~4095); s1_ = s0_ + 4096; } \
    _Pragma("unroll") for (int k_ = 0; k_ < 6; ++k_) { const int idx_ = (tid_) + 512 * k_, row_ = idx_ >> 5, c16_ = idx_ & 31, gr_ = r0_ - 15 + row_; \
        u32x4 v_ = {0u, 0u, 0u, 0u}; if (idx_ < 94 * 32 && gr_ >= s0_ && gr_ < s1_) v_ = *(const u32x4*)((const bf16*)(p.ws + WS_GLU) + (size_t)gr_ * 256 + c16_ * 8); (inr_)[k_] = v_; } } while (0)
__device__ __forceinline__ void conv_item(ldsp lds, int item, int layer, const Params& p, const f32x2 (&w2)[31], const f32x2 bb2, u32x4 (&inr)[6], int next_item) {
    const int tid = ltid(), lane = tid & 63, w = __builtin_amdgcn_readfirstlane(tid >> 6), r16 = lane & 15, quad = lane >> 4;
    const int r0 = item * 64;
    const bf16* pwT = (const bf16*)(p.ws + WS_PWT) + (size_t)layer * 65536;
    ldsp IN = lds;
    LAS float* CV = (LAS float*)(lds + 49152);
    ldsp AO = lds;
#pragma unroll
    for (int k = 0; k < 6; ++k) { const int idx = tid + 512 * k, row = idx >> 5, c16 = idx & 31; if (idx < 94 * 32) *(LAS u32x4*)(IN + row * 512 + c16 * 16) = inr[k]; }
    u32x2 gpre[4][2];
#pragma unroll
    for (int m = 0; m < 4; ++m)
#pragma unroll
        for (int nt = 0; nt < 2; ++nt) gpre[m][nt] = *(const u32x2*)((const bf16*)(p.ws + WS_Y) + (size_t)(r0 + 16 * m + r16) * 1024 + PC_YA + 32 * w + 16 * nt + 4 * quad);
    LBAR();
    {
        const int cp = tid & 127, qtr = tid >> 7;
#pragma unroll 1
        for (int ob = 0; ob < 2; ++ob) {
            const int t0 = 16 * qtr + 8 * ob;
            f32x2 x[38];
#pragma unroll
            for (int i = 0; i < 38; ++i) { const unsigned u = *(LAS unsigned*)(IN + (t0 + i) * 512 + cp * 4); x[i] = (f32x2){bflo(u), bfhi(u)}; }
            f32x2 a0[8];
#pragma unroll
            for (int o = 0; o < 8; ++o) a0[o] = bb2;
#pragma unroll
            for (int j = 0; j < 31; ++j)
#pragma unroll
                for (int o = 0; o < 8; ++o) a0[o] = x[o + j] * w2[j] + a0[o];
#pragma unroll
            for (int o = 0; o < 8; ++o) *(LAS f32x2*)(CV + (t0 + o) * 288 + 2 * cp) = a0[o];
        }
    }
    LBAR();
    bf16x8 pwf[8][2];
#pragma unroll
    for (int kk = 0; kk < 8; ++kk) { pwf[kk][0] = *(const bf16x8*)(pwT + (size_t)(32 * w + r16) * 256 + 32 * kk + 8 * quad); pwf[kk][1] = *(const bf16x8*)(pwT + (size_t)(32 * w + 16 + r16) * 256 + 32 * kk + 8 * quad); }
    {
        const int tok = tid >> 3, part = tid & 7;
        f32x4 v[8]; float s = 0.f;
#pragma unroll
        for (int i = 0; i < 8; ++i) { v[i] = *(LAS f32x4*)(CV + tok * 288 + 32 * i + 4 * part); s += (v[i][0] + v[i][1]) + (v[i][2] + v[i][3]); }
        s += __shfl_xor(s, 1); s += __shfl_xor(s, 2); s += __shfl_xor(s, 4);
        const float mean = s * (1.f / 256.f); float q = 0.f;
#pragma unroll
        for (int i = 0; i < 8; ++i) { v[i] = v[i] - mean; q += (v[i][0] * v[i][0] + v[i][1] * v[i][1]) + (v[i][2] * v[i][2] + v[i][3] * v[i][3]); }
        q += __shfl_xor(q, 1); q += __shfl_xor(q, 2); q += __shfl_xor(q, 4);
        const float rstd = __builtin_amdgcn_rsqf(q * (1.f / 256.f) + EPS);
#pragma unroll
        for (int i = 0; i < 8; ++i) { const int c = 32 * i + 4 * part; const f32x4 gg = *(LAS f32x4*)(lds + L_LNP + c * 4), bb = *(LAS f32x4*)(lds + L_LNP + 1024 + c * 4);
            f32x4 y = v[i] * rstd * gg + bb;
            u32x2 o; o.x = pk2(siluf_(y[0]), siluf_(y[1])); o.y = pk2(siluf_(y[2]), siluf_(y[3]));
            *(LAS u32x2*)(AO + tok * 528 + c * 2) = o; }
    }
    LBAR();
    { const int nit = next_item >= 0 ? next_item : item; CONV_LOAD_IN(inr, nit, tid); }
    {
        f32x4 acc[4][2];
#pragma unroll
        for (int m = 0; m < 4; ++m) { acc[m][0] = (f32x4){0.f, 0.f, 0.f, 0.f}; acc[m][1] = (f32x4){0.f, 0.f, 0.f, 0.f}; }
#pragma unroll
        for (int kk = 0; kk < 8; ++kk) {
            const bf16x8 b0 = pwf[kk][0], b1 = pwf[kk][1]; bf16x8 af[4];
#pragma unroll
            for (int m = 0; m < 4; ++m) af[m] = *(LAS bf16x8*)(AO + (16 * m + r16) * 528 + (32 * kk + 8 * quad) * 2);
#pragma unroll
            for (int m = 0; m < 4; ++m) { acc[m][0] = MFMA16(b0, af[m], acc[m][0]); acc[m][1] = MFMA16(b1, af[m], acc[m][1]); }
        }
#pragma unroll
        for (int m = 0; m < 4; ++m)
#pragma unroll
            for (int nt = 0; nt < 2; ++nt) { bf16* gp = (bf16*)(p.ws + WS_Y) + (size_t)(r0 + 16 * m + r16) * 1024 + PC_YA + 32 * w + 16 * nt + 4 * quad;
                const u32x2 g = gpre[m][nt]; u32x2 o; o.x = pk2(acc[m][nt][0] * bflo(g.x), acc[m][nt][1] * bfhi(g.x)); o.y = pk2(acc[m][nt][2] * bflo(g.y), acc[m][nt][3] * bfhi(g.y));
                *(u32x2*)gp = o; }
    }
    LBAR();
}

__device__ __forceinline__ void sgu_item(ldsp lds, int item, int layer, const Params& p) {
    const int tid = ltid(), lane = tid & 63, w = __builtin_amdgcn_readfirstlane(tid >> 6), r16 = lane & 15, quad = lane >> 4;
    const int r0 = (item >> 1) * 128, hp = item & 1;
    const bf16* SW = (const bf16*)(p.ws + WS_SGW) + (size_t)layer * 65536; const float* sb = p.sgu_b + layer * 512;
    ldsp VT = lds;
    u32x2 upre[2][4], gpre[2][4];
    bf16x8 wfp[2][4];
    { const int h = 2 * hp + (w >> 2), tq = w & 3;
#pragma unroll
      for (int tti = 0; tti < 2; ++tti)
#pragma unroll
          for (int kk = 0; kk < 4; ++kk) wfp[tti][kk] = *(const bf16x8*)(SW + (size_t)(h * 128 + 16 * (2 * tq + tti) + r16) * 128 + 32 * kk + 8 * quad);
#pragma unroll
      for (int tti = 0; tti < 2; ++tti)
#pragma unroll
          for (int dt = 0; dt < 4; ++dt) { const size_t row = (size_t)(r0 + 16 * (2 * tq + tti) + r16); const int ch = h * 64 + 16 * dt + 4 * quad;
              upre[tti][dt] = *(const u32x2*)((const bf16*)(p.ws + WS_BU) + row * 256 + ch); gpre[tti][dt] = *(const u32x2*)((const bf16*)(p.ws + WS_Y) + row * 1024 + PC_YB + ch); } }
    {
        const int tok = tid >> 2, part = tid & 3;
        const bf16* src = (const bf16*)(p.ws + WS_BV) + (size_t)(r0 + tok) * 256;
        float v[64]; float s = 0.f;
#pragma unroll
        for (int i = 0; i < 8; ++i) { const u32x4 t = *(const u32x4*)(src + 32 * i + 8 * part);
            v[8 * i + 0] = bflo(t.x); v[8 * i + 1] = bfhi(t.x); v[8 * i + 2] = bflo(t.y); v[8 * i + 3] = bfhi(t.y); v[8 * i + 4] = bflo(t.z); v[8 * i + 5] = bfhi(t.z); v[8 * i + 6] = bflo(t.w); v[8 * i + 7] = bfhi(t.w); }
#pragma unroll
        for (int i = 0; i < 64; ++i) s += v[i];
        s += __shfl_xor(s, 1); s += __shfl_xor(s, 2);
        const float mean = s * (1.f / 256.f); float q = 0.f;
#pragma unroll
        for (int i = 0; i < 64; ++i) { v[i] -= mean; q += v[i] * v[i]; }
        q += __shfl_xor(q, 1); q += __shfl_xor(q, 2);
        const float rstd = __builtin_amdgcn_rsqf(q * (1.f / 256.f) + EPS);
        const bool odd = tok & 1;
        unsigned own[16];
#pragma unroll
        for (int i = 0; i < 8; ++i) {
            if ((i >> 2) != hp) continue;
            const int cbp = (32 * i + 8 * part) * 4;
            const f32x4 g0 = *(LAS f32x4*)(lds + L_LNP + 2048 + cbp), g1 = *(LAS f32x4*)(lds + L_LNP + 2048 + cbp + 16), b0 = *(LAS f32x4*)(lds + L_LNP + 3072 + cbp), b1 = *(LAS f32x4*)(lds + L_LNP + 3072 + cbp + 16);
            own[(i & 3) * 4 + 0] = pk2(v[8 * i + 0] * rstd * g0[0] + b0[0], v[8 * i + 1] * rstd * g0[1] + b0[1]);
            own[(i & 3) * 4 + 1] = pk2(v[8 * i + 2] * rstd * g0[2] + b0[2], v[8 * i + 3] * rstd * g0[3] + b0[3]);
            own[(i & 3) * 4 + 2] = pk2(v[8 * i + 4] * rstd * g1[0] + b1[0], v[8 * i + 5] * rstd * g1[1] + b1[1]);
            own[(i & 3) * 4 + 3] = pk2(v[8 * i + 6] * rstd * g1[2] + b1[2], v[8 * i + 7] * rstd * g1[3] + b1[3]);
        }
        unsigned oth[16];
#pragma unroll
        for (int k = 0; k < 16; ++k) oth[k] = (unsigned)__shfl_xor((int)own[k], 4);
#pragma unroll
        for (int k = 0; k < 16; ++k) {
            const int cb = 32 * (4 * hp + (k >> 2)) + 8 * part, e2 = 2 * (k & 3);
            const unsigned val = odd ? ((oth[k] >> 16) | (own[k] & 0xffff0000u)) : ((own[k] & 0xffffu) | (oth[k] << 16));
            const int ch = cb + e2 + (odd ? 1 : 0), t0 = tok & ~1;
            *(LAS unsigned*)(VT + ch * 272 + t0 * 2) = val;
        }
    }
    LBAR();
    {
        const int h = 2 * hp + (w >> 2), tq = w & 3;
        bf16x8 vf[4][4];
#pragma unroll
        for (int dt = 0; dt < 4; ++dt)
#pragma unroll
            for (int kk = 0; kk < 4; ++kk) vf[dt][kk] = *(LAS bf16x8*)(VT + (h * 64 + 16 * dt + r16) * 272 + (32 * kk + 8 * quad) * 2);
#pragma unroll
        for (int tti = 0; tti < 2; ++tti) {
            const int tt = 2 * tq + tti;
            bf16x8 wf[4];
#pragma unroll
            for (int kk = 0; kk < 4; ++kk) wf[kk] = wfp[tti][kk];
            f32x4 acc[4];
#pragma unroll
            for (int dt = 0; dt < 4; ++dt) { acc[dt] = (f32x4){0.f, 0.f, 0.f, 0.f};
#pragma unroll
                for (int kk = 0; kk < 4; ++kk) acc[dt] = MFMA16(vf[dt][kk], wf[kk], acc[dt]); }
            const float bias = sb[h * 128 + 16 * tt + r16];
            bf16* rowy = (bf16*)(p.ws + WS_Y) + (size_t)(r0 + 16 * tt + r16) * 1024; const bf16* rowu = (const bf16*)(p.ws + WS_BU) + (size_t)(r0 + 16 * tt + r16) * 256;
#pragma unroll
            for (int dt = 0; dt < 4; ++dt) { const int ch = h * 64 + 16 * dt + 4 * quad;
                const u32x2 uu = upre[tti][dt], g = gpre[tti][dt]; u32x2 o;
                o.x = pk2(bflo(uu.x) * (acc[dt][0] + bias) * bflo(g.x), bfhi(uu.x) * (acc[dt][1] + bias) * bfhi(g.x));
                o.y = pk2(bflo(uu.y) * (acc[dt][2] + bias) * bflo(g.y), bfhi(uu.y) * (acc[dt][3] + bias) * bfhi(g.y));
                *(u32x2*)(rowy + PC_YB + ch) = o; }
        }
    }
    LBAR();
}

constexpr int H_QD = 0, H_KD = 17408, H_KO = 34816, H_Q3 = 52224, H_K0 = 56576, H_KST = 60928, H_VT = 79360, H_SC = 97792, H_TT = 107008, H_ER = 109056, H_DEC = 111104, H_OS = 111616;

__device__ __forceinline__ void score_tile(ldsp lds, int qoff, int koff, int ti, int sj, bool diag, int r16, int quad) {
    f32x4 acc = {0.f, 0.f, 0.f, 0.f};
    bf16x8 ka[4], qa[4];
#pragma unroll
    for (int kk = 0; kk < 4; ++kk) { ka[kk] = *(LAS bf16x8*)(lds + koff + r16 * 272 + (32 * kk + 8 * quad) * 2); qa[kk] = *(LAS bf16x8*)(lds + qoff + r16 * 272 + (32 * kk + 8 * quad) * 2); }
#pragma unroll
    for (int kk = 0; kk < 4; ++kk) acc = MFMA16(ka[kk], qa[kk], acc);
    if (diag) {
#pragma unroll
        for (int e = 0; e < 4; ++e) if (4 * quad + e > r16) acc[e] = 0.f;
    }
    u32x2 o; o.x = pk2(acc[0], acc[1]); o.y = pk2(acc[2], acc[3]);
    *(LAS u32x2*)(lds + H_SC + (16 * ti + r16) * 144 + (16 * sj + 4 * quad) * 2) = o;
}

__device__ __forceinline__ void gate_fk(float z, float lbv, float oml, float& f, float& kk) {
    z = fmaxf(z, -30.f);
    const float e = __expf(-z), s = __builtin_amdgcn_rcpf(1.f + e);
    f = oml * s + lbv; kk = oml * e * s;
}
constexpr int H_T8 = 113664, H_QS = 117760;
#define HG_TOK(c0_, i_) (dir ? (c0_) + 63 - 8 * w - (i_) : (c0_) + 8 * w + (i_))
#define HG_LD(arr_, c0_, i_) (*(const unsigned*)(Pb + ((unsigned)HG_TOK(c0_, i_) * 256u + (arr_))))

constexpr int A_KST = 0, A_VT = 34816, A_T8 = 69632, A_DEC = 73728;
#define HGA_LD(arr_, c0_, i_) (*(const unsigned*)(Pb + ((unsigned)(dir ? (c0_) + 127 - 16 * w - (i_) : (c0_) + 16 * w + (i_)) * 256u + (arr_))))
template <int DIR> __device__ __forceinline__ void hgrn_passA_dir(ldsp lds, int item, int layer, const Params& p) {
    const int tid = ltid(), lane = tid & 63, w = __builtin_amdgcn_readfirstlane(tid >> 6), r16 = lane & 15, quad = lane >> 4;
    constexpr int dir = DIR; const int h = (item >> 1) & 3, sg = item >> 3; const int slot = item;
    const int kp = lane;
    float lb0 = 0.f, lb1 = 0.f;
    if (layer) { const float* lp = dir ? p.lb_b : p.lb_f; const f32x2 a = *(const f32x2*)(lp + 512 + h * 128 + 2 * kp), b = *(const f32x2*)(lp + h * 128 + 2 * kp); lb0 = sigmoidf_(a.x - b.x); lb1 = sigmoidf_(a.y - b.y); }
    const float om0 = 1.f - lb0, om1 = 1.f - lb1;
    f32x4 S[8];
#pragma unroll
    for (int m = 0; m < 8; ++m) S[m] = (f32x4){0.f, 0.f, 0.f, 0.f};
    float pd0 = 1.f, pd1 = 1.f;
    const unsigned char* Pb = p.ws + WS_HQ; const unsigned az = (dir ? 3u : 2u) * HARR + (unsigned)h * HHEAD + kp * 4u, av = HARR + (unsigned)h * HHEAD + kp * 4u;
    unsigned zr[16];
    { const int c0 = sg * 256 + (dir ? 128 : 0);
#pragma unroll
      for (int i = 0; i < 16; ++i) zr[i] = HGA_LD(az, c0, i); }
#pragma unroll 1
    for (int cc = 0; cc < 2; ++cc) {
        unsigned vr[16];
        { const int c0 = sg * 256 + ((dir != 0) == (cc == 0) ? 128 : 0);
#pragma unroll
          for (int i = 0; i < 16; ++i) vr[i] = HGA_LD(av, c0, i); }
        float ks0[16], ks1[16]; float E0 = 1.f, E1 = 1.f;
#pragma unroll
        for (int i = 15; i >= 0; --i) { float f0, f1, k0, k1; gate_fk(bflo(zr[i]), lb0, om0, f0, k0); gate_fk(bfhi(zr[i]), lb1, om1, f1, k1); ks0[i] = k0 * E0; ks1[i] = k1 * E1; E0 *= f0; E1 *= f1; }
        *(LAS f32x2*)(lds + A_T8 + (w * 128 + 2 * kp) * 4) = (f32x2){E0, E1};
#pragma unroll
        for (int hf = 0; hf < 2; ++hf) {
            *(LAS u32x4*)(lds + A_VT + (2 * kp) * 272 + 32 * w + 16 * hf) = (u32x4){__builtin_amdgcn_perm(vr[8 * hf + 1], vr[8 * hf + 0], 0x05040100u), __builtin_amdgcn_perm(vr[8 * hf + 3], vr[8 * hf + 2], 0x05040100u), __builtin_amdgcn_perm(vr[8 * hf + 5], vr[8 * hf + 4], 0x05040100u), __builtin_amdgcn_perm(vr[8 * hf + 7], vr[8 * hf + 6], 0x05040100u)};
            *(LAS u32x4*)(lds + A_VT + (2 * kp + 1) * 272 + 32 * w + 16 * hf) = (u32x4){__builtin_amdgcn_perm(vr[8 * hf + 1], vr[8 * hf + 0], 0x07060302u), __builtin_amdgcn_perm(vr[8 * hf + 3], vr[8 * hf + 2], 0x07060302u), __builtin_amdgcn_perm(vr[8 * hf + 5], vr[8 * hf + 4], 0x07060302u), __builtin_amdgcn_perm(vr[8 * hf + 7], vr[8 * hf + 6], 0x07060302u)}; }
        if (cc == 0) { const int c0 = sg * 256 + (dir ? 0 : 128);
#pragma unroll
            for (int i = 0; i < 16; ++i) zr[i] = HGA_LD(az, c0, i); }
        LBAR();
        float fa0 = 1.f, fa1 = 1.f, d0 = 1.f, d1 = 1.f;
#pragma unroll
        for (int g = 0; g < 8; ++g) { const f32x2 t = *(LAS f32x2*)(lds + A_T8 + (g * 128 + 2 * kp) * 4); d0 *= t.x; d1 *= t.y; if (g > w) { fa0 *= t.x; fa1 *= t.y; } }
#pragma unroll
        for (int hf = 0; hf < 2; ++hf) {
            *(LAS u32x4*)(lds + A_KST + (2 * kp) * 272 + 32 * w + 16 * hf) = (u32x4){pk2(ks0[8 * hf + 0] * fa0, ks0[8 * hf + 1] * fa0), pk2(ks0[8 * hf + 2] * fa0, ks0[8 * hf + 3] * fa0), pk2(ks0[8 * hf + 4] * fa0, ks0[8 * hf + 5] * fa0), pk2(ks0[8 * hf + 6] * fa0, ks0[8 * hf + 7] * fa0)};
            *(LAS u32x4*)(lds + A_KST + (2 * kp + 1) * 272 + 32 * w + 16 * hf) = (u32x4){pk2(ks1[8 * hf + 0] * fa1, ks1[8 * hf + 1] * fa1), pk2(ks1[8 * hf + 2] * fa1, ks1[8 * hf + 3] * fa1), pk2(ks1[8 * hf + 4] * fa1, ks1[8 * hf + 5] * fa1), pk2(ks1[8 * hf + 6] * fa1, ks1[8 * hf + 7] * fa1)}; }
        if (w == 0) { *(LAS f32x2*)(lds + A_DEC + 2 * kp * 4) = (f32x2){d0, d1}; pd0 *= d0; pd1 *= d1; }
        LBAR();
        bf16x8 vf[4];
#pragma unroll
        for (int kk = 0; kk < 4; ++kk) vf[kk] = *(LAS bf16x8*)(lds + A_VT + (16 * w + r16) * 272 + (32 * kk + 8 * quad) * 2);
#pragma unroll
        for (int mh = 0; mh < 4; ++mh) {
            bf16x8 af[2][4]; f32x4 dd[2];
#pragma unroll
            for (int mi = 0; mi < 2; ++mi) { const int m = 2 * mh + mi; dd[mi] = *(LAS f32x4*)(lds + A_DEC + (16 * m + 4 * quad) * 4);
#pragma unroll
                for (int kk = 0; kk < 4; ++kk) af[mi][kk] = *(LAS bf16x8*)(lds + A_KST + (16 * m + r16) * 272 + (32 * kk + 8 * quad) * 2); }
#pragma unroll
            for (int mi = 0; mi < 2; ++mi) { const int m = 2 * mh + mi; S[m] = S[m] * dd[mi];
#pragma unroll
                for (int kk = 0; kk < 4; ++kk) S[m] = MFMA16(af[mi][kk], vf[kk], S[m]); } }
        LBAR();
    }
    u32x4* sp = (u32x4*)((unsigned char*)p.out + OUT_ST + (size_t)slot * 32768) + (w * 64 + lane) * 4;
#pragma unroll
    for (int i = 0; i < 4; ++i) sp[i] = (u32x4){pk2(S[2 * i][0], S[2 * i][1]), pk2(S[2 * i][2], S[2 * i][3]), pk2(S[2 * i + 1][0], S[2 * i + 1][1]), pk2(S[2 * i + 1][2], S[2 * i + 1][3])};
    if (w == 0) *(f32x2*)((float*)(p.ws + WS_LOGD) + slot * 128 + 2 * kp) = (f32x2){pd0, pd1};
}
__device__ __forceinline__ void hgrn_passA_item(ldsp lds, int item, int layer, const Params& p) { if (item & 1) hgrn_passA_dir<1>(lds, item, layer, p); else hgrn_passA_dir<0>(lds, item, layer, p); }

__device__ __forceinline__ void hgrn_passB(const Params& p) {
    unsigned char* ST = (unsigned char*)p.out + OUT_ST; const float* LD = (const float*)(p.ws + WS_LOGD);
    const int gt = blockIdx.x * 512 + ltid(), NT = gridDim.x * 512;
#pragma unroll 1
    for (int e = gt; e < 64 * 4096; e += NT) {
        const int chain = e >> 12, q = e & 4095, m = q & 7, ln = (q >> 3) & 63, sq = chain >> 3, h = (chain >> 1) & 3, dir = chain & 1;
        const int kd = 16 * m + 4 * (ln >> 4);
        const int seg0 = sq < 4 ? sq * 32 : 128 + (sq - 4) * 16, n = sq < 4 ? 32 : 16;
        const int sgf = dir ? seg0 + n - 1 : seg0, step = dir ? -1 : 1;
        f32x4 carry = {0.f, 0.f, 0.f, 0.f};
#pragma unroll 1
        for (int s0 = 0; s0 < n; s0 += 16) {
            u32x2 loc[16]; f32x4 dd[16];
#pragma unroll
            for (int s = 0; s < 16; ++s) { const int slot = ((sgf + step * (s0 + s)) * 4 + h) * 2 + dir; loc[s] = *(const u32x2*)(ST + (size_t)slot * 32768 + q * 8); dd[s] = *(const f32x4*)(LD + slot * 128 + kd); }
#pragma unroll
            for (int s = 0; s < 16; ++s) { const int slot = ((sgf + step * (s0 + s)) * 4 + h) * 2 + dir;
                *(u32x2*)(ST + (size_t)slot * 32768 + q * 8) = (u32x2){pk2(carry[0], carry[1]), pk2(carry[2], carry[3])};
                carry = dd[s] * carry + (f32x4){bflo(loc[s].x), bfhi(loc[s].x), bflo(loc[s].y), bfhi(loc[s].y)}; }
        }
    }
}

template <int DIR> __device__ __forceinline__ void hgrn_passC_dir(ldsp lds, int item, int layer, const Params& p) {
    const int tid = ltid(), lane = tid & 63, w = __builtin_amdgcn_readfirstlane(tid >> 6), r16 = lane & 15, quad = lane >> 4;
    const int h = item & 3, sg = item >> 2;
    const int kp = lane;
    const f32x4 gn = *(const f32x4*)(p.hgrn_g + layer * 128 + 16 * w + 4 * quad);
    constexpr int dir = DIR;
    {
        const int slot = (sg * 4 + h) * 2 + dir;
        float lb0 = 0.f, lb1 = 0.f;
        if (layer) { const float* lp = dir ? p.lb_b : p.lb_f; const f32x2 a = *(const f32x2*)(lp + 512 + h * 128 + 2 * kp), b = *(const f32x2*)(lp + h * 128 + 2 * kp); lb0 = sigmoidf_(a.x - b.x); lb1 = sigmoidf_(a.y - b.y); }
        const float om0 = 1.f - lb0, om1 = 1.f - lb1;
        f32x4 S[8];
        { const u32x4* sp = (const u32x4*)((const unsigned char*)p.out + OUT_ST + (size_t)slot * 32768) + (w * 64 + lane) * 4;
#pragma unroll
          for (int i = 0; i < 4; ++i) { const u32x4 t = sp[i]; S[2 * i] = (f32x4){bflo(t.x), bfhi(t.x), bflo(t.y), bfhi(t.y)}; S[2 * i + 1] = (f32x4){bflo(t.z), bfhi(t.z), bflo(t.w), bfhi(t.w)}; } }
        unsigned char* Pb = p.ws + WS_HQ; bf16* Y = (bf16*)(p.ws + WS_Y);
        const unsigned aq = (unsigned)h * HHEAD + kp * 4u, az = (dir ? 3u : 2u) * HARR + (unsigned)h * HHEAD + kp * 4u, av = HARR + (unsigned)h * HHEAD + kp * 4u;
        const unsigned colo = 2u * HARR + (unsigned)h * HHEAD + (16 * w + 4 * quad) * 2u;
        unsigned zr[8], qr[8], vr[8];
        { const int c0 = sg * 256 + (dir ? (SEGC - 1) : 0) * 64;
#pragma unroll
          for (int i = 0; i < 8; ++i) { zr[i] = HG_LD(az, c0, i); qr[i] = HG_LD(aq, c0, i); vr[i] = HG_LD(av, c0, i); } }
#pragma unroll 1
        for (int cc = 0; cc < SEGC; ++cc) {
            const int c0 = sg * 256 + (dir ? (SEGC - 1 - cc) : cc) * 64;
            u32x2 ofr[4], ggr[4];
            {
                float el0[8], el1[8], kk0[8], kk1[8], q0[8], q1[8]; float E0 = 1.f, E1 = 1.f;
#pragma unroll
                for (int i = 0; i < 8; ++i) { float f0, f1; gate_fk(bflo(zr[i]), lb0, om0, f0, kk0[i]); gate_fk(bfhi(zr[i]), lb1, om1, f1, kk1[i]); E0 *= f0; E1 *= f1; el0[i] = E0; el1[i] = E1; q0[i] = bflo(qr[i]); q1[i] = bfhi(qr[i]); }
                *(LAS f32x2*)(lds + H_T8 + (w * 128 + 2 * kp) * 4) = (f32x2){E0, E1};
                *(LAS u32x4*)(lds + H_VT + (2 * kp) * 144 + 16 * w) = (u32x4){__builtin_amdgcn_perm(vr[1], vr[0], 0x05040100u), __builtin_amdgcn_perm(vr[3], vr[2], 0x05040100u), __builtin_amdgcn_perm(vr[5], vr[4], 0x05040100u), __builtin_amdgcn_perm(vr[7], vr[6], 0x05040100u)};
                *(LAS u32x4*)(lds + H_VT + (2 * kp + 1) * 144 + 16 * w) = (u32x4){__builtin_amdgcn_perm(vr[1], vr[0], 0x07060302u), __builtin_amdgcn_perm(vr[3], vr[2], 0x07060302u), __builtin_amdgcn_perm(vr[5], vr[4], 0x07060302u), __builtin_amdgcn_perm(vr[7], vr[6], 0x07060302u)};
                if (cc + 1 < SEGC) { const int c1 = sg * 256 + (dir ? (SEGC - 2 - cc) : cc + 1) * 64;
#pragma unroll
                    for (int i = 0; i < 8; ++i) { zr[i] = HG_LD(az, c1, i); qr[i] = HG_LD(aq, c1, i); vr[i] = HG_LD(av, c1, i); } }
                if (dir == 1) {
#pragma unroll
                    for (int tt = 0; tt < 4; ++tt) { const int tok = c0 + 63 - (16 * tt + r16); ofr[tt] = *(const u32x2*)(Pb + ((unsigned)tok * 256u + colo)); ggr[tt] = *(const u32x2*)(Y + (size_t)tok * 1024 + PC_YC + h * 128 + 16 * w + 4 * quad); } }
                LBAR();
                f32x2 T[8], PF[9];
#pragma unroll
                for (int g = 0; g < 8; ++g) T[g] = *(LAS f32x2*)(lds + H_T8 + (g * 128 + 2 * kp) * 4);
                PF[0] = (f32x2){1.f, 1.f};
#pragma unroll
                for (int g = 0; g < 8; ++g) PF[g + 1] = PF[g] * T[g];
                f32x2 pf;
                switch (w) { case 0: pf = PF[0]; break; case 1: pf = PF[1]; break; case 2: pf = PF[2]; break; case 3: pf = PF[3]; break; case 4: pf = PF[4]; break; case 5: pf = PF[5]; break; case 6: pf = PF[6]; break; default: pf = PF[7]; break; }
                float bt0[8], bt1[8];
#pragma unroll
                for (int i = 0; i < 8; ++i) { const int tau = 8 * w + i;
                    const float e0 = pf.x * el0[i], e1 = pf.y * el1[i];
                    bt0[i] = kk0[i] * __builtin_amdgcn_rcpf(fmaxf(e0, 1e-34f)); bt1[i] = kk1[i] * __builtin_amdgcn_rcpf(fmaxf(e1, 1e-34f));
                    *(LAS unsigned*)(lds + H_QS + tau * 272 + kp * 4) = pk2(q0[i] * e0, q1[i] * e1);
                    *(LAS unsigned*)(lds + H_KD + tau * 272 + kp * 4) = pk2(bt0[i], bt1[i]); }
                *(LAS u32x4*)(lds + H_KST + (2 * kp) * 144 + 16 * w) = (u32x4){pk2(bt0[0], bt0[1]), pk2(bt0[2], bt0[3]), pk2(bt0[4], bt0[5]), pk2(bt0[6], bt0[7])};
                *(LAS u32x4*)(lds + H_KST + (2 * kp + 1) * 144 + 16 * w) = (u32x4){pk2(bt1[0], bt1[1]), pk2(bt1[2], bt1[3]), pk2(bt1[4], bt1[5]), pk2(bt1[6], bt1[7])};
                if (w == 4) *(LAS f32x2*)(lds + H_DEC + 2 * kp * 4) = PF[8];
                LBAR();
            }
            if (w < 4) score_tile(lds, H_QS + 16 * w * 272, H_KD + 16 * w * 272, w, w, true, r16, quad);
            else if (w < 7) score_tile(lds, H_QS + 16 * (w - 3) * 272, H_KD + 16 * (w - 4) * 272, w - 3, w - 4, false, r16, quad);
            else score_tile(lds, H_QS + 32 * 272, H_KD, 2, 0, false, r16, quad);
            if (w == 0) score_tile(lds, H_QS + 48 * 272, H_KD + 16 * 272, 3, 1, false, r16, quad);
            if (w == 1) score_tile(lds, H_QS + 48 * 272, H_KD, 3, 0, false, r16, quad);
            if (w == 2) *(LAS u32x2*)(lds + H_SC + (r16) * 144 + (16 + 4 * quad) * 2) = (u32x2){0u, 0u};
            if (w == 3) *(LAS u32x2*)(lds + H_SC + (32 + r16) * 144 + (48 + 4 * quad) * 2) = (u32x2){0u, 0u};
            f32x4 o[4];
            bf16x8 sa[4];
#pragma unroll
            for (int pp = 0; pp < 4; ++pp) sa[pp] = mk8(pk2(S[2 * pp][0], S[2 * pp][1]), pk2(S[2 * pp][2], S[2 * pp][3]), pk2(S[2 * pp + 1][0], S[2 * pp + 1][1]), pk2(S[2 * pp + 1][2], S[2 * pp + 1][3]));
#pragma unroll
            for (int tt = 0; tt < 4; ++tt) { o[tt] = (f32x4){0.f, 0.f, 0.f, 0.f};
                u32x2 qb[4][2];
#pragma unroll
                for (int pp = 0; pp < 4; ++pp) { qb[pp][0] = *(LAS u32x2*)(lds + H_QS + (16 * tt + r16) * 272 + (32 * pp + 4 * quad) * 2); qb[pp][1] = *(LAS u32x2*)(lds + H_QS + (16 * tt + r16) * 272 + (32 * pp + 16 + 4 * quad) * 2); }
#pragma unroll
                for (int pp = 0; pp < 4; ++pp) o[tt] = MFMA16(sa[pp], mk8(qb[pp][0].x, qb[pp][0].y, qb[pp][1].x, qb[pp][1].y), o[tt]); }
            LBAR();
            bf16x8 vf[2];
#pragma unroll
            for (int kk = 0; kk < 2; ++kk) vf[kk] = *(LAS bf16x8*)(lds + H_VT + (16 * w + r16) * 144 + (32 * kk + 8 * quad) * 2);
            bf16x8 scf[4][2];
#pragma unroll
            for (int tt = 0; tt < 4; ++tt)
#pragma unroll
                for (int kk = 0; kk < 2; ++kk) { if (kk == 1 && tt < 2) continue; scf[tt][kk] = *(LAS bf16x8*)(lds + H_SC + (16 * tt + r16) * 144 + (32 * kk + 8 * quad) * 2); }
#pragma unroll
            for (int tt = 0; tt < 4; ++tt)
#pragma unroll
                for (int kk = 0; kk < 2; ++kk) { if (kk == 1 && tt < 2) continue; o[tt] = MFMA16(vf[kk], scf[tt][kk], o[tt]); }
#pragma unroll
            for (int mh = 0; mh < 2; ++mh) {
                bf16x8 af[4][2]; f32x4 dd[4];
#pragma unroll
                for (int mi = 0; mi < 4; ++mi) { const int m = 4 * mh + mi;
#pragma unroll
                    for (int kk = 0; kk < 2; ++kk) af[mi][kk] = *(LAS bf16x8*)(lds + H_KST + (16 * m + r16) * 144 + (32 * kk + 8 * quad) * 2);
                    dd[mi] = *(LAS f32x4*)(lds + H_DEC + (16 * m + 4 * quad) * 4); }
#pragma unroll
                for (int mi = 0; mi < 4; ++mi) { const int m = 4 * mh + mi;
#pragma unroll
                    for (int kk = 0; kk < 2; ++kk) S[m] = MFMA16(af[mi][kk], vf[kk], S[m]);
                    S[m] = S[m] * dd[mi]; } }
            if (dir == 0) {
#pragma unroll
                for (int tt = 0; tt < 4; ++tt) { const int tok = c0 + 16 * tt + r16; u32x2 ov; ov.x = pk2(o[tt][0], o[tt][1]); ov.y = pk2(o[tt][2], o[tt][3]);
                    *(u32x2*)(Pb + ((unsigned)tok * 256u + colo)) = ov; }
                LBAR();
            } else {
#pragma unroll
                for (int tt = 0; tt < 4; ++tt) { const int tok = c0 + 63 - (16 * tt + r16);
                    const u32x2 of = ofr[tt];
                    o[tt][0] += bflo(of.x); o[tt][1] += bfhi(of.x); o[tt][2] += bflo(of.y); o[tt][3] += bfhi(of.y);
                    float ss = (o[tt][0] * o[tt][0] + o[tt][1] * o[tt][1]) + (o[tt][2] * o[tt][2] + o[tt][3] * o[tt][3]);
                    ss += __shfl_xor(ss, 16); ss += __shfl_xor(ss, 32);
                    if (quad == 0) *(LAS float*)(lds + H_OS + (w * 64 + 16 * tt + r16) * 4) = ss; }
                LBAR();
#pragma unroll
                for (int tt = 0; tt < 4; ++tt) { const int tau = 16 * tt + r16, tok = c0 + 63 - tau; float tot = 0.f;
#pragma unroll
                    for (int ww = 0; ww < 8; ++ww) tot += *(LAS float*)(lds + H_OS + (ww * 64 + tau) * 4);
                    const float rs = __builtin_amdgcn_rsqf(tot * (1.f / 128.f) + EPS);
                    bf16* gp = Y + (size_t)tok * 1024 + PC_YC + h * 128 + 16 * w + 4 * quad; const u32x2 g = ggr[tt]; u32x2 ov;
                    ov.x = pk2(o[tt][0] * rs * gn[0] * bflo(g.x), o[tt][1] * rs * gn[1] * bfhi(g.x)); ov.y = pk2(o[tt][2] * rs * gn[2] * bflo(g.y), o[tt][3] * rs * gn[3] * bfhi(g.y));
                    *(u32x2*)gp = ov; }
            }
        }
        __syncthreads();
    }
}
__device__ __forceinline__ void hgrn_passC_item(ldsp lds, int item, int layer, const Params& p) { hgrn_passC_dir<0>(lds, item, layer, p); hgrn_passC_dir<1>(lds, item, layer, p); }

#define XB_TMO      128
#define XB_XCNT(j)  (256  + 64 * (j))
#define XB_XSUB(j)  (1280 + 64 * (j))
#define XB_XGEN(j)  (2304 + 64 * (j))
#define XB_TOP      3328
#define XB_TOPGEN   3392
#define XCD_BAR_WORDS 3456
#define XB_SPIN_CAP (1u << 18)

__device__ __forceinline__ unsigned xb_ld(unsigned* p)              { return __hip_atomic_load(p, __ATOMIC_RELAXED, __HIP_MEMORY_SCOPE_AGENT); }
__device__ __forceinline__ unsigned xb_add(unsigned* p, unsigned v) { return __hip_atomic_fetch_add(p, v, __ATOMIC_RELAXED, __HIP_MEMORY_SCOPE_AGENT); }
__device__ __forceinline__ unsigned xb_xcc_id() { return (unsigned)__builtin_amdgcn_s_getreg((3 << 11) | 20) & 0xFu; }
#define XB_SPIN(cond, bar) do { unsigned _sp = 0; while (cond) { __builtin_amdgcn_s_sleep(1); \
    if ((++_sp & 255u) == 0u) { if (xb_ld(&(bar)[XB_TMO])) break; if (_sp > XB_SPIN_CAP) { atomicAdd(&(bar)[XB_TMO], 1u); break; } } } } while (0)

struct XcdBarrier {
    unsigned* bar; unsigned x;
    volatile LAS unsigned* st;
};

__device__ __forceinline__ XcdBarrier xcd_barrier_post(unsigned* bar, volatile LAS unsigned* st) {
    XcdBarrier b; b.bar = bar; b.x = xb_xcc_id(); b.st = st;
    if (ltid() == 0) (void)xb_add(&bar[XB_XCNT(b.x)], 1u);
    return b;
}
__device__ __forceinline__ void xcd_barrier_complete(unsigned* bar, unsigned x, unsigned& nloc, unsigned& nx) {
    const unsigned G = gridDim.x * gridDim.y * gridDim.z;
    unsigned sum, cnt, mine, sp = 0u;
    for (;;) {
        sum = 0u; cnt = 0u; mine = 0u;
#pragma unroll
        for (unsigned j = 0; j < 16; ++j) { const unsigned c = xb_ld(&bar[XB_XCNT(j)]); sum += c; cnt += (c > 0u) ? 1u : 0u; mine = (j == x) ? c : mine; }
        if (sum == G) break;
        __builtin_amdgcn_s_sleep(1);
        if ((++sp & 255u) == 0u) { if (xb_ld(&bar[XB_TMO])) break; if (sp > XB_SPIN_CAP) { atomicAdd(&bar[XB_TMO], 1u); break; } }
    }
    nloc = mine > 0u ? mine : 1u; nx = cnt > 0u ? cnt : 1u;
}

__device__ __forceinline__ void xcd_barrier(const XcdBarrier& b) {
    asm volatile("s_waitcnt vmcnt(0)" ::: "memory");
    __syncthreads();
    if (ltid() == 0) {
        unsigned* bar = b.bar;
        __builtin_amdgcn_s_waitcnt(0);
        unsigned nloc = b.st[0], nx = b.st[1];
        if (nloc == 0u) { xcd_barrier_complete(bar, b.x, nloc, nx); b.st[0] = nloc; b.st[1] = nx; }
        const unsigned old = xb_add(&bar[XB_XSUB(b.x)], 1u);
        const unsigned gen = old / nloc;
        if (old + 1u == (gen + 1u) * nloc) {
            __builtin_amdgcn_fence(__ATOMIC_RELEASE, "agent");
            asm volatile("s_waitcnt vmcnt(0)" ::: "memory");
            const unsigned og = xb_add(&bar[XB_TOP], 1u);
            const unsigned tg = og / nx;
            if (og + 1u == (tg + 1u) * nx) xb_add(&bar[XB_TOPGEN], 1u);
            else XB_SPIN(xb_ld(&bar[XB_TOPGEN]) == tg, bar);
            __builtin_amdgcn_fence(__ATOMIC_ACQUIRE, "agent");
            xb_add(&bar[XB_XGEN(b.x)], 1u);
            asm volatile("s_waitcnt vmcnt(0)" ::: "memory");
        } else {
            XB_SPIN(xb_ld(&bar[XB_XGEN(b.x)]) == gen, bar);
            __builtin_amdgcn_fence(__ATOMIC_ACQUIRE, "agent");
            asm volatile("s_waitcnt vmcnt(0)" ::: "memory");
        }
    }
    __syncthreads();
}


__global__ void __launch_bounds__(512, 2) fwd_kernel(Params p) {
    extern __shared__ __attribute__((aligned(16))) unsigned char lds_raw[];
    ldsp lds = (ldsp)lds_raw;
    cg::grid_group grid = cg::this_grid();
    unsigned char* ws = p.ws;
    bf16* XB = (bf16*)(ws + WS_XB); float* part = (float*)(ws + WS_PART);
    const int G = gridDim.x, bx = blockIdx.x;
    if (ltid() < 2) *(LAS unsigned*)(lds + LDS_BARST + 4 * ltid()) = 0u;
    __syncthreads();
    const XcdBarrier xbar = xcd_barrier_post((unsigned*)(ws + WS_BAR), (volatile LAS unsigned*)(lds + LDS_BARST));
#pragma unroll 1
    for (int ph = p.ph_lo; ph < p.ph_hi; ++ph) {
        if (ph == 0) prologue(lds, p);
        else if (ph == NPH - 1) final_norm(p);
        else {
            const int layer = (ph - 1) / 5, sub = (ph - 1) % 5;
            if (sub == 0) {
                pg8::Gemm g{layer == 0 ? XB : (const bf16*)p.out, (const bf16*)(ws + WS_BT1) + (size_t)layer * DIN * D, M, DIN, D, D}; pg8::StaticOrder S; S.init(M, DIN, G, bx);
                Epi1 E{ws, part};
                pg8::gemm_phase<Epi1, pg8::StaticOrder, true, true>(lds, g, S, E);
            } else if (sub == 1) {
                for (int it = bx; it < NSEG * 8; it += G) hgrn_passA_item(lds, it, layer, p);
            } else if (sub == 2) {
                hgrn_passB(p);
                { const int t_ = ltid(); if (t_ < 256) { *(LAS float*)(lds + L_LNP + 4 * t_) = p.conv_ln_g[layer * 256 + t_]; *(LAS float*)(lds + L_LNP + 1024 + 4 * t_) = p.conv_ln_b[layer * 256 + t_];
                      *(LAS float*)(lds + L_LNP + 2048 + 4 * t_) = p.sgu_ln_g[layer * 256 + t_]; *(LAS float*)(lds + L_LNP + 3072 + 4 * t_) = p.sgu_ln_b[layer * 256 + t_]; } }
                { f32x2 w2[31]; const int cp = ltid() & 127; const float* cw = p.conv_w + layer * 31 * 256;
#pragma unroll
                  for (int j = 0; j < 31; ++j) w2[j] = *(const f32x2*)(cw + j * 256 + 2 * cp);
                  const f32x2 bb2 = *(const f32x2*)(p.conv_b + layer * 256 + 2 * cp);
                  u32x4 inr[6]; CONV_LOAD_IN(inr, bx < 768 ? bx : 0, ltid());
                  for (int it = bx; it < 768; it += G) conv_item(lds, it, layer, p, w2, bb2, inr, it + G < 768 ? it + G : -1); }
                for (int it = bx; it < 768; it += G) sgu_item(lds, it, layer, p);
            } else if (sub == 3) {
                for (int it = bx; it < NSEG * 4; it += G) hgrn_passC_item(lds, it, layer, p);
            } else {
                pg8::Gemm g{(const bf16*)(ws + WS_Y), (const bf16*)(ws + WS_BT2) + (size_t)layer * D * D, M, D, D, D}; pg8::StaticOrder S; S.init(M, D, G, bx);
                Epi2 E{p.xp, p.xs, M0, layer == 0 ? (const bf16*)XB : (const bf16*)p.out, nullptr, layer == 0 ? (bf16*)p.out : XB, part};
                pg8::gemm_phase<Epi2, pg8::StaticOrder, true, true>(lds, g, S, E);
            }
        }
        if (ph + 1 < p.ph_hi) { if (p.ph_hi > NPH) grid.sync();
                                xcd_barrier(xbar); }
    }
}

extern "C" void kernel_launch(void* const* d_in, const int* in_sizes, int n_in, void* d_out, int out_size, void* d_ws, size_t ws_size, hipStream_t stream) {
    static int grid = 0;
    if (grid == 0) {
        if (n_in != 18 || out_size != M * D || ws_size < WS_END) { fprintf(stderr, "kernel_launch: unexpected shapes (n_in %d out %d ws %zu)\n", n_in, out_size, ws_size); grid = -1; return; }
        int dev = 0, cus = 0, per_cu = 0;
        hipGetDevice(&dev); hipDeviceGetAttribute(&cus, hipDeviceAttributeMultiprocessorCount, dev);
        hipFuncSetAttribute((const void*)fwd_kernel, hipFuncAttributeMaxDynamicSharedMemorySize, LDS_BYTES);
        if (hipOccupancyMaxActiveBlocksPerMultiprocessor(&per_cu, (const void*)fwd_kernel, 512, LDS_BYTES) != hipSuccess || per_cu < 1) per_cu = 1;
        (void)hipGetLastError();
        grid = cus * per_cu;
    }
    if (grid < 0) return;
    Params p{};
    const float** pp = (const float**)&p;
    for (int i = 0; i < 18; ++i) pp[i] = (const float*)d_in[i];
    p.out = (float*)d_out; p.ws = (unsigned char*)d_ws;
    if (hipMemsetAsync((char*)d_ws + WS_BAR, 0, 16384, stream) != hipSuccess) { fprintf(stderr, "kernel_launch: memset of the barrier words failed\n"); return; }
#if ONE_LAUNCH
    p.ph_lo = 0; p.ph_hi = NPH;
    void* args[] = {&p};
    hipError_t e = hipLaunchCooperativeKernel((const void*)fwd_kernel, dim3(grid), dim3(512), args, LDS_BYTES, stream);
    if (e != hipSuccess) fprintf(stderr, "cooperative launch failed: %s (grid %d)\n", hipGetErrorString(e), grid);
#else
    for (int ph = 0; ph < NPH; ++ph) { p.ph_lo = ph; p.ph_hi = ph + 1; hipLaunchKernelGGL(fwd_kernel, dim3(grid), dim3(512), LDS_BYTES, stream, p); }
#endif
}
```

```cpp
#include <hip/hip_runtime.h>
#include <hip/hip_cooperative_groups.h>
#include <cstdio>
#include <cstdint>
namespace cg = cooperative_groups;

__device__ __forceinline__ int ltid() { int t = threadIdx.x; asm volatile("" : "+v"(t)); return t; }
namespace pg8 {
#define PG8_LAS __attribute__((address_space(3)))
typedef unsigned short bf16_t;
typedef short bf16x8 __attribute__((ext_vector_type(8)));
typedef float f32x4 __attribute__((ext_vector_type(4)));
typedef unsigned u32x4 __attribute__((ext_vector_type(4)));
constexpr int BM = 256, BK = 64, HALF = 128, HTB = HALF * BK * 2  , STAGE_BYTES = 8 * HTB, NXCD = 8, WGM = 8;

__host__ __device__ __forceinline__ int lds_byte(int r, int c) { const int st = (r >> 4) * 2 + (c >> 5), rr = r & 15, cc = c & 31, ob = rr * 64 + cc * 2; return st * 1024 + (ob ^ (((ob >> 9) & 1) << 5)); }
__host__ __device__ __forceinline__ void stage_rc(int b, int& R, int& C) { const int st = b / 1024, sb = b % 1024, swz = sb ^ (((sb >> 9) & 1) << 5); R = (st >> 1) * 16 + swz / 64; C = (st & 1) * 32 + (swz % 64) / 2; }
__host__ __device__ __forceinline__ int perm32(int rho) { const int n = rho >> 4, i = rho & 15; return 8 * (i >> 2) + 4 * n + (i & 3); }

struct Unit { int pm, pn; };
struct Gemm { const bf16_t* A; const bf16_t* Bt; int M, N, K, lda; };

struct StaticOrder {
    int nM, nN, nwg, G, c;
    __host__ __device__ void init(int M, int N, int G_, int c_) { nM = M / BM; nN = N / BM; nwg = nM * nN; G = G_; c = c_; }
    __host__ __device__ bool next(int i, Unit& u) const {
        const long L = (long)i * G + c; if (L >= nwg) return false;
        int wgid = (int)L; { const int q = nwg / NXCD, r = nwg % NXCD, xcd = wgid % NXCD, off = wgid / NXCD; wgid = (xcd < r ? xcd * (q + 1) : r * (q + 1) + (xcd - r) * q) + off; }
        const int nig = WGM * nN, gid = wgid / nig, fm = gid * WGM, gsz = (nM - fm) < WGM ? (nM - fm) : WGM;
        u.pm = fm + ((wgid % nig) % gsz); u.pn = (wgid % nig) / gsz; return true;
    }
    __device__ __forceinline__ void a_ready(const Unit&) const {}
    __device__ __forceinline__ void done(const Unit&) const {}
};

typedef float f32x2 __attribute__((ext_vector_type(2)));
__device__ __forceinline__ f32x2 gelu_pk(f32x2 v) {
    const f32x2 av = __builtin_elementwise_abs(v), d = av * 0.2316418882f + 1.0f;
    f32x2 t; t.x = __builtin_amdgcn_rcpf(d.x); t.y = __builtin_amdgcn_rcpf(d.y);
    f32x2 q = t * 0.5307027145f + (-0.7265760135f); q = q * t + 0.7107068705f; q = q * t + (-0.142248368f); q = q * t + 0.127414796f; q = q * t;
    const f32x2 s = (v * v) * (-0.72134752044f);
    f32x2 e; e.x = __builtin_amdgcn_exp2f(s.x); e.y = __builtin_amdgcn_exp2f(s.y);
    const f32x2 m = v * (q * e), r = v - m;
    f32x2 o; o.x = v.x < 0.f ? m.x : r.x; o.y = v.y < 0.f ? m.y : r.y; return o;
}

template <class Epi, class Sched, bool ALIGN_EPI = false, bool SP2 = false>
__device__ __forceinline__ void gemm_phase(PG8_LAS unsigned char* lds, const Gemm g, const Sched& S, const Epi& E) {
    const int tid = ltid(), wid = __builtin_amdgcn_readfirstlane(tid >> 6), lane = tid & 63, wr = wid >> 2, wc = wid & 3, fr = lane & 15, fq = lane >> 4;
    const int K = g.K, nt = K / BK;
    unsigned voffA[2], voffB[2];
#pragma unroll
    for (int i = 0; i < 2; ++i) { int R, C; stage_rc(tid * 16 + i * 8192, R, C); const int Rb = Epi::PERM ? ((R & ~31) + perm32(R & 31)) : R;
        voffA[i] = (unsigned)(R * g.lda + C) * 2u; voffB[i] = (unsigned)(Rb * K + C) * 2u; }
    const size_t kstep = (size_t)(BK * 2);
    const size_t hstepB = (size_t)HALF * K * 2, hstepA = (size_t)HALF * g.lda * 2;
    const size_t tstepA = 2 * hstepA, tstepB = 2 * hstepB;
    const unsigned ldsw = (unsigned)wid * 1024u;
    const int aoff = lds_byte(wr * 64 + fr, fq * 8), boff = lds_byte(wc * 32 + fr, fq * 8);
#define PG8_SA(b, h) (((b) * 2 + (h)) * HTB)
#define PG8_SB(b, h) ((4 + (b) * 2 + (h)) * HTB)
#define PG8_STAGE(bufoff, gbase, voff) do { _Pragma("unroll") for (int _i = 0; _i < 2; ++_i) \
        __builtin_amdgcn_global_load_lds((const unsigned*)((const char*)(gbase) + (voff)[_i]), (PG8_LAS unsigned*)(lds + (bufoff) + ldsw + _i * 8192), 16, 0, 0); } while (0)
#define PG8_LDA(dst, b, h) do { _Pragma("unroll") for (int m = 0; m < 4; ++m) _Pragma("unroll") for (int k = 0; k < 2; ++k) dst[m][k] = *(const PG8_LAS bf16x8*)(lds + PG8_SA(b, h) + aoff + m * 2048 + k * 1024); } while (0)
#define PG8_LDB(dst, b, h) do { _Pragma("unroll") for (int n = 0; n < 2; ++n) _Pragma("unroll") for (int k = 0; k < 2; ++k) dst[n][k] = *(const PG8_LAS bf16x8*)(lds + PG8_SB(b, h) + boff + n * 2048 + k * 1024); } while (0)
#define PG8_MMA(ai, bj, At, Bt) do { __builtin_amdgcn_s_setprio(1); _Pragma("unroll") for (int m = 0; m < 4; ++m) _Pragma("unroll") for (int n = 0; n < 2; ++n) _Pragma("unroll") for (int k = 0; k < 2; ++k) \
        acc[ai][bj][m][n] = __builtin_amdgcn_mfma_f32_16x16x32_bf16(Bt[n][k], At[m][k], acc[ai][bj][m][n], 0, 0, 0); __builtin_amdgcn_s_setprio(0); } while (0)
#define PG8_WAIT_V(n) asm volatile("s_waitcnt vmcnt(" #n ")" ::: "memory")
#define PG8_WAIT_L(n) asm volatile("s_waitcnt lgkmcnt(" #n ")" ::: "memory")
#define PG8_BAR __builtin_amdgcn_s_barrier()
#define PG8_SCHED __builtin_amdgcn_sched_barrier(0)
    Unit cur, nxt; int ui = 0;
    if (!S.next(0, cur)) return;
    f32x4 acc[2][2][4][2];
#pragma unroll
    for (int a = 0; a < 2; ++a)
#pragma unroll
        for (int b = 0; b < 2; ++b)
#pragma unroll
            for (int m = 0; m < 4; ++m)
#pragma unroll
                for (int n = 0; n < 2; ++n) acc[a][b][m][n] = (f32x4){0.f, 0.f, 0.f, 0.f};
    bf16x8 At[4][2], B0[2][2], B1[2][2];
    const char* cA = (const char*)g.A + (size_t)cur.pm * tstepA; const char* cB = (const char*)g.Bt + (size_t)cur.pn * tstepB;
    S.a_ready(cur);
    if constexpr (SP2) {
        PG8_STAGE(PG8_SB(0, 0), cB, voffB); PG8_STAGE(PG8_SB(0, 1), cB + hstepB, voffB); PG8_STAGE(PG8_SA(0, 0), cA, voffA); PG8_STAGE(PG8_SA(0, 1), cA + hstepA, voffA);
        if (wr == 1) PG8_BAR;
        PG8_WAIT_V(2); PG8_BAR;
        PG8_STAGE(PG8_SB(1, 0), cB + kstep, voffB); PG8_STAGE(PG8_SA(1, 0), cA + kstep, voffA); PG8_STAGE(PG8_SB(1, 1), cB + hstepB + kstep, voffB);
        PG8_WAIT_V(6); PG8_BAR;
    } else {
        PG8_STAGE(PG8_SB(0, 0), cB, voffB); PG8_STAGE(PG8_SA(0, 0), cA, voffA); PG8_STAGE(PG8_SB(0, 1), cB + hstepB, voffB); PG8_STAGE(PG8_SA(0, 1), cA + hstepA, voffA);
        if (wr == 1) PG8_BAR;
        PG8_WAIT_V(4); PG8_BAR;
        PG8_STAGE(PG8_SB(1, 0), cB + kstep, voffB); PG8_STAGE(PG8_SA(1, 0), cA + kstep, voffA); PG8_STAGE(PG8_SB(1, 1), cB + hstepB + kstep, voffB);
        PG8_WAIT_V(6); PG8_BAR;
    }
    for (;;) {
        const bool has_next = S.next(ui + 1, nxt);
        const char* nA = has_next ? (const char*)g.A + (size_t)nxt.pm * tstepA : cA; const char* nB = has_next ? (const char*)g.Bt + (size_t)nxt.pn * tstepB : cB;
        for (int t = 0; t < nt; t += 2) {
            const bool last = (t == nt - 2);
            const char* a1 = cA + (size_t)(t + 1) * kstep;
            const char* a2 = last ? nA : cA + (size_t)(t + 2) * kstep; const char* b2 = last ? nB : cB + (size_t)(t + 2) * kstep;
            const char* a3 = a2 + kstep; const char* b3 = b2 + kstep;
            if (last && has_next) S.a_ready(nxt);
            if constexpr (SP2) {
            PG8_LDB(B0, 0, 0); PG8_LDB(B1, 0, 1); PG8_SCHED; PG8_LDA(At, 0, 0); PG8_STAGE(PG8_SA(1, 1), a1 + hstepA, voffA);
            PG8_WAIT_V(8); PG8_WAIT_L(0); PG8_BAR; PG8_MMA(0, 0, At, B0); PG8_MMA(0, 1, At, B1); PG8_BAR; PG8_SCHED;
            PG8_LDA(At, 0, 1); PG8_STAGE(PG8_SB(0, 0), b2, voffB); PG8_STAGE(PG8_SB(0, 1), b2 + hstepB, voffB); PG8_STAGE(PG8_SA(0, 0), a2, voffA);
            PG8_WAIT_V(8); PG8_WAIT_L(0); PG8_BAR; PG8_MMA(1, 0, At, B0); PG8_MMA(1, 1, At, B1); PG8_BAR; PG8_SCHED;
            PG8_LDB(B0, 1, 0); PG8_LDB(B1, 1, 1); PG8_SCHED; PG8_LDA(At, 1, 0); PG8_STAGE(PG8_SA(0, 1), a2 + hstepA, voffA);
            PG8_WAIT_V(8); PG8_WAIT_L(0); PG8_BAR; PG8_MMA(0, 0, At, B0); PG8_MMA(0, 1, At, B1); PG8_BAR; PG8_SCHED;
            PG8_LDA(At, 1, 1); PG8_STAGE(PG8_SB(1, 0), b3, voffB); PG8_STAGE(PG8_SB(1, 1), b3 + hstepB, voffB); PG8_STAGE(PG8_SA(1, 0), a3, voffA);
            PG8_WAIT_V(8); PG8_WAIT_L(0); PG8_BAR; PG8_MMA(1, 0, At, B0); PG8_MMA(1, 1, At, B1); PG8_BAR; PG8_SCHED;
            } else {
            PG8_LDB(B0, 0, 0); PG8_SCHED; PG8_LDA(At, 0, 0); PG8_STAGE(PG8_SA(1, 1), a1 + hstepA, voffA);
            PG8_WAIT_L(8); PG8_BAR; PG8_WAIT_L(0); PG8_MMA(0, 0, At, B0); PG8_BAR; PG8_SCHED;
            PG8_LDB(B1, 0, 1); PG8_STAGE(PG8_SB(0, 0), b2, voffB);
            PG8_BAR; PG8_WAIT_L(0); PG8_MMA(0, 1, At, B1); PG8_BAR;
            PG8_LDA(At, 0, 1); PG8_STAGE(PG8_SA(0, 0), a2, voffA);
            PG8_BAR; PG8_WAIT_L(0); PG8_MMA(1, 0, At, B0); PG8_BAR; PG8_SCHED;
            PG8_STAGE(PG8_SB(0, 1), b2 + hstepB, voffB);
            PG8_WAIT_V(6); PG8_BAR; PG8_MMA(1, 1, At, B1); PG8_BAR;
            PG8_LDB(B0, 1, 0); PG8_SCHED; PG8_LDA(At, 1, 0); PG8_STAGE(PG8_SA(0, 1), a2 + hstepA, voffA);
            PG8_WAIT_L(8); PG8_BAR; PG8_WAIT_L(0); PG8_MMA(0, 0, At, B0); PG8_BAR; PG8_SCHED;
            PG8_LDB(B1, 1, 1); PG8_STAGE(PG8_SB(1, 0), b3, voffB);
            PG8_BAR; PG8_WAIT_L(0); PG8_MMA(0, 1, At, B1); PG8_BAR;
            PG8_LDA(At, 1, 1); PG8_STAGE(PG8_SA(1, 0), a3, voffA);
            PG8_BAR; PG8_WAIT_L(0); PG8_MMA(1, 0, At, B0); PG8_BAR; PG8_SCHED;
            PG8_STAGE(PG8_SB(1, 1), b3 + hstepB, voffB);
            PG8_WAIT_V(6); PG8_BAR; PG8_MMA(1, 1, At, B1); PG8_BAR;
            }
        }
        if constexpr (ALIGN_EPI) { if (wr == 0) PG8_BAR; }
        if constexpr (!Epi::AFTER_DRAIN) { E(acc, cur, wr, wc, fr, fq); S.done(cur); }
        if (!has_next) break;
#pragma unroll
        for (int a = 0; a < 2; ++a)
#pragma unroll
            for (int b = 0; b < 2; ++b)
#pragma unroll
                for (int m = 0; m < 4; ++m)
#pragma unroll
                    for (int n = 0; n < 2; ++n) acc[a][b][m][n] = (f32x4){0.f, 0.f, 0.f, 0.f};
        cur = nxt; cA = nA; cB = nB; ++ui;
        if constexpr (ALIGN_EPI) { if (wr == 1) PG8_BAR; }
    }
    PG8_WAIT_V(0);
    if constexpr (!ALIGN_EPI) { if (wr == 0) PG8_BAR; }
    PG8_BAR;
    if constexpr (Epi::AFTER_DRAIN) { E.fused(acc, cur, wr, wc, fr, fq, lds, wid, lane); S.done(cur); }
#undef PG8_SA
#undef PG8_SB
#undef PG8_STAGE
#undef PG8_LDA
#undef PG8_LDB
#undef PG8_MMA
#undef PG8_WAIT_V
#undef PG8_WAIT_L
#undef PG8_BAR
#undef PG8_SCHED
}
}

#ifndef ONE_LAUNCH
#define ONE_LAUNCH 1
#endif
#define LAS __attribute__((address_space(3)))
typedef unsigned short bf16;
typedef unsigned u32x4 __attribute__((ext_vector_type(4)));
typedef unsigned u32x2 __attribute__((ext_vector_type(2)));
typedef float f32x4 __attribute__((ext_vector_type(4)));
typedef float f32x2 __attribute__((ext_vector_type(2)));
typedef short bf16x8 __attribute__((ext_vector_type(8)));
typedef __bf16 bf16x2_t __attribute__((ext_vector_type(2)));
typedef LAS unsigned char* ldsp;

constexpr int M = 49152, M0 = 32768, D = 1024, DIN = 4096;
constexpr float EPS = 1e-6f;
constexpr int PC_YA = 0, PC_YB = 256, PC_YC = 512;
constexpr int NSEG = 192, SEGC = 4;
constexpr size_t MiB = 1u << 20;
constexpr size_t WS_PART = 0, WS_LOGD = 3 * MiB, WS_BT1 = 4 * MiB, WS_BT2 = 20 * MiB, WS_PWT = 24 * MiB, WS_SGW = 24 * MiB + 256 * 1024;
constexpr size_t OUT_ST = 96 * MiB;
constexpr size_t WS_XB = 26 * MiB, WS_Y = 122 * MiB, WS_GLU = 218 * MiB, WS_BU = 242 * MiB, WS_BV = 266 * MiB, WS_HQ = 290 * MiB, WS_END = 482 * MiB;
constexpr unsigned HARR = 48u << 20, HHEAD = (unsigned)M * 256u;
constexpr int LDS_BYTES = 147456, LDS_BARST = 145408;
constexpr size_t WS_BAR = 3 * MiB + 896 * 1024;
constexpr int NPH = 12;

struct Params {
    const float *xp, *xs, *norm_g, *w_in, *conv_w, *conv_b, *conv_ln_g, *conv_ln_b, *conv_pw, *sgu_ln_g, *sgu_ln_b, *sgu_w, *sgu_b, *lb_f, *lb_b, *hgrn_g, *w_out, *final_g;
    float* out; unsigned char* ws; int ph_lo, ph_hi;
};

__device__ __forceinline__ float bf2f(bf16 b) { return __uint_as_float((unsigned)b << 16); }
__device__ __forceinline__ float bflo(unsigned w) { return __uint_as_float(w << 16); }
__device__ __forceinline__ float bfhi(unsigned w) { return __uint_as_float(w & 0xffff0000u); }
__device__ __forceinline__ unsigned pk2(float lo, float hi) { f32x2 v = {lo, hi}; bf16x2_t b = __builtin_convertvector(v, bf16x2_t); return __builtin_bit_cast(unsigned, b); }
__device__ __forceinline__ bf16 f2bf(float x) { return (bf16)(pk2(x, 0.f) & 0xffffu); }
__device__ __forceinline__ float sigmoidf_(float x) { return __builtin_amdgcn_rcpf(1.f + __expf(-x)); }
__device__ __forceinline__ float siluf_(float x) { return x * sigmoidf_(x); }
__device__ __forceinline__ float wave_sum(float v) {
#pragma unroll
    for (int o = 1; o < 64; o <<= 1) v += __shfl_xor(v, o);
    return v;
}
__device__ __forceinline__ bf16x8 mk8(unsigned a, unsigned b, unsigned c, unsigned d) { u32x4 v = {a, b, c, d}; return __builtin_bit_cast(bf16x8, v); }
#define LBAR() asm volatile("s_waitcnt lgkmcnt(0)\n\ts_barrier" ::: "memory")
#define MFMA16(a, b, c) __builtin_amdgcn_mfma_f32_16x16x32_bf16((a), (b), (c), 0, 0, 0)

struct Epi1 {
    static constexpr bool PERM = true, AFTER_DRAIN = false;
    unsigned char* ws; const float* part;
    __device__ __forceinline__ void operator()(const pg8::f32x4 (&acc)[2][2][4][2], const pg8::Unit& u, int wr, int wc, int fr, int fq) const {
        const int row0 = u.pm * 256 + wr * 64 + fr; const int pn = u.pn;
        const int cw = wc * 32 + 8 * fq;
#pragma unroll
        for (int ai = 0; ai < 2; ++ai)
#pragma unroll
            for (int m = 0; m < 4; ++m) {
                const int r = row0 + ai * 128 + m * 16;
                float s = 0.f;
#pragma unroll
                for (int q = 0; q < 4; ++q) s += part[(size_t)(4 * fq + q) * M + r];
                s += __shfl_xor(s, 16); s += __shfl_xor(s, 32);
                const float rs = __builtin_amdgcn_rsqf(s * (1.f / D) + EPS);
                if (pn < 2) {
                    f32x4 a0 = acc[ai][0][m][0] * rs, a1 = acc[ai][0][m][1] * rs, g0 = acc[ai][1][m][0] * rs, g1 = acc[ai][1][m][1] * rs;
                    u32x4 w;
                    w.x = pk2(a0[0] * sigmoidf_(g0[0]), a0[1] * sigmoidf_(g0[1])); w.y = pk2(a0[2] * sigmoidf_(g0[2]), a0[3] * sigmoidf_(g0[3]));
                    w.z = pk2(a1[0] * sigmoidf_(g1[0]), a1[1] * sigmoidf_(g1[1])); w.w = pk2(a1[2] * sigmoidf_(g1[2]), a1[3] * sigmoidf_(g1[3]));
                    *(u32x4*)((bf16*)(ws + WS_GLU) + (size_t)r * 256 + 128 * pn + cw) = w;
                } else {
#pragma unroll
                    for (int bj = 0; bj < 2; ++bj) {
                        f32x4 v0 = acc[ai][bj][m][0] * rs, v1 = acc[ai][bj][m][1] * rs;
                        if (pn < 6) {
#pragma unroll
                            for (int e = 0; e < 4; ++e) { v0[e] = siluf_(v0[e]); v1[e] = siluf_(v1[e]); }
                        } else if (pn < 8) {
                            f32x2 a = pg8::gelu_pk((f32x2){v0[0], v0[1]}), b = pg8::gelu_pk((f32x2){v0[2], v0[3]}), c = pg8::gelu_pk((f32x2){v1[0], v1[1]}), d = pg8::gelu_pk((f32x2){v1[2], v1[3]});
                            v0 = (f32x4){a.x, a.y, b.x, b.y}; v1 = (f32x4){c.x, c.y, d.x, d.y};
                        }
                        u32x4 w; w.x = pk2(v0[0], v0[1]); w.y = pk2(v0[2], v0[3]); w.z = pk2(v1[0], v1[1]); w.w = pk2(v1[2], v1[3]);
                        bf16* dst;
                        if (pn < 6) dst = (bf16*)(ws + WS_Y) + (size_t)r * 1024 + 256 * (pn - 2) + 128 * bj + cw;
                        else if (pn < 8) dst = (bf16*)(ws + (pn == 6 ? WS_BU : WS_BV)) + (size_t)r * 256 + 128 * bj + cw;
                        else dst = (bf16*)(ws + WS_HQ + (size_t)((pn - 8) >> 1) * HARR + (size_t)(2 * ((pn - 8) & 1) + bj) * HHEAD) + (size_t)r * 128 + cw;
                        *(u32x4*)dst = w;
                    }
                }
            }
    }
};
struct Epi2 {
    static constexpr bool PERM = true, AFTER_DRAIN = false;
    const float* xin0; const float* xin1; int split; const bf16* xinb; float* xout; bf16* XB; float* part;
    __device__ __forceinline__ void operator()(const pg8::f32x4 (&acc)[2][2][4][2], const pg8::Unit& u, int wr, int wc, int fr, int fq) const {
        const int row0 = u.pm * 256 + wr * 64 + fr; const int pn = u.pn;
        const int cw = pn * 256 + wc * 32 + 8 * fq;
#pragma unroll
        for (int ai = 0; ai < 2; ++ai)
#pragma unroll
            for (int m = 0; m < 4; ++m) {
                const int r = row0 + ai * 128 + m * 16;
                const float* src = (r < split) ? xin0 + (size_t)r * D : xin1 + (size_t)(r - split) * D;
                float ss = 0.f;
#pragma unroll
                for (int bj = 0; bj < 2; ++bj) {
                    const int col = cw + 128 * bj;
                    f32x4 v0, v1;
                    if (xinb) { const u32x4 t = *(const u32x4*)(xinb + (size_t)r * D + col); v0 = (f32x4){bflo(t.x), bfhi(t.x), bflo(t.y), bfhi(t.y)}; v1 = (f32x4){bflo(t.z), bfhi(t.z), bflo(t.w), bfhi(t.w)}; }
                    else { v0 = *(const f32x4*)(src + col); v1 = *(const f32x4*)(src + col + 4); }
                    v0 = v0 + acc[ai][bj][m][0]; v1 = v1 + acc[ai][bj][m][1];
                    if (xout) { *(f32x4*)(xout + (size_t)r * D + col) = v0; *(f32x4*)(xout + (size_t)r * D + col + 4) = v1; }
                    ss += (v0[0] * v0[0] + v0[1] * v0[1]) + (v0[2] * v0[2] + v0[3] * v0[3]) + (v1[0] * v1[0] + v1[1] * v1[1]) + (v1[2] * v1[2] + v1[3] * v1[3]);
                    { u32x4 w; w.x = pk2(v0[0], v0[1]); w.y = pk2(v0[2], v0[3]); w.z = pk2(v1[0], v1[1]); w.w = pk2(v1[2], v1[3]); *(u32x4*)(XB + (size_t)r * D + col) = w; }
                }
                ss += __shfl_xor(ss, 16); ss += __shfl_xor(ss, 32);
                if (fq == 0) part[(size_t)(pn * 4 + wc) * M + r] = ss;
            }
    }
};

__device__ __forceinline__ int srcmap128(int b) {
    if (b < 4) return ((b & 1) ? 256 : 0) + 128 * (b >> 1);
    if (b < 6) return 512 + 128 * (b - 4);
    if (b < 8) return 1280 + 128 * (b - 6);
    if (b < 12) return 3584 + 128 * (b - 8);
    if (b < 14) return 768 + 128 * (b - 12);
    if (b < 16) return 1024 + 128 * (b - 14);
    if (b < 20) return 1536 + 128 * (b - 16);
    if (b < 24) return 2048 + 128 * (b - 20);
    if (b < 28) return 2560 + 128 * (b - 24);
    return 3072 + 128 * (b - 28);
}
__device__ __forceinline__ void tr_item(const float* W, int N, int sc0, const float* gk, int k0, bf16* WT, int K, int drow0, LAS float* scr, int lane) {
    float v[64];
#pragma unroll
    for (int kk = 0; kk < 64; ++kk) v[kk] = W[(size_t)(k0 + kk) * N + sc0 + lane];
    if (gk) {
#pragma unroll
        for (int kk = 0; kk < 64; ++kk) v[kk] *= gk[k0 + kk]; }
#pragma unroll
    for (int kk = 0; kk < 64; ++kk) scr[kk * 65 + lane] = v[kk];
    asm volatile("s_waitcnt lgkmcnt(0)" ::: "memory");
    const int c = lane & 7;
#pragma unroll
    for (int j = 0; j < 8; ++j) { const int n = (lane >> 3) + 8 * j; const LAS float* s = scr + (8 * c) * 65 + n;
        u32x4 o; o.x = pk2(s[0 * 65], s[1 * 65]); o.y = pk2(s[2 * 65], s[3 * 65]); o.z = pk2(s[4 * 65], s[5 * 65]); o.w = pk2(s[6 * 65], s[7 * 65]);
        *(u32x4*)(WT + (size_t)(drow0 + n) * K + k0 + 8 * c) = o; }
    asm volatile("s_waitcnt lgkmcnt(0)" ::: "memory");
}
__device__ __forceinline__ void prologue(ldsp lds, const Params& p) {
    const int tid = ltid(), lane = tid & 63, wave = __builtin_amdgcn_readfirstlane(tid >> 6);
    const int gw = blockIdx.x * 8 + wave, NGW = gridDim.x * 8;
    LAS float* scr = (LAS float*)(lds + wave * 16640);
    unsigned char* ws = p.ws;
    constexpr int I_IN = 16 * 64, I_OUT = 16 * 16, I_PW = 4 * 4, I_L = I_IN + I_OUT + I_PW;
    for (int it = gw; it < 2 * I_L; it += NGW) {
        const int l = it / I_L; int r = it - l * I_L;
        if (r < I_IN) { const int kb = r >> 6, nb = r & 63; tr_item(p.w_in + (size_t)l * D * DIN, DIN, srcmap128(nb >> 1) + 64 * (nb & 1), p.norm_g + l * D, 64 * kb, (bf16*)(ws + WS_BT1) + (size_t)l * DIN * D, D, 64 * nb, scr, lane); continue; }
        r -= I_IN;
        if (r < I_OUT) { const int kb = r >> 4, nb = r & 15; tr_item(p.w_out + (size_t)l * D * D, D, 64 * nb, nullptr, 64 * kb, (bf16*)(ws + WS_BT2) + (size_t)l * D * D, D, 64 * nb, scr, lane); continue; }
        r -= I_OUT;
        { const int kb = r >> 2, nb = r & 3; tr_item(p.conv_pw + (size_t)l * 65536, 256, 64 * nb, nullptr, 64 * kb, (bf16*)(ws + WS_PWT) + (size_t)l * 65536, 256, 64 * nb, scr, lane); }
    }
    { const int gt = blockIdx.x * 512 + tid, NT = gridDim.x * 512; bf16* o = (bf16*)(ws + WS_SGW);
      for (int i = gt; i < 2 * 4 * 128 * 128 / 4; i += NT) { const f32x4 v = *(const f32x4*)(p.sgu_w + 4 * (size_t)i); u32x2 w; w.x = pk2(v[0], v[1]); w.y = pk2(v[2], v[3]); *(u32x2*)(o + 4 * (size_t)i) = w; } }
    bf16* XB = (bf16*)(ws + WS_XB); float* part = (float*)(ws + WS_PART);
    for (int r = gw; r < M; r += 4 * NGW) {
        f32x4 v[4][4];
#pragma unroll
        for (int u = 0; u < 4; ++u) { const int rr = r + u * NGW; if (rr < M) { const float* src = (rr < M0) ? p.xp + (size_t)rr * D : p.xs + (size_t)(rr - M0) * D;
#pragma unroll
            for (int j = 0; j < 4; ++j) v[u][j] = ((const f32x4*)src)[lane + 64 * j]; } }
#pragma unroll
        for (int u = 0; u < 4; ++u) { const int rr = r + u * NGW; if (rr < M) { float s = 0.f;
            unsigned long long* o8 = (unsigned long long*)(XB + (size_t)rr * D) + lane;
#pragma unroll
            for (int j = 0; j < 4; ++j) { const f32x4 t = v[u][j]; s += (t[0] * t[0] + t[1] * t[1]) + (t[2] * t[2] + t[3] * t[3]); o8[64 * j] = (unsigned long long)pk2(t[0], t[1]) | ((unsigned long long)pk2(t[2], t[3]) << 32); }
            s = wave_sum(s);
            if (lane < 16) part[(size_t)lane * M + rr] = lane == 0 ? s : 0.f; } }
    }
}

__device__ __forceinline__ void final_norm(const Params& p) {
    const int tid = ltid(), lane = tid & 63, wave = tid >> 6;
    const int gw = blockIdx.x * 8 + wave, NGW = gridDim.x * 8;
    const float* part = (const float*)(p.ws + WS_PART);
    f32x4 g[4];
#pragma unroll
    for (int j = 0; j < 4; ++j) g[j] = *((const f32x4*)p.final_g + lane + 64 * j);
    const bf16* XB = (const bf16*)(p.ws + WS_XB);
    for (int r = gw; r < M; r += 4 * NGW) {
        u32x2 v[4][4]; float s[4];
#pragma unroll
        for (int u = 0; u < 4; ++u) { const int rr = r + u * NGW; if (rr < M) { s[u] = lane < 16 ? part[(size_t)lane * M + rr] : 0.f;
#pragma unroll
            for (int j = 0; j < 4; ++j) v[u][j] = ((const u32x2*)(XB + (size_t)rr * D))[lane + 64 * j]; } }
#pragma unroll
        for (int u = 0; u < 4; ++u) { const int rr = r + u * NGW; if (rr < M) { const float rs = __builtin_amdgcn_rsqf(wave_sum(s[u]) * (1.f / D) + EPS);
#pragma unroll
            for (int j = 0; j < 4; ++j) { const f32x4 x = {bflo(v[u][j].x), bfhi(v[u][j].x), bflo(v[u][j].y), bfhi(v[u][j].y)}; ((f32x4*)(p.out + (size_t)rr * D))[lane + 64 * j] = x * rs * g[j]; } } }
    }
}

constexpr int L_LNP = 122880;
#define CONV_LOAD_IN(inr_, item_, tid_) do { const int r0_ = (item_) * 64; int s0_, s1_; if (r0_ < M0) { s0_ = r0_ & ~8191; s1_ = s0_ + 8192; } else { s0_ = M0 + ((r0_ - M0) & ~4095); s1_ = s0_ + 4096; } \
    _Pragma("unroll") for (int k_ = 0; k_ < 6; ++k_) { const int idx_ = (tid_) + 512 * k_, row_ = idx_ >> 5, c16_ = idx_ & 31, gr_ = r0_ - 15 + row_; \
        u32x4 v_ = {0u, 0u, 0u, 0u}; if (idx_ < 94 * 32 && gr_ >= s0_ && gr_ < s1_) v_ = *(const u32x4*)((const bf16*)(p.ws + WS_GLU) + (size_t)gr_ * 256 + c16_ * 8); (inr_)[k_] = v_; } } while (0)
__device__ __forceinline__ void conv_item(ldsp lds, int item, int layer, const Params& p, const f32x2 (&w2)[31], const f32x2 bb2, u32x4 (&inr)[6], int next_item) {
    const int tid = ltid(), lane = tid & 63, w = __builtin_amdgcn_readfirstlane(tid >> 6), r16 = lane & 15, quad = lane >> 4;
    const int r0 = item * 64;
    const bf16* pwT = (const bf16*)(p.ws + WS_PWT) + (size_t)layer * 65536;
    ldsp IN = lds;
    LAS float* CV = (LAS float*)(lds + 49152);
    ldsp AO = lds;
#pragma unroll
    for (int k = 0; k < 6; ++k) { const int idx = tid + 512 * k, row = idx >> 5, c16 = idx & 31; if (idx < 94 * 32) *(LAS u32x4*)(IN + row * 512 + c16 * 16) = inr[k]; }
    u32x2 gpre[4][2];
#pragma unroll
    for (int m = 0; m < 4; ++m)
#pragma unroll
        for (int nt = 0; nt < 2; ++nt) gpre[m][nt] = *(const u32x2*)((const bf16*)(p.ws + WS_Y) + (size_t)(r0 + 16 * m + r16) * 1024 + PC_YA + 32 * w + 16 * nt + 4 * quad);
    LBAR();
    {
        const int cp = tid & 127, qtr = tid >> 7;
#pragma unroll 1
        for (int ob = 0; ob < 2; ++ob) {
            const int t0 = 16 * qtr + 8 * ob;
            f32x2 x[38];
#pragma unroll
            for (int i = 0; i < 38; ++i) { const unsigned u = *(LAS unsigned*)(IN + (t0 + i) * 512 + cp * 4); x[i] = (f32x2){bflo(u), bfhi(u)}; }
            f32x2 a0[8];
#pragma unroll
            for (int o = 0; o < 8; ++o) a0[o] = bb2;
#pragma unroll
            for (int j = 0; j < 31; ++j)
#pragma unroll
                for (int o = 0; o < 8; ++o) a0[o] = x[o + j] * w2[j] + a0[o];
#pragma unroll
            for (int o = 0; o < 8; ++o) *(LAS f32x2*)(CV + (t0 + o) * 288 + 2 * cp) = a0[o];
        }
    }
    LBAR();
    bf16x8 pwf[8][2];
#pragma unroll
    for (int kk = 0; kk < 8; ++kk) { pwf[kk][0] = *(const bf16x8*)(pwT + (size_t)(32 * w + r16) * 256 + 32 * kk + 8 * quad); pwf[kk][1] = *(const bf16x8*)(pwT + (size_t)(32 * w + 16 + r16) * 256 + 32 * kk + 8 * quad); }
    {
        const int tok = tid >> 3, part = tid & 7;
        f32x4 v[8]; float s = 0.f;
#pragma unroll
        for (int i = 0; i < 8; ++i) { v[i] = *(LAS f32x4*)(CV + tok * 288 + 32 * i + 4 * part); s += (v[i][0] + v[i][1]) + (v[i][2] + v[i][3]); }
        s += __shfl_xor(s, 1); s += __shfl_xor(s, 2); s += __shfl_xor(s, 4);
        const float mean = s * (1.f / 256.f); float q = 0.f;
#pragma unroll
        for (int i = 0; i < 8; ++i) { v[i] = v[i] - mean; q += (v[i][0] * v[i][0] + v[i][1] * v[i][1]) + (v[i][2] * v[i][2] + v[i][3] * v[i][3]); }
        q += __shfl_xor(q, 1); q += __shfl_xor(q, 2); q += __shfl_xor(q, 4);
        const float rstd = __builtin_amdgcn_rsqf(q * (1.f / 256.f) + EPS);
#pragma unroll
        for (int i = 0; i < 8; ++i) { const int c = 32 * i + 4 * part; const f32x4 gg = *(LAS f32x4*)(lds + L_LNP + c * 4), bb = *(LAS f32x4*)(lds + L_LNP + 1024 + c * 4);
            f32x4 y = v[i] * rstd * gg + bb;
            u32x2 o; o.x = pk2(siluf_(y[0]), siluf_(y[1])); o.y = pk2(siluf_(y[2]), siluf_(y[3]));
            *(LAS u32x2*)(AO + tok * 528 + c * 2) = o; }
    }
    LBAR();
    { const int nit = next_item >= 0 ? next_item : item; CONV_LOAD_IN(inr, nit, tid); }
    {
        f32x4 acc[4][2];
#pragma unroll
        for (int m = 0; m < 4; ++m) { acc[m][0] = (f32x4){0.f, 0.f, 0.f, 0.f}; acc[m][1] = (f32x4){0.f, 0.f, 0.f, 0.f}; }
#pragma unroll
        for (int kk = 0; kk < 8; ++kk) {
            const bf16x8 b0 = pwf[kk][0], b1 = pwf[kk][1]; bf16x8 af[4];
#pragma unroll
            for (int m = 0; m < 4; ++m) af[m] = *(LAS bf16x8*)(AO + (16 * m + r16) * 528 + (32 * kk + 8 * quad) * 2);
#pragma unroll
            for (int m = 0; m < 4; ++m) { acc[m][0] = MFMA16(b0, af[m], acc[m][0]); acc[m][1] = MFMA16(b1, af[m], acc[m][1]); }
        }
#pragma unroll
        for (int m = 0; m < 4; ++m)
#pragma unroll
            for (int nt = 0; nt < 2; ++nt) { bf16* gp = (bf16*)(p.ws + WS_Y) + (size_t)(r0 + 16 * m + r16) * 1024 + PC_YA + 32 * w + 16 * nt + 4 * quad;
                const u32x2 g = gpre[m][nt]; u32x2 o; o.x = pk2(acc[m][nt][0] * bflo(g.x), acc[m][nt][1] * bfhi(g.x)); o.y = pk2(acc[m][nt][2] * bflo(g.y), acc[m][nt][3] * bfhi(g.y));
                *(u32x2*)gp = o; }
    }
    LBAR();
}

__device__ __forceinline__ void sgu_item(ldsp lds, int item, int layer, const Params& p, u32x4 (&bv)[8], int next_item) {
    const int tid = ltid(), lane = tid & 63, w = __builtin_amdgcn_readfirstlane(tid >> 6), r16 = lane & 15, quad = lane >> 4;
    const int r0 = (item >> 1) * 128, hp = item & 1;
    const bf16* SW = (const bf16*)(p.ws + WS_SGW) + (size_t)layer * 65536; const float* sb = p.sgu_b + layer * 512;
    ldsp VT = lds;
    u32x2 upre[2][4], gpre[2][4];
    { const int h = 2 * hp + (w >> 2), tq = w & 3;
#pragma unroll
      for (int tti = 0; tti < 2; ++tti)
#pragma unroll
          for (int dt = 0; dt < 4; ++dt) { const size_t row = (size_t)(r0 + 16 * (2 * tq + tti) + r16); const int ch = h * 64 + 16 * dt + 4 * quad;
              upre[tti][dt] = *(const u32x2*)((const bf16*)(p.ws + WS_BU) + row * 256 + ch); gpre[tti][dt] = *(const u32x2*)((const bf16*)(p.ws + WS_Y) + row * 1024 + PC_YB + ch); } }
    {
        const int tok = tid >> 2, part = tid & 3;
        float v[64]; float s = 0.f;
#pragma unroll
        for (int i = 0; i < 8; ++i) { const u32x4 t = bv[i];
            v[8 * i + 0] = bflo(t.x); v[8 * i + 1] = bfhi(t.x); v[8 * i + 2] = bflo(t.y); v[8 * i + 3] = bfhi(t.y); v[8 * i + 4] = bflo(t.z); v[8 * i + 5] = bfhi(t.z); v[8 * i + 6] = bflo(t.w); v[8 * i + 7] = bfhi(t.w); }
#pragma unroll
        for (int i = 0; i < 64; ++i) s += v[i];
        s += __shfl_xor(s, 1); s += __shfl_xor(s, 2);
        const float mean = s * (1.f / 256.f); float q = 0.f;
#pragma unroll
        for (int i = 0; i < 64; ++i) { v[i] -= mean; q += v[i] * v[i]; }
        q += __shfl_xor(q, 1); q += __shfl_xor(q, 2);
        const float rstd = __builtin_amdgcn_rsqf(q * (1.f / 256.f) + EPS);
        const bool odd = tok & 1;
        unsigned own[16];
#pragma unroll
        for (int i = 0; i < 8; ++i) {
            if ((i >> 2) != hp) continue;
            const int cbp = (32 * i + 8 * part) * 4;
            const f32x4 g0 = *(LAS f32x4*)(lds + L_LNP + 2048 + cbp), g1 = *(LAS f32x4*)(lds + L_LNP + 2048 + cbp + 16), b0 = *(LAS f32x4*)(lds + L_LNP + 3072 + cbp), b1 = *(LAS f32x4*)(lds + L_LNP + 3072 + cbp + 16);
            own[(i & 3) * 4 + 0] = pk2(v[8 * i + 0] * rstd * g0[0] + b0[0], v[8 * i + 1] * rstd * g0[1] + b0[1]);
            own[(i & 3) * 4 + 1] = pk2(v[8 * i + 2] * rstd * g0[2] + b0[2], v[8 * i + 3] * rstd * g0[3] + b0[3]);
            own[(i & 3) * 4 + 2] = pk2(v[8 * i + 4] * rstd * g1[0] + b1[0], v[8 * i + 5] * rstd * g1[1] + b1[1]);
            own[(i & 3) * 4 + 3] = pk2(v[8 * i + 6] * rstd * g1[2] + b1[2], v[8 * i + 7] * rstd * g1[3] + b1[3]);
        }
        unsigned oth[16];
#pragma unroll
        for (int k = 0; k < 16; ++k) oth[k] = (unsigned)__shfl_xor((int)own[k], 4);
#pragma unroll
        for (int k = 0; k < 16; ++k) {
            const int cb = 32 * (4 * hp + (k >> 2)) + 8 * part, e2 = 2 * (k & 3);
            const unsigned val = odd ? ((oth[k] >> 16) | (own[k] & 0xffff0000u)) : ((own[k] & 0xffffu) | (oth[k] << 16));
            const int ch = cb + e2 + (odd ? 1 : 0), t0 = tok & ~1;
            *(LAS unsigned*)(VT + ch * 272 + t0 * 2) = val;
        }
    }
    LBAR();
    bf16x8 wfp[2][4];
    { const int h = 2 * hp + (w >> 2), tq = w & 3;
#pragma unroll
      for (int tti = 0; tti < 2; ++tti)
#pragma unroll
          for (int kk = 0; kk < 4; ++kk) wfp[tti][kk] = *(const bf16x8*)(SW + (size_t)(h * 128 + 16 * (2 * tq + tti) + r16) * 128 + 32 * kk + 8 * quad); }
    { const int nit = next_item >= 0 ? next_item : item; const bf16* srcn = (const bf16*)(p.ws + WS_BV) + (size_t)((nit >> 1) * 128 + (tid >> 2)) * 256;
#pragma unroll
      for (int i = 0; i < 8; ++i) bv[i] = *(const u32x4*)(srcn + 32 * i + 8 * (tid & 3)); }
    {
        const int h = 2 * hp + (w >> 2), tq = w & 3;
        bf16x8 vf[4][4];
#pragma unroll
        for (int dt = 0; dt < 4; ++dt)
#pragma unroll
            for (int kk = 0; kk < 4; ++kk) vf[dt][kk] = *(LAS bf16x8*)(VT + (h * 64 + 16 * dt + r16) * 272 + (32 * kk + 8 * quad) * 2);
#pragma unroll
        for (int tti = 0; tti < 2; ++tti) {
            const int tt = 2 * tq + tti;
            bf16x8 wf[4];
#pragma unroll
            for (int kk = 0; kk < 4; ++kk) wf[kk] = wfp[tti][kk];
            f32x4 acc[4];
#pragma unroll
            for (int dt = 0; dt < 4; ++dt) { acc[dt] = (f32x4){0.f, 0.f, 0.f, 0.f};
#pragma unroll
                for (int kk = 0; kk < 4; ++kk) acc[dt] = MFMA16(vf[dt][kk], wf[kk], acc[dt]); }
            const float bias = sb[h * 128 + 16 * tt + r16];
            bf16* rowy = (bf16*)(p.ws + WS_Y) + (size_t)(r0 + 16 * tt + r16) * 1024; const bf16* rowu = (const bf16*)(p.ws + WS_BU) + (size_t)(r0 + 16 * tt + r16) * 256;
#pragma unroll
            for (int dt = 0; dt < 4; ++dt) { const int ch = h * 64 + 16 * dt + 4 * quad;
                const u32x2 uu = upre[tti][dt], g = gpre[tti][dt]; u32x2 o;
                o.x = pk2(bflo(uu.x) * (acc[dt][0] + bias) * bflo(g.x), bfhi(uu.x) * (acc[dt][1] + bias) * bfhi(g.x));
                o.y = pk2(bflo(uu.y) * (acc[dt][2] + bias) * bflo(g.y), bfhi(uu.y) * (acc[dt][3] + bias) * bfhi(g.y));
                *(u32x2*)(rowy + PC_YB + ch) = o; }
        }
    }
    LBAR();
}

constexpr int H_QD = 0, H_KD = 17408, H_KO = 34816, H_Q3 = 52224, H_K0 = 56576, H_KST = 60928, H_VT = 79360, H_SC = 97792, H_TT = 107008, H_ER = 109056, H_DEC = 111104, H_OS = 111616;

__device__ __forceinline__ void score_tile(ldsp lds, int qoff, int koff, int ti, int sj, bool diag, int r16, int quad) {
    f32x4 acc = {0.f, 0.f, 0.f, 0.f};
    bf16x8 ka[4], qa[4];
#pragma unroll
    for (int kk = 0; kk < 4; ++kk) { ka[kk] = *(LAS bf16x8*)(lds + koff + r16 * 272 + (32 * kk + 8 * quad) * 2); qa[kk] = *(LAS bf16x8*)(lds + qoff + r16 * 272 + (32 * kk + 8 * quad) * 2); }
#pragma unroll
    for (int kk = 0; kk < 4; ++kk) acc = MFMA16(ka[kk], qa[kk], acc);
    if (diag) {
#pragma unroll
        for (int e = 0; e < 4; ++e) if (4 * quad + e > r16) acc[e] = 0.f;
    }
    u32x2 o; o.x = pk2(acc[0], acc[1]); o.y = pk2(acc[2], acc[3]);
    *(LAS u32x2*)(lds + H_SC + (16 * ti + r16) * 144 + (16 * sj + 4 * quad) * 2) = o;
}

__device__ __forceinline__ void gate_fk(float z, float lbv, float oml, float& f, float& kk) {
    z = fmaxf(z, -30.f);
    const float e = __expf(-z), s = __builtin_amdgcn_rcpf(1.f + e);
    f = oml * s + lbv; kk = oml * e * s;
}
constexpr int H_T8 = 113664, H_QS = 117760;
#define HG_TOK(c0_, i_) (dir ? (c0_) + 63 - 8 * w - (i_) : (c0_) + 8 * w + (i_))
#define HG_LD(arr_, c0_, i_) (*(const unsigned*)(Pb + ((unsigned)HG_TOK(c0_, i_) * 256u + (arr_))))

constexpr int A_KST = 0, A_VT = 34816, A_T8 = 69632, A_DEC = 73728;
#define HGA_LD(arr_, c0_, i_) (*(const unsigned*)(Pb + ((unsigned)(dir ? (c0_) + 127 - 16 * w - (i_) : (c0_) + 16 * w + (i_)) * 256u + (arr_))))
template <int DIR> __device__ __forceinline__ void hgrn_passA_dir(ldsp lds, int item, int layer, const Params& p) {
    const int tid = ltid(), lane = tid & 63, w = __builtin_amdgcn_readfirstlane(tid >> 6), r16 = lane & 15, quad = lane >> 4;
    constexpr int dir = DIR; const int h = (item >> 1) & 3, sg = item >> 3; const int slot = item;
    const int kp = lane;
    float lb0 = 0.f, lb1 = 0.f;
    if (layer) { const float* lp = dir ? p.lb_b : p.lb_f; const f32x2 a = *(const f32x2*)(lp + 512 + h * 128 + 2 * kp), b = *(const f32x2*)(lp + h * 128 + 2 * kp); lb0 = sigmoidf_(a.x - b.x); lb1 = sigmoidf_(a.y - b.y); }
    const float om0 = 1.f - lb0, om1 = 1.f - lb1;
    f32x4 S[8];
#pragma unroll
    for (int m = 0; m < 8; ++m) S[m] = (f32x4){0.f, 0.f, 0.f, 0.f};
    float pd0 = 1.f, pd1 = 1.f;
    const unsigned char* Pb = p.ws + WS_HQ; const unsigned az = (dir ? 3u : 2u) * HARR + (unsigned)h * HHEAD + kp * 4u, av = HARR + (unsigned)h * HHEAD + kp * 4u;
    unsigned zr[16];
    { const int c0 = sg * 256 + (dir ? 128 : 0);
#pragma unroll
      for (int i = 0; i < 16; ++i) zr[i] = HGA_LD(az, c0, i); }
#pragma unroll 1
    for (int cc = 0; cc < 2; ++cc) {
        unsigned vr[16];
        { const int c0 = sg * 256 + ((dir != 0) == (cc == 0) ? 128 : 0);
#pragma unroll
          for (int i = 0; i < 16; ++i) vr[i] = HGA_LD(av, c0, i); }
        float ks0[16], ks1[16]; float E0 = 1.f, E1 = 1.f;
#pragma unroll
        for (int i = 15; i >= 0; --i) { float f0, f1, k0, k1; gate_fk(bflo(zr[i]), lb0, om0, f0, k0); gate_fk(bfhi(zr[i]), lb1, om1, f1, k1); ks0[i] = k0 * E0; ks1[i] = k1 * E1; E0 *= f0; E1 *= f1; }
        *(LAS f32x2*)(lds + A_T8 + (w * 128 + 2 * kp) * 4) = (f32x2){E0, E1};
#pragma unroll
        for (int hf = 0; hf < 2; ++hf) {
            *(LAS u32x4*)(lds + A_VT + (2 * kp) * 272 + 32 * w + 16 * hf) = (u32x4){__builtin_amdgcn_perm(vr[8 * hf + 1], vr[8 * hf + 0], 0x05040100u), __builtin_amdgcn_perm(vr[8 * hf + 3], vr[8 * hf + 2], 0x05040100u), __builtin_amdgcn_perm(vr[8 * hf + 5], vr[8 * hf + 4], 0x05040100u), __builtin_amdgcn_perm(vr[8 * hf + 7], vr[8 * hf + 6], 0x05040100u)};
            *(LAS u32x4*)(lds + A_VT + (2 * kp + 1) * 272 + 32 * w + 16 * hf) = (u32x4){__builtin_amdgcn_perm(vr[8 * hf + 1], vr[8 * hf + 0], 0x07060302u), __builtin_amdgcn_perm(vr[8 * hf + 3], vr[8 * hf + 2], 0x07060302u), __builtin_amdgcn_perm(vr[8 * hf + 5], vr[8 * hf + 4], 0x07060302u), __builtin_amdgcn_perm(vr[8 * hf + 7], vr[8 * hf + 6], 0x07060302u)}; }
        if (cc == 0) { const int c0 = sg * 256 + (dir ? 0 : 128);
#pragma unroll
            for (int i = 0; i < 16; ++i) zr[i] = HGA_LD(az, c0, i); }
        LBAR();
        float fa0 = 1.f, fa1 = 1.f, d0 = 1.f, d1 = 1.f;
#pragma unroll
        for (int g = 0; g < 8; ++g) { const f32x2 t = *(LAS f32x2*)(lds + A_T8 + (g * 128 + 2 * kp) * 4); d0 *= t.x; d1 *= t.y; if (g > w) { fa0 *= t.x; fa1 *= t.y; } }
#pragma unroll
        for (int hf = 0; hf < 2; ++hf) {
            *(LAS u32x4*)(lds + A_KST + (2 * kp) * 272 + 32 * w + 16 * hf) = (u32x4){pk2(ks0[8 * hf + 0] * fa0, ks0[8 * hf + 1] * fa0), pk2(ks0[8 * hf + 2] * fa0, ks0[8 * hf + 3] * fa0), pk2(ks0[8 * hf + 4] * fa0, ks0[8 * hf + 5] * fa0), pk2(ks0[8 * hf + 6] * fa0, ks0[8 * hf + 7] * fa0)};
            *(LAS u32x4*)(lds + A_KST + (2 * kp + 1) * 272 + 32 * w + 16 * hf) = (u32x4){pk2(ks1[8 * hf + 0] * fa1, ks1[8 * hf + 1] * fa1), pk2(ks1[8 * hf + 2] * fa1, ks1[8 * hf + 3] * fa1), pk2(ks1[8 * hf + 4] * fa1, ks1[8 * hf + 5] * fa1), pk2(ks1[8 * hf + 6] * fa1, ks1[8 * hf + 7] * fa1)}; }
        if (w == 0) { *(LAS f32x2*)(lds + A_DEC + 2 * kp * 4) = (f32x2){d0, d1}; pd0 *= d0; pd1 *= d1; }
        LBAR();
        bf16x8 vf[4];
#pragma unroll
        for (int kk = 0; kk < 4; ++kk) vf[kk] = *(LAS bf16x8*)(lds + A_VT + (16 * w + r16) * 272 + (32 * kk + 8 * quad) * 2);
#pragma unroll
        for (int mh = 0; mh < 4; ++mh) {
            bf16x8 af[2][4]; f32x4 dd[2];
#pragma unroll
            for (int mi = 0; mi < 2; ++mi) { const int m = 2 * mh + mi; dd[mi] = *(LAS f32x4*)(lds + A_DEC + (16 * m + 4 * quad) * 4);
#pragma unroll
                for (int kk = 0; kk < 4; ++kk) af[mi][kk] = *(LAS bf16x8*)(lds + A_KST + (16 * m + r16) * 272 + (32 * kk + 8 * quad) * 2); }
#pragma unroll
            for (int mi = 0; mi < 2; ++mi) { const int m = 2 * mh + mi; S[m] = S[m] * dd[mi];
#pragma unroll
                for (int kk = 0; kk < 4; ++kk) S[m] = MFMA16(af[mi][kk], vf[kk], S[m]); } }
        LBAR();
    }
    u32x4* sp = (u32x4*)((unsigned char*)p.out + OUT_ST + (size_t)slot * 32768) + (w * 64 + lane) * 4;
#pragma unroll
    for (int i = 0; i < 4; ++i) sp[i] = (u32x4){pk2(S[2 * i][0], S[2 * i][1]), pk2(S[2 * i][2], S[2 * i][3]), pk2(S[2 * i + 1][0], S[2 * i + 1][1]), pk2(S[2 * i + 1][2], S[2 * i + 1][3])};
    if (w == 0) *(f32x2*)((float*)(p.ws + WS_LOGD) + slot * 128 + 2 * kp) = (f32x2){pd0, pd1};
}
__device__ __forceinline__ void hgrn_passA_item(ldsp lds, int item, int layer, const Params& p) { if (item & 1) hgrn_passA_dir<1>(lds, item, layer, p); else hgrn_passA_dir<0>(lds, item, layer, p); }

__device__ __forceinline__ void hgrn_passB(const Params& p) {
    unsigned char* ST = (unsigned char*)p.out + OUT_ST; const float* LD = (const float*)(p.ws + WS_LOGD);
    const int gt = blockIdx.x * 512 + ltid(), NT = gridDim.x * 512;
#pragma unroll 1
    for (int e = gt; e < 64 * 4096; e += NT) {
        const int chain = e >> 12, q = e & 4095, m = q & 7, ln = (q >> 3) & 63, sq = chain >> 3, h = (chain >> 1) & 3, dir = chain & 1;
        const int kd = 16 * m + 4 * (ln >> 4);
        const int seg0 = sq < 4 ? sq * 32 : 128 + (sq - 4) * 16, n = sq < 4 ? 32 : 16;
        const int sgf = dir ? seg0 + n - 1 : seg0, step = dir ? -1 : 1;
        f32x4 carry = {0.f, 0.f, 0.f, 0.f};
#pragma unroll 1
        for (int s0 = 0; s0 < n; s0 += 16) {
            u32x2 loc[16]; f32x4 dd[16];
#pragma unroll
            for (int s = 0; s < 16; ++s) { const int slot = ((sgf + step * (s0 + s)) * 4 + h) * 2 + dir; loc[s] = *(const u32x2*)(ST + (size_t)slot * 32768 + q * 8); dd[s] = *(const f32x4*)(LD + slot * 128 + kd); }
#pragma unroll
            for (int s = 0; s < 16; ++s) { const int slot = ((sgf + step * (s0 + s)) * 4 + h) * 2 + dir;
                *(u32x2*)(ST + (size_t)slot * 32768 + q * 8) = (u32x2){pk2(carry[0], carry[1]), pk2(carry[2], carry[3])};
                carry = dd[s] * carry + (f32x4){bflo(loc[s].x), bfhi(loc[s].x), bflo(loc[s].y), bfhi(loc[s].y)}; }
        }
    }
}

template <int DIR> __device__ __forceinline__ void hgrn_passC_dir(ldsp lds, int item, int layer, const Params& p) {
    const int tid = ltid(), lane = tid & 63, w = __builtin_amdgcn_readfirstlane(tid >> 6), r16 = lane & 15, quad = lane >> 4;
    const int h = item & 3, sg = item >> 2;
    const int kp = lane;
    const f32x4 gn = *(const f32x4*)(p.hgrn_g + layer * 128 + 16 * w + 4 * quad);
    constexpr int dir = DIR;
    {
        const int slot = (sg * 4 + h) * 2 + dir;
        float lb0 = 0.f, lb1 = 0.f;
        if (layer) { const float* lp = dir ? p.lb_b : p.lb_f; const f32x2 a = *(const f32x2*)(lp + 512 + h * 128 + 2 * kp), b = *(const f32x2*)(lp + h * 128 + 2 * kp); lb0 = sigmoidf_(a.x - b.x); lb1 = sigmoidf_(a.y - b.y); }
        const float om0 = 1.f - lb0, om1 = 1.f - lb1;
        f32x4 S[8];
        { const u32x4* sp = (const u32x4*)((const unsigned char*)p.out + OUT_ST + (size_t)slot * 32768) + (w * 64 + lane) * 4;
#pragma unroll
          for (int i = 0; i < 4; ++i) { const u32x4 t = sp[i]; S[2 * i] = (f32x4){bflo(t.x), bfhi(t.x), bflo(t.y), bfhi(t.y)}; S[2 * i + 1] = (f32x4){bflo(t.z), bfhi(t.z), bflo(t.w), bfhi(t.w)}; } }
        unsigned char* Pb = p.ws + WS_HQ; bf16* Y = (bf16*)(p.ws + WS_Y);
        const unsigned aq = (unsigned)h * HHEAD + kp * 4u, az = (dir ? 3u : 2u) * HARR + (unsigned)h * HHEAD + kp * 4u, av = HARR + (unsigned)h * HHEAD + kp * 4u;
        const unsigned colo = 2u * HARR + (unsigned)h * HHEAD + (16 * w + 4 * quad) * 2u;
        unsigned zr[8], qr[8], vr[8];
        { const int c0 = sg * 256 + (dir ? (SEGC - 1) : 0) * 64;
#pragma unroll
          for (int i = 0; i < 8; ++i) { zr[i] = HG_LD(az, c0, i); qr[i] = HG_LD(aq, c0, i); vr[i] = HG_LD(av, c0, i); } }
#pragma unroll 1
        for (int cc = 0; cc < SEGC; ++cc) {
            const int c0 = sg * 256 + (dir ? (SEGC - 1 - cc) : cc) * 64;
            u32x2 ofr[4], ggr[4];
            {
                float el0[8], el1[8], kk0[8], kk1[8], q0[8], q1[8]; float E0 = 1.f, E1 = 1.f;
#pragma unroll
                for (int i = 0; i < 8; ++i) { float f0, f1; gate_fk(bflo(zr[i]), lb0, om0, f0, kk0[i]); gate_fk(bfhi(zr[i]), lb1, om1, f1, kk1[i]); E0 *= f0; E1 *= f1; el0[i] = E0; el1[i] = E1; q0[i] = bflo(qr[i]); q1[i] = bfhi(qr[i]); }
                *(LAS f32x2*)(lds + H_T8 + (w * 128 + 2 * kp) * 4) = (f32x2){E0, E1};
                *(LAS u32x4*)(lds + H_VT + (2 * kp) * 144 + 16 * w) = (u32x4){__builtin_amdgcn_perm(vr[1], vr[0], 0x05040100u), __builtin_amdgcn_perm(vr[3], vr[2], 0x05040100u), __builtin_amdgcn_perm(vr[5], vr[4], 0x05040100u), __builtin_amdgcn_perm(vr[7], vr[6], 0x05040100u)};
                *(LAS u32x4*)(lds + H_VT + (2 * kp + 1) * 144 + 16 * w) = (u32x4){__builtin_amdgcn_perm(vr[1], vr[0], 0x07060302u), __builtin_amdgcn_perm(vr[3], vr[2], 0x07060302u), __builtin_amdgcn_perm(vr[5], vr[4], 0x07060302u), __builtin_amdgcn_perm(vr[7], vr[6], 0x07060302u)};
                if (cc + 1 < SEGC) { const int c1 = sg * 256 + (dir ? (SEGC - 2 - cc) : cc + 1) * 64;
#pragma unroll
                    for (int i = 0; i < 8; ++i) { zr[i] = HG_LD(az, c1, i); qr[i] = HG_LD(aq, c1, i); vr[i] = HG_LD(av, c1, i); } }
                if (dir == 1) {
#pragma unroll
                    for (int tt = 0; tt < 4; ++tt) { const int tok = c0 + 63 - (16 * tt + r16); ofr[tt] = *(const u32x2*)(Pb + ((unsigned)tok * 256u + colo)); ggr[tt] = *(const u32x2*)(Y + (size_t)tok * 1024 + PC_YC + h * 128 + 16 * w + 4 * quad); } }
                LBAR();
                f32x2 T[8], PF[9];
#pragma unroll
                for (int g = 0; g < 8; ++g) T[g] = *(LAS f32x2*)(lds + H_T8 + (g * 128 + 2 * kp) * 4);
                PF[0] = (f32x2){1.f, 1.f};
#pragma unroll
                for (int g = 0; g < 8; ++g) PF[g + 1] = PF[g] * T[g];
                f32x2 pf;
                switch (w) { case 0: pf = PF[0]; break; case 1: pf = PF[1]; break; case 2: pf = PF[2]; break; case 3: pf = PF[3]; break; case 4: pf = PF[4]; break; case 5: pf = PF[5]; break; case 6: pf = PF[6]; break; default: pf = PF[7]; break; }
                float bt0[8], bt1[8];
#pragma unroll
                for (int i = 0; i < 8; ++i) { const int tau = 8 * w + i;
                    const float e0 = pf.x * el0[i], e1 = pf.y * el1[i];
                    bt0[i] = kk0[i] * __builtin_amdgcn_rcpf(fmaxf(e0, 1e-34f)); bt1[i] = kk1[i] * __builtin_amdgcn_rcpf(fmaxf(e1, 1e-34f));
                    *(LAS unsigned*)(lds + H_QS + tau * 272 + kp * 4) = pk2(q0[i] * e0, q1[i] * e1);
                    *(LAS unsigned*)(lds + H_KD + tau * 272 + kp * 4) = pk2(bt0[i], bt1[i]); }
                *(LAS u32x4*)(lds + H_KST + (2 * kp) * 144 + 16 * w) = (u32x4){pk2(bt0[0], bt0[1]), pk2(bt0[2], bt0[3]), pk2(bt0[4], bt0[5]), pk2(bt0[6], bt0[7])};
                *(LAS u32x4*)(lds + H_KST + (2 * kp + 1) * 144 + 16 * w) = (u32x4){pk2(bt1[0], bt1[1]), pk2(bt1[2], bt1[3]), pk2(bt1[4], bt1[5]), pk2(bt1[6], bt1[7])};
                if (w == 4) *(LAS f32x2*)(lds + H_DEC + 2 * kp * 4) = PF[8];
                LBAR();
            }
            if (w < 4) score_tile(lds, H_QS + 16 * w * 272, H_KD + 16 * w * 272, w, w, true, r16, quad);
            else if (w < 7) score_tile(lds, H_QS + 16 * (w - 3) * 272, H_KD + 16 * (w - 4) * 272, w - 3, w - 4, false, r16, quad);
            else score_tile(lds, H_QS + 32 * 272, H_KD, 2, 0, false, r16, quad);
            if (w == 0) score_tile(lds, H_QS + 48 * 272, H_KD + 16 * 272, 3, 1, false, r16, quad);
            if (w == 1) score_tile(lds, H_QS + 48 * 272, H_KD, 3, 0, false, r16, quad);
            if (w == 2) *(LAS u32x2*)(lds + H_SC + (r16) * 144 + (16 + 4 * quad) * 2) = (u32x2){0u, 0u};
            if (w == 3) *(LAS u32x2*)(lds + H_SC + (32 + r16) * 144 + (48 + 4 * quad) * 2) = (u32x2){0u, 0u};
            f32x4 o[4];
            bf16x8 sa[4];
#pragma unroll
            for (int pp = 0; pp < 4; ++pp) sa[pp] = mk8(pk2(S[2 * pp][0], S[2 * pp][1]), pk2(S[2 * pp][2], S[2 * pp][3]), pk2(S[2 * pp + 1][0], S[2 * pp + 1][1]), pk2(S[2 * pp + 1][2], S[2 * pp + 1][3]));
#pragma unroll
            for (int tt = 0; tt < 4; ++tt) { o[tt] = (f32x4){0.f, 0.f, 0.f, 0.f};
                u32x2 qb[4][2];
#pragma unroll
                for (int pp = 0; pp < 4; ++pp) { qb[pp][0] = *(LAS u32x2*)(lds + H_QS + (16 * tt + r16) * 272 + (32 * pp + 4 * quad) * 2); qb[pp][1] = *(LAS u32x2*)(lds + H_QS + (16 * tt + r16) * 272 + (32 * pp + 16 + 4 * quad) * 2); }
#pragma unroll
                for (int pp = 0; pp < 4; ++pp) o[tt] = MFMA16(sa[pp], mk8(qb[pp][0].x, qb[pp][0].y, qb[pp][1].x, qb[pp][1].y), o[tt]); }
            LBAR();
            bf16x8 vf[2];
#pragma unroll
            for (int kk = 0; kk < 2; ++kk) vf[kk] = *(LAS bf16x8*)(lds + H_VT + (16 * w + r16) * 144 + (32 * kk + 8 * quad) * 2);
            bf16x8 scf[4][2];
#pragma unroll
            for (int tt = 0; tt < 4; ++tt)
#pragma unroll
                for (int kk = 0; kk < 2; ++kk) { if (kk == 1 && tt < 2) continue; scf[tt][kk] = *(LAS bf16x8*)(lds + H_SC + (16 * tt + r16) * 144 + (32 * kk + 8 * quad) * 2); }
#pragma unroll
            for (int tt = 0; tt < 4; ++tt)
#pragma unroll
                for (int kk = 0; kk < 2; ++kk) { if (kk == 1 && tt < 2) continue; o[tt] = MFMA16(vf[kk], scf[tt][kk], o[tt]); }
#pragma unroll
            for (int mh = 0; mh < 2; ++mh) {
                bf16x8 af[4][2]; f32x4 dd[4];
#pragma unroll
                for (int mi = 0; mi < 4; ++mi) { const int m = 4 * mh + mi;
#pragma unroll
                    for (int kk = 0; kk < 2; ++kk) af[mi][kk] = *(LAS bf16x8*)(lds + H_KST + (16 * m + r16) * 144 + (32 * kk + 8 * quad) * 2);
                    dd[mi] = *(LAS f32x4*)(lds + H_DEC + (16 * m + 4 * quad) * 4); }
#pragma unroll
                for (int mi = 0; mi < 4; ++mi) { const int m = 4 * mh + mi;
#pragma unroll
                    for (int kk = 0; kk < 2; ++kk) S[m] = MFMA16(af[mi][kk], vf[kk], S[m]);
                    S[m] = S[m] * dd[mi]; } }
            if (dir == 0) {
#pragma unroll
                for (int tt = 0; tt < 4; ++tt) { const int tok = c0 + 16 * tt + r16; u32x2 ov; ov.x = pk2(o[tt][0], o[tt][1]); ov.y = pk2(o[tt][2], o[tt][3]);
                    *(u32x2*)(Pb + ((unsigned)tok * 256u + colo)) = ov; }
                LBAR();
            } else {
#pragma unroll
                for (int tt = 0; tt < 4; ++tt) { const int tok = c0 + 63 - (16 * tt + r16);
                    const u32x2 of = ofr[tt];
                    o[tt][0] += bflo(of.x); o[tt][1] += bfhi(of.x); o[tt][2] += bflo(of.y); o[tt][3] += bfhi(of.y);
                    float ss = (o[tt][0] * o[tt][0] + o[tt][1] * o[tt][1]) + (o[tt][2] * o[tt][2] + o[tt][3] * o[tt][3]);
                    ss += __shfl_xor(ss, 16); ss += __shfl_xor(ss, 32);
                    if (quad == 0) *(LAS float*)(lds + H_OS + (w * 64 + 16 * tt + r16) * 4) = ss; }
                LBAR();
#pragma unroll
                for (int tt = 0; tt < 4; ++tt) { const int tau = 16 * tt + r16, tok = c0 + 63 - tau; float tot = 0.f;
#pragma unroll
                    for (int ww = 0; ww < 8; ++ww) tot += *(LAS float*)(lds + H_OS + (ww * 64 + tau) * 4);
                    const float rs = __builtin_amdgcn_rsqf(tot * (1.f / 128.f) + EPS);
                    bf16* gp = Y + (size_t)tok * 1024 + PC_YC + h * 128 + 16 * w + 4 * quad; const u32x2 g = ggr[tt]; u32x2 ov;
                    ov.x = pk2(o[tt][0] * rs * gn[0] * bflo(g.x), o[tt][1] * rs * gn[1] * bfhi(g.x)); ov.y = pk2(o[tt][2] * rs * gn[2] * bflo(g.y), o[tt][3] * rs * gn[3] * bfhi(g.y));
                    *(u32x2*)gp = ov; }
            }
        }
        __syncthreads();
    }
}
__device__ __forceinline__ void hgrn_passC_item(ldsp lds, int item, int layer, const Params& p) { hgrn_passC_dir<0>(lds, item, layer, p); hgrn_passC_dir<1>(lds, item, layer, p); }

#define XB_TMO      128
#define XB_XCNT(j)  (256  + 64 * (j))
#define XB_XSUB(j)  (1280 + 64 * (j))
#define XB_XGEN(j)  (2304 + 64 * (j))
#define XB_TOP      3328
#define XB_TOPGEN   3392
#define XCD_BAR_WORDS 3456
#define XB_SPIN_CAP (1u << 18)

__device__ __forceinline__ unsigned xb_ld(unsigned* p)              { return __hip_atomic_load(p, __ATOMIC_RELAXED, __HIP_MEMORY_SCOPE_AGENT); }
__device__ __forceinline__ unsigned xb_add(unsigned* p, unsigned v) { return __hip_atomic_fetch_add(p, v, __ATOMIC_RELAXED, __HIP_MEMORY_SCOPE_AGENT); }
__device__ __forceinline__ unsigned xb_xcc_id() { return (unsigned)__builtin_amdgcn_s_getreg((3 << 11) | 20) & 0xFu; }
#define XB_SPIN(cond, bar) do { unsigned _sp = 0; while (cond) { __builtin_amdgcn_s_sleep(1); \
    if ((++_sp & 255u) == 0u) { if (xb_ld(&(bar)[XB_TMO])) break; if (_sp > XB_SPIN_CAP) { atomicAdd(&(bar)[XB_TMO], 1u); break; } } } } while (0)

struct XcdBarrier {
    unsigned* bar; unsigned x;
    volatile LAS unsigned* st;
};

__device__ __forceinline__ XcdBarrier xcd_barrier_post(unsigned* bar, volatile LAS unsigned* st) {
    XcdBarrier b; b.bar = bar; b.x = xb_xcc_id(); b.st = st;
    if (ltid() == 0) (void)xb_add(&bar[XB_XCNT(b.x)], 1u);
    return b;
}
__device__ __forceinline__ void xcd_barrier_complete(unsigned* bar, unsigned x, unsigned& nloc, unsigned& nx) {
    const unsigned G = gridDim.x * gridDim.y * gridDim.z;
    unsigned sum, cnt, mine, sp = 0u;
    for (;;) {
        sum = 0u; cnt = 0u; mine = 0u;
#pragma unroll
        for (unsigned j = 0; j < 16; ++j) { const unsigned c = xb_ld(&bar[XB_XCNT(j)]); sum += c; cnt += (c > 0u) ? 1u : 0u; mine = (j == x) ? c : mine; }
        if (sum == G) break;
        __builtin_amdgcn_s_sleep(1);
        if ((++sp & 255u) == 0u) { if (xb_ld(&bar[XB_TMO])) break; if (sp > XB_SPIN_CAP) { atomicAdd(&bar[XB_TMO], 1u); break; } }
    }
    nloc = mine > 0u ? mine : 1u; nx = cnt > 0u ? cnt : 1u;
}

__device__ __forceinline__ void xcd_barrier(const XcdBarrier& b) {
    asm volatile("s_waitcnt vmcnt(0)" ::: "memory");
    __syncthreads();
    if (ltid() == 0) {
        unsigned* bar = b.bar;
        __builtin_amdgcn_s_waitcnt(0);
        unsigned nloc = b.st[0], nx = b.st[1];
        if (nloc == 0u) { xcd_barrier_complete(bar, b.x, nloc, nx); b.st[0] = nloc; b.st[1] = nx; }
        const unsigned old = xb_add(&bar[XB_XSUB(b.x)], 1u);
        const unsigned gen = old / nloc;
        if (old + 1u == (gen + 1u) * nloc) {
            __builtin_amdgcn_fence(__ATOMIC_RELEASE, "agent");
            asm volatile("s_waitcnt vmcnt(0)" ::: "memory");
            const unsigned og = xb_add(&bar[XB_TOP], 1u);
            const unsigned tg = og / nx;
            if (og + 1u == (tg + 1u) * nx) xb_add(&bar[XB_TOPGEN], 1u);
            else XB_SPIN(xb_ld(&bar[XB_TOPGEN]) == tg, bar);
            __builtin_amdgcn_fence(__ATOMIC_ACQUIRE, "agent");
            xb_add(&bar[XB_XGEN(b.x)], 1u);
            asm volatile("s_waitcnt vmcnt(0)" ::: "memory");
        } else {
            XB_SPIN(xb_ld(&bar[XB_XGEN(b.x)]) == gen, bar);
            __builtin_amdgcn_fence(__ATOMIC_ACQUIRE, "agent");
            asm volatile("s_waitcnt vmcnt(0)" ::: "memory");
        }
    }
    __syncthreads();
}


__global__ void __launch_bounds__(512, 2) fwd_kernel(Params p) {
    extern __shared__ __attribute__((aligned(16))) unsigned char lds_raw[];
    ldsp lds = (ldsp)lds_raw;
    cg::grid_group grid = cg::this_grid();
    unsigned char* ws = p.ws;
    bf16* XB = (bf16*)(ws + WS_XB); float* part = (float*)(ws + WS_PART);
    const int G = gridDim.x, bx = blockIdx.x;
    if (ltid() < 2) *(LAS unsigned*)(lds + LDS_BARST + 4 * ltid()) = 0u;
    __syncthreads();
    const XcdBarrier xbar = xcd_barrier_post((unsigned*)(ws + WS_BAR), (volatile LAS unsigned*)(lds + LDS_BARST));
#pragma unroll 1
    for (int ph = p.ph_lo; ph < p.ph_hi; ++ph) {
        if (ph == 0) prologue(lds, p);
        else if (ph == NPH - 1) final_norm(p);
        else {
            const int layer = (ph - 1) / 5, sub = (ph - 1) % 5;
            if (sub == 0) {
                pg8::Gemm g{layer == 0 ? XB : (const bf16*)p.out, (const bf16*)(ws + WS_BT1) + (size_t)layer * DIN * D, M, DIN, D, D}; pg8::StaticOrder S; S.init(M, DIN, G, bx);
                Epi1 E{ws, part};
                pg8::gemm_phase<Epi1, pg8::StaticOrder, true, true>(lds, g, S, E);
            } else if (sub == 1) {
                for (int it = bx; it < NSEG * 8; it += G) hgrn_passA_item(lds, it, layer, p);
            } else if (sub == 2) {
                hgrn_passB(p);
                { const int t_ = ltid(); if (t_ < 256) { *(LAS float*)(lds + L_LNP + 4 * t_) = p.conv_ln_g[layer * 256 + t_]; *(LAS float*)(lds + L_LNP + 1024 + 4 * t_) = p.conv_ln_b[layer * 256 + t_];
                      *(LAS float*)(lds + L_LNP + 2048 + 4 * t_) = p.sgu_ln_g[layer * 256 + t_]; *(LAS float*)(lds + L_LNP + 3072 + 4 * t_) = p.sgu_ln_b[layer * 256 + t_]; } }
                { f32x2 w2[31]; const int cp = ltid() & 127; const float* cw = p.conv_w + layer * 31 * 256;
#pragma unroll
                  for (int j = 0; j < 31; ++j) w2[j] = *(const f32x2*)(cw + j * 256 + 2 * cp);
                  const f32x2 bb2 = *(const f32x2*)(p.conv_b + layer * 256 + 2 * cp);
                  u32x4 inr[6]; CONV_LOAD_IN(inr, bx < 768 ? bx : 0, ltid());
                  for (int it = bx; it < 768; it += G) conv_item(lds, it, layer, p, w2, bb2, inr, it + G < 768 ? it + G : -1); }
                { u32x4 bv[8]; const int tid_ = ltid(); const int it0 = bx < 768 ? bx : 0;
                  { const bf16* src = (const bf16*)(p.ws + WS_BV) + (size_t)((it0 >> 1) * 128 + (tid_ >> 2)) * 256;
#pragma unroll
                    for (int i = 0; i < 8; ++i) bv[i] = *(const u32x4*)(src + 32 * i + 8 * (tid_ & 3)); }
                  for (int it = bx; it < 768; it += G) sgu_item(lds, it, layer, p, bv, it + G < 768 ? it + G : -1); }
            } else if (sub == 3) {
                for (int it = bx; it < NSEG * 4; it += G) hgrn_passC_item(lds, it, layer, p);
            } else {
                pg8::Gemm g{(const bf16*)(ws + WS_Y), (const bf16*)(ws + WS_BT2) + (size_t)layer * D * D, M, D, D, D}; pg8::StaticOrder S; S.init(M, D, G, bx);
                Epi2 E{p.xp, p.xs, M0, layer == 0 ? (const bf16*)XB : (const bf16*)p.out, nullptr, layer == 0 ? (bf16*)p.out : XB, part};
                pg8::gemm_phase<Epi2, pg8::StaticOrder, true, true>(lds, g, S, E);
            }
        }
        if (ph + 1 < p.ph_hi) { if (p.ph_hi > NPH) grid.sync();
                                xcd_barrier(xbar); }
    }
}

extern "C" void kernel_launch(void* const* d_in, const int* in_sizes, int n_in, void* d_out, int out_size, void* d_ws, size_t ws_size, hipStream_t stream) {
    static int grid = 0;
    if (grid == 0) {
        if (n_in != 18 || out_size != M * D || ws_size < WS_END) { fprintf(stderr, "kernel_launch: unexpected shapes (n_in %d out %d ws %zu)\n", n_in, out_size, ws_size); grid = -1; return; }
        int dev = 0, cus = 0, per_cu = 0;
        hipGetDevice(&dev); hipDeviceGetAttribute(&cus, hipDeviceAttributeMultiprocessorCount, dev);
        hipFuncSetAttribute((const void*)fwd_kernel, hipFuncAttributeMaxDynamicSharedMemorySize, LDS_BYTES);
        if (hipOccupancyMaxActiveBlocksPerMultiprocessor(&per_cu, (const void*)fwd_kernel, 512, LDS_BYTES) != hipSuccess || per_cu < 1) per_cu = 1;
        (void)hipGetLastError();
        grid = cus * per_cu;
    }
    if (grid < 0) return;
    Params p{};
    const float** pp = (const float**)&p;
    for (int i = 0; i < 18; ++i) pp[i] = (const float*)d_in[i];
    p.out = (float*)d_out; p.ws = (unsigned char*)d_ws;
    if (hipMemsetAsync((char*)d_ws + WS_BAR, 0, 16384, stream) != hipSuccess) { fprintf(stderr, "kernel_launch: memset of the barrier words failed\n"); return; }
#if ONE_LAUNCH
    p.ph_lo = 0; p.ph_hi = NPH;
    void* args[] = {&p};
    hipError_t e = hipLaunchCooperativeKernel((const void*)fwd_kernel, dim3(grid), dim3(512), args, LDS_BYTES, stream);
    if (e != hipSuccess) fprintf(stderr, "cooperative launch failed: %s (grid %d)\n", hipGetErrorString(e), grid);
#else
    for (int ph = 0; ph < NPH; ++ph) { p.ph_lo = ph; p.ph_hi = ph + 1; hipLaunchKernelGGL(fwd_kernel, dim3(grid), dim3(512), LDS_BYTES, stream, p); }
#endif
}
```

```cpp
#include <hip/hip_runtime.h>
#include <hip/hip_cooperative_groups.h>
#include <cstdio>
#include <cstdint>
namespace cg = cooperative_groups;

__device__ __forceinline__ int ltid() { int t = threadIdx.x; asm volatile("" : "+v"(t)); return t; }
namespace pg8 {
#define PG8_LAS __attribute__((address_space(3)))
typedef unsigned short bf16_t;
typedef short bf16x8 __attribute__((ext_vector_type(8)));
typedef float f32x4 __attribute__((ext_vector_type(4)));
typedef unsigned u32x4 __attribute__((ext_vector_type(4)));
constexpr int BM = 256, BK = 64, HALF = 128, HTB = HALF * BK * 2  , STAGE_BYTES = 8 * HTB, NXCD = 8, WGM = 8;

__host__ __device__ __forceinline__ int lds_byte(int r, int c) { const int st = (r >> 4) * 2 + (c >> 5), rr = r & 15, cc = c & 31, ob = rr * 64 + cc * 2; return st * 1024 + (ob ^ (((ob >> 9) & 1) << 5)); }
__host__ __device__ __forceinline__ void stage_rc(int b, int& R, int& C) { const int st = b / 1024, sb = b % 1024, swz = sb ^ (((sb >> 9) & 1) << 5); R = (st >> 1) * 16 + swz / 64; C = (st & 1) * 32 + (swz % 64) / 2; }
__host__ __device__ __forceinline__ int perm32(int rho) { const int n = rho >> 4, i = rho & 15; return 8 * (i >> 2) + 4 * n + (i & 3); }

struct Unit { int pm, pn; };
struct Gemm { const bf16_t* A; const bf16_t* Bt; int M, N, K, lda; };

struct StaticOrder {
    int nM, nN, nwg, G, c;
    __host__ __device__ void init(int M, int N, int G_, int c_) { nM = M / BM; nN = N / BM; nwg = nM * nN; G = G_; c = c_; }
    __host__ __device__ bool next(int i, Unit& u) const {
        const long L = (long)i * G + c; if (L >= nwg) return false;
        int wgid = (int)L; { const int q = nwg / NXCD, r = nwg % NXCD, xcd = wgid % NXCD, off = wgid / NXCD; wgid = (xcd < r ? xcd * (q + 1) : r * (q + 1) + (xcd - r) * q) + off; }
        const int nig = WGM * nN, gid = wgid / nig, fm = gid * WGM, gsz = (nM - fm) < WGM ? (nM - fm) : WGM;
        u.pm = fm + ((wgid % nig) % gsz); u.pn = (wgid % nig) / gsz; return true;
    }
    __device__ __forceinline__ void a_ready(const Unit&) const {}
    __device__ __forceinline__ void done(const Unit&) const {}
};

typedef float f32x2 __attribute__((ext_vector_type(2)));
__device__ __forceinline__ f32x2 gelu_pk(f32x2 v) {
    const f32x2 av = __builtin_elementwise_abs(v), d = av * 0.2316418882f + 1.0f;
    f32x2 t; t.x = __builtin_amdgcn_rcpf(d.x); t.y = __builtin_amdgcn_rcpf(d.y);
    f32x2 q = t * 0.5307027145f + (-0.7265760135f); q = q * t + 0.7107068705f; q = q * t + (-0.142248368f); q = q * t + 0.127414796f; q = q * t;
    const f32x2 s = (v * v) * (-0.72134752044f);
    f32x2 e; e.x = __builtin_amdgcn_exp2f(s.x); e.y = __builtin_amdgcn_exp2f(s.y);
    const f32x2 m = v * (q * e), r = v - m;
    f32x2 o; o.x = v.x < 0.f ? m.x : r.x; o.y = v.y < 0.f ? m.y : r.y; return o;
}

template <class Epi, class Sched, bool ALIGN_EPI = false, bool SP2 = false>
__device__ __forceinline__ void gemm_phase(PG8_LAS unsigned char* lds, const Gemm g, const Sched& S, const Epi& E) {
    const int tid = ltid(), wid = __builtin_amdgcn_readfirstlane(tid >> 6), lane = tid & 63, wr = wid >> 2, wc = wid & 3, fr = lane & 15, fq = lane >> 4;
    const int K = g.K, nt = K / BK;
    unsigned voffA[2], voffB[2];
#pragma unroll
    for (int i = 0; i < 2; ++i) { int R, C; stage_rc(tid * 16 + i * 8192, R, C); const int Rb = Epi::PERM ? ((R & ~31) + perm32(R & 31)) : R;
        voffA[i] = (unsigned)(R * g.lda + C) * 2u; voffB[i] = (unsigned)(Rb * K + C) * 2u; }
    const size_t kstep = (size_t)(BK * 2);
    const size_t hstepB = (size_t)HALF * K * 2, hstepA = (size_t)HALF * g.lda * 2;
    const size_t tstepA = 2 * hstepA, tstepB = 2 * hstepB;
    const unsigned ldsw = (unsigned)wid * 1024u;
    const int aoff = lds_byte(wr * 64 + fr, fq * 8), boff = lds_byte(wc * 32 + fr, fq * 8);
#define PG8_SA(b, h) (((b) * 2 + (h)) * HTB)
#define PG8_SB(b, h) ((4 + (b) * 2 + (h)) * HTB)
#define PG8_STAGE(bufoff, gbase, voff) do { _Pragma("unroll") for (int _i = 0; _i < 2; ++_i) \
        __builtin_amdgcn_global_load_lds((const unsigned*)((const char*)(gbase) + (voff)[_i]), (PG8_LAS unsigned*)(lds + (bufoff) + ldsw + _i * 8192), 16, 0, 0); } while (0)
#define PG8_LDA(dst, b, h) do { _Pragma("unroll") for (int m = 0; m < 4; ++m) _Pragma("unroll") for (int k = 0; k < 2; ++k) dst[m][k] = *(const PG8_LAS bf16x8*)(lds + PG8_SA(b, h) + aoff + m * 2048 + k * 1024); } while (0)
#define PG8_LDB(dst, b, h) do { _Pragma("unroll") for (int n = 0; n < 2; ++n) _Pragma("unroll") for (int k = 0; k < 2; ++k) dst[n][k] = *(const PG8_LAS bf16x8*)(lds + PG8_SB(b, h) + boff + n * 2048 + k * 1024); } while (0)
#define PG8_MMA(ai, bj, At, Bt) do { __builtin_amdgcn_s_setprio(1); _Pragma("unroll") for (int m = 0; m < 4; ++m) _Pragma("unroll") for (int n = 0; n < 2; ++n) _Pragma("unroll") for (int k = 0; k < 2; ++k) \
        acc[ai][bj][m][n] = __builtin_amdgcn_mfma_f32_16x16x32_bf16(Bt[n][k], At[m][k], acc[ai][bj][m][n], 0, 0, 0); __builtin_amdgcn_s_setprio(0); } while (0)
#define PG8_WAIT_V(n) asm volatile("s_waitcnt vmcnt(" #n ")" ::: "memory")
#define PG8_WAIT_L(n) asm volatile("s_waitcnt lgkmcnt(" #n ")" ::: "memory")
#define PG8_BAR __builtin_amdgcn_s_barrier()
#define PG8_SCHED __builtin_amdgcn_sched_barrier(0)
    Unit cur, nxt; int ui = 0;
    if (!S.next(0, cur)) return;
    f32x4 acc[2][2][4][2];
#pragma unroll
    for (int a = 0; a < 2; ++a)
#pragma unroll
        for (int b = 0; b < 2; ++b)
#pragma unroll
            for (int m = 0; m < 4; ++m)
#pragma unroll
                for (int n = 0; n < 2; ++n) acc[a][b][m][n] = (f32x4){0.f, 0.f, 0.f, 0.f};
    bf16x8 At[4][2], B0[2][2], B1[2][2];
    const char* cA = (const char*)g.A + (size_t)cur.pm * tstepA; const char* cB = (const char*)g.Bt + (size_t)cur.pn * tstepB;
    S.a_ready(cur);
    if constexpr (SP2) {
        PG8_STAGE(PG8_SB(0, 0), cB, voffB); PG8_STAGE(PG8_SB(0, 1), cB + hstepB, voffB); PG8_STAGE(PG8_SA(0, 0), cA, voffA); PG8_STAGE(PG8_SA(0, 1), cA + hstepA, voffA);
        if (wr == 1) PG8_BAR;
        PG8_WAIT_V(2); PG8_BAR;
        PG8_STAGE(PG8_SB(1, 0), cB + kstep, voffB); PG8_STAGE(PG8_SA(1, 0), cA + kstep, voffA); PG8_STAGE(PG8_SB(1, 1), cB + hstepB + kstep, voffB);
        PG8_WAIT_V(6); PG8_BAR;
    } else {
        PG8_STAGE(PG8_SB(0, 0), cB, voffB); PG8_STAGE(PG8_SA(0, 0), cA, voffA); PG8_STAGE(PG8_SB(0, 1), cB + hstepB, voffB); PG8_STAGE(PG8_SA(0, 1), cA + hstepA, voffA);
        if (wr == 1) PG8_BAR;
        PG8_WAIT_V(4); PG8_BAR;
        PG8_STAGE(PG8_SB(1, 0), cB + kstep, voffB); PG8_STAGE(PG8_SA(1, 0), cA + kstep, voffA); PG8_STAGE(PG8_SB(1, 1), cB + hstepB + kstep, voffB);
        PG8_WAIT_V(6); PG8_BAR;
    }
    for (;;) {
        const bool has_next = S.next(ui + 1, nxt);
        const char* nA = has_next ? (const char*)g.A + (size_t)nxt.pm * tstepA : cA; const char* nB = has_next ? (const char*)g.Bt + (size_t)nxt.pn * tstepB : cB;
        for (int t = 0; t < nt; t += 2) {
            const bool last = (t == nt - 2);
            const char* a1 = cA + (size_t)(t + 1) * kstep;
            const char* a2 = last ? nA : cA + (size_t)(t + 2) * kstep; const char* b2 = last ? nB : cB + (size_t)(t + 2) * kstep;
            const char* a3 = a2 + kstep; const char* b3 = b2 + kstep;
            if (last && has_next) S.a_ready(nxt);
            if constexpr (SP2) {
            PG8_LDB(B0, 0, 0); PG8_LDB(B1, 0, 1); PG8_SCHED; PG8_LDA(At, 0, 0); PG8_STAGE(PG8_SA(1, 1), a1 + hstepA, voffA);
            PG8_WAIT_V(8); PG8_WAIT_L(0); PG8_BAR; PG8_MMA(0, 0, At, B0); PG8_MMA(0, 1, At, B1); PG8_BAR; PG8_SCHED;
            PG8_LDA(At, 0, 1); PG8_STAGE(PG8_SB(0, 0), b2, voffB); PG8_STAGE(PG8_SB(0, 1), b2 + hstepB, voffB); PG8_STAGE(PG8_SA(0, 0), a2, voffA);
            PG8_WAIT_V(8); PG8_WAIT_L(0); PG8_BAR; PG8_MMA(1, 0, At, B0); PG8_MMA(1, 1, At, B1); PG8_BAR; PG8_SCHED;
            PG8_LDB(B0, 1, 0); PG8_LDB(B1, 1, 1); PG8_SCHED; PG8_LDA(At, 1, 0); PG8_STAGE(PG8_SA(0, 1), a2 + hstepA, voffA);
            PG8_WAIT_V(8); PG8_WAIT_L(0); PG8_BAR; PG8_MMA(0, 0, At, B0); PG8_MMA(0, 1, At, B1); PG8_BAR; PG8_SCHED;
            PG8_LDA(At, 1, 1); PG8_STAGE(PG8_SB(1, 0), b3, voffB); PG8_STAGE(PG8_SB(1, 1), b3 + hstepB, voffB); PG8_STAGE(PG8_SA(1, 0), a3, voffA);
            PG8_WAIT_V(8); PG8_WAIT_L(0); PG8_BAR; PG8_MMA(1, 0, At, B0); PG8_MMA(1, 1, At, B1); PG8_BAR; PG8_SCHED;
            } else {
            PG8_LDB(B0, 0, 0); PG8_SCHED; PG8_LDA(At, 0, 0); PG8_STAGE(PG8_SA(1, 1), a1 + hstepA, voffA);
            PG8_WAIT_L(8); PG8_BAR; PG8_WAIT_L(0); PG8_MMA(0, 0, At, B0); PG8_BAR; PG8_SCHED;
            PG8_LDB(B1, 0, 1); PG8_STAGE(PG8_SB(0, 0), b2, voffB);
            PG8_BAR; PG8_WAIT_L(0); PG8_MMA(0, 1, At, B1); PG8_BAR;
            PG8_LDA(At, 0, 1); PG8_STAGE(PG8_SA(0, 0), a2, voffA);
            PG8_BAR; PG8_WAIT_L(0); PG8_MMA(1, 0, At, B0); PG8_BAR; PG8_SCHED;
            PG8_STAGE(PG8_SB(0, 1), b2 + hstepB, voffB);
            PG8_WAIT_V(6); PG8_BAR; PG8_MMA(1, 1, At, B1); PG8_BAR;
            PG8_LDB(B0, 1, 0); PG8_SCHED; PG8_LDA(At, 1, 0); PG8_STAGE(PG8_SA(0, 1), a2 + hstepA, voffA);
            PG8_WAIT_L(8); PG8_BAR; PG8_WAIT_L(0); PG8_MMA(0, 0, At, B0); PG8_BAR; PG8_SCHED;
            PG8_LDB(B1, 1, 1); PG8_STAGE(PG8_SB(1, 0), b3, voffB);
            PG8_BAR; PG8_WAIT_L(0); PG8_MMA(0, 1, At, B1); PG8_BAR;
            PG8_LDA(At, 1, 1); PG8_STAGE(PG8_SA(1, 0), a3, voffA);
            PG8_BAR; PG8_WAIT_L(0); PG8_MMA(1, 0, At, B0); PG8_BAR; PG8_SCHED;
            PG8_STAGE(PG8_SB(1, 1), b3 + hstepB, voffB);
            PG8_WAIT_V(6); PG8_BAR; PG8_MMA(1, 1, At, B1); PG8_BAR;
            }
        }
        if constexpr (ALIGN_EPI) { if (wr == 0) PG8_BAR; }
        if constexpr (!Epi::AFTER_DRAIN) { E(acc, cur, wr, wc, fr, fq); S.done(cur); }
        if (!has_next) break;
#pragma unroll
        for (int a = 0; a < 2; ++a)
#pragma unroll
            for (int b = 0; b < 2; ++b)
#pragma unroll
                for (int m = 0; m < 4; ++m)
#pragma unroll
                    for (int n = 0; n < 2; ++n) acc[a][b][m][n] = (f32x4){0.f, 0.f, 0.f, 0.f};
        cur = nxt; cA = nA; cB = nB; ++ui;
        if constexpr (ALIGN_EPI) { if (wr == 1) PG8_BAR; }
    }
    PG8_WAIT_V(0);
    if constexpr (!ALIGN_EPI) { if (wr == 0) PG8_BAR; }
    PG8_BAR;
    if constexpr (Epi::AFTER_DRAIN) { E.fused(acc, cur, wr, wc, fr, fq, lds, wid, lane); S.done(cur); }
#undef PG8_SA
#undef PG8_SB
#undef PG8_STAGE
#undef PG8_LDA
#undef PG8_LDB
#undef PG8_MMA
#undef PG8_WAIT_V
#undef PG8_WAIT_L
#undef PG8_BAR
#undef PG8_SCHED
}
}

#ifndef ONE_LAUNCH
#define ONE_LAUNCH 1
#endif
#define LAS __attribute__((address_space(3)))
typedef unsigned short bf16;
typedef unsigned u32x4 __attribute__((ext_vector_type(4)));
typedef unsigned u32x2 __attribute__((ext_vector_type(2)));
typedef float f32x4 __attribute__((ext_vector_type(4)));
typedef float f32x2 __attribute__((ext_vector_type(2)));
typedef short bf16x8 __attribute__((ext_vector_type(8)));
typedef __bf16 bf16x2_t __attribute__((ext_vector_type(2)));
typedef LAS unsigned char* ldsp;

constexpr int M = 49152, M0 = 32768, D = 1024, DIN = 4096;
constexpr float EPS = 1e-6f;
constexpr int PC_YA = 0, PC_YB = 256, PC_YC = 512;
constexpr int NSEG = 192, SEGC = 4;
constexpr size_t MiB = 1u << 20;
constexpr size_t WS_PART = 0, WS_LOGD = 3 * MiB, WS_BT1 = 4 * MiB, WS_BT2 = 20 * MiB, WS_PWT = 24 * MiB, WS_SGW = 24 * MiB + 256 * 1024;
constexpr size_t OUT_ST = 96 * MiB;
constexpr size_t WS_XB = 26 * MiB, WS_Y = 122 * MiB, WS_GLU = 218 * MiB, WS_BU = 242 * MiB, WS_BV = 266 * MiB, WS_HQ = 290 * MiB, WS_END = 482 * MiB;
constexpr unsigned HARR = 48u << 20, HHEAD = (unsigned)M * 256u;
constexpr int LDS_BYTES = 147456, LDS_BARST = 145408;
constexpr size_t WS_BAR = 3 * MiB + 896 * 1024;
constexpr int NPH = 12;

struct Params {
    const float *xp, *xs, *norm_g, *w_in, *conv_w, *conv_b, *conv_ln_g, *conv_ln_b, *conv_pw, *sgu_ln_g, *sgu_ln_b, *sgu_w, *sgu_b, *lb_f, *lb_b, *hgrn_g, *w_out, *final_g;
    float* out; unsigned char* ws; int ph_lo, ph_hi;
};

__device__ __forceinline__ float bf2f(bf16 b) { return __uint_as_float((unsigned)b << 16); }
__device__ __forceinline__ float bflo(unsigned w) { return __uint_as_float(w << 16); }
__device__ __forceinline__ float bfhi(unsigned w) { return __uint_as_float(w & 0xffff0000u); }
__device__ __forceinline__ unsigned pk2(float lo, float hi) { f32x2 v = {lo, hi}; bf16x2_t b = __builtin_convertvector(v, bf16x2_t); return __builtin_bit_cast(unsigned, b); }
__device__ __forceinline__ bf16 f2bf(float x) { return (bf16)(pk2(x, 0.f) & 0xffffu); }
__device__ __forceinline__ float sigmoidf_(float x) { return __builtin_amdgcn_rcpf(1.f + __expf(-x)); }
__device__ __forceinline__ float siluf_(float x) { return x * sigmoidf_(x); }
__device__ __forceinline__ float wave_sum(float v) {
#pragma unroll
    for (int o = 1; o < 64; o <<= 1) v += __shfl_xor(v, o);
    return v;
}
__device__ __forceinline__ bf16x8 mk8(unsigned a, unsigned b, unsigned c, unsigned d) { u32x4 v = {a, b, c, d}; return __builtin_bit_cast(bf16x8, v); }
#define LBAR() asm volatile("s_waitcnt lgkmcnt(0)\n\ts_barrier" ::: "memory")
#define MFMA16(a, b, c) __builtin_amdgcn_mfma_f32_16x16x32_bf16((a), (b), (c), 0, 0, 0)

struct Epi1 {
    static constexpr bool PERM = true, AFTER_DRAIN = false;
    unsigned char* ws; const float* part;
    __device__ __forceinline__ void operator()(const pg8::f32x4 (&acc)[2][2][4][2], const pg8::Unit& u, int wr, int wc, int fr, int fq) const {
        const int row0 = u.pm * 256 + wr * 64 + fr; const int pn = u.pn;
        const int cw = wc * 32 + 8 * fq;
#pragma unroll
        for (int ai = 0; ai < 2; ++ai)
#pragma unroll
            for (int m = 0; m < 4; ++m) {
                const int r = row0 + ai * 128 + m * 16;
                float s = 0.f;
#pragma unroll
                for (int q = 0; q < 4; ++q) s += part[(size_t)(4 * fq + q) * M + r];
                s += __shfl_xor(s, 16); s += __shfl_xor(s, 32);
                const float rs = __builtin_amdgcn_rsqf(s * (1.f / D) + EPS);
                if (pn < 2) {
                    f32x4 a0 = acc[ai][0][m][0] * rs, a1 = acc[ai][0][m][1] * rs, g0 = acc[ai][1][m][0] * rs, g1 = acc[ai][1][m][1] * rs;
                    u32x4 w;
                    w.x = pk2(a0[0] * sigmoidf_(g0[0]), a0[1] * sigmoidf_(g0[1])); w.y = pk2(a0[2] * sigmoidf_(g0[2]), a0[3] * sigmoidf_(g0[3]));
                    w.z = pk2(a1[0] * sigmoidf_(g1[0]), a1[1] * sigmoidf_(g1[1])); w.w = pk2(a1[2] * sigmoidf_(g1[2]), a1[3] * sigmoidf_(g1[3]));
                    *(u32x4*)((bf16*)(ws + WS_GLU) + (size_t)r * 256 + 128 * pn + cw) = w;
                } else {
#pragma unroll
                    for (int bj = 0; bj < 2; ++bj) {
                        f32x4 v0 = acc[ai][bj][m][0] * rs, v1 = acc[ai][bj][m][1] * rs;
                        if (pn < 6) {
#pragma unroll
                            for (int e = 0; e < 4; ++e) { v0[e] = siluf_(v0[e]); v1[e] = siluf_(v1[e]); }
                        } else if (pn < 8) {
                            f32x2 a = pg8::gelu_pk((f32x2){v0[0], v0[1]}), b = pg8::gelu_pk((f32x2){v0[2], v0[3]}), c = pg8::gelu_pk((f32x2){v1[0], v1[1]}), d = pg8::gelu_pk((f32x2){v1[2], v1[3]});
                            v0 = (f32x4){a.x, a.y, b.x, b.y}; v1 = (f32x4){c.x, c.y, d.x, d.y};
                        }
                        u32x4 w; w.x = pk2(v0[0], v0[1]); w.y = pk2(v0[2], v0[3]); w.z = pk2(v1[0], v1[1]); w.w = pk2(v1[2], v1[3]);
                        bf16* dst;
                        if (pn < 6) dst = (bf16*)(ws + WS_Y) + (size_t)r * 1024 + 256 * (pn - 2) + 128 * bj + cw;
                        else if (pn < 8) dst = (bf16*)(ws + (pn == 6 ? WS_BU : WS_BV)) + (size_t)r * 256 + 128 * bj + cw;
                        else dst = (bf16*)(ws + WS_HQ + (size_t)((pn - 8) >> 1) * HARR + (size_t)(2 * ((pn - 8) & 1) + bj) * HHEAD) + (size_t)r * 128 + cw;
                        *(u32x4*)dst = w;
                    }
                }
            }
    }
};
struct Epi2 {
    static constexpr bool PERM = true, AFTER_DRAIN = false;
    const float* xin0; const float* xin1; int split; const bf16* xinb; float* xout; bf16* XB; float* part;
    __device__ __forceinline__ void operator()(const pg8::f32x4 (&acc)[2][2][4][2], const pg8::Unit& u, int wr, int wc, int fr, int fq) const {
        const int row0 = u.pm * 256 + wr * 64 + fr; const int pn = u.pn;
        const int cw = pn * 256 + wc * 32 + 8 * fq;
#pragma unroll
        for (int ai = 0; ai < 2; ++ai)
#pragma unroll
            for (int m = 0; m < 4; ++m) {
                const int r = row0 + ai * 128 + m * 16;
                const float* src = (r < split) ? xin0 + (size_t)r * D : xin1 + (size_t)(r - split) * D;
                float ss = 0.f;
#pragma unroll
                for (int bj = 0; bj < 2; ++bj) {
                    const int col = cw + 128 * bj;
                    f32x4 v0, v1;
                    if (xinb) { const u32x4 t = *(const u32x4*)(xinb + (size_t)r * D + col); v0 = (f32x4){bflo(t.x), bfhi(t.x), bflo(t.y), bfhi(t.y)}; v1 = (f32x4){bflo(t.z), bfhi(t.z), bflo(t.w), bfhi(t.w)}; }
                    else { v0 = *(const f32x4*)(src + col); v1 = *(const f32x4*)(src + col + 4); }
                    v0 = v0 + acc[ai][bj][m][0]; v1 = v1 + acc[ai][bj][m][1];
                    if (xout) { *(f32x4*)(xout + (size_t)r * D + col) = v0; *(f32x4*)(xout + (size_t)r * D + col + 4) = v1; }
                    ss += (v0[0] * v0[0] + v0[1] * v0[1]) + (v0[2] * v0[2] + v0[3] * v0[3]) + (v1[0] * v1[0] + v1[1] * v1[1]) + (v1[2] * v1[2] + v1[3] * v1[3]);
                    { u32x4 w; w.x = pk2(v0[0], v0[1]); w.y = pk2(v0[2], v0[3]); w.z = pk2(v1[0], v1[1]); w.w = pk2(v1[2], v1[3]); *(u32x4*)(XB + (size_t)r * D + col) = w; }
                }
                ss += __shfl_xor(ss, 16); ss += __shfl_xor(ss, 32);
                if (fq == 0) part[(size_t)(pn * 4 + wc) * M + r] = ss;
            }
    }
};

__device__ __forceinline__ int srcmap128(int b) {
    if (b < 4) return ((b & 1) ? 256 : 0) + 128 * (b >> 1);
    if (b < 6) return 512 + 128 * (b - 4);
    if (b < 8) return 1280 + 128 * (b - 6);
    if (b < 12) return 3584 + 128 * (b - 8);
    if (b < 14) return 768 + 128 * (b - 12);
    if (b < 16) return 1024 + 128 * (b - 14);
    if (b < 20) return 1536 + 128 * (b - 16);
    if (b < 24) return 2048 + 128 * (b - 20);
    if (b < 28) return 2560 + 128 * (b - 24);
    return 3072 + 128 * (b - 28);
}
__device__ __forceinline__ void tr_item(const float* W, int N, int sc0, const float* gk, int k0, bf16* WT, int K, int drow0, LAS float* scr, int lane) {
    float v[64];
#pragma unroll
    for (int kk = 0; kk < 64; ++kk) v[kk] = W[(size_t)(k0 + kk) * N + sc0 + lane];
    if (gk) {
#pragma unroll
        for (int kk = 0; kk < 64; ++kk) v[kk] *= gk[k0 + kk]; }
#pragma unroll
    for (int kk = 0; kk < 64; ++kk) scr[kk * 65 + lane] = v[kk];
    asm volatile("s_waitcnt lgkmcnt(0)" ::: "memory");
    const int c = lane & 7;
#pragma unroll
    for (int j = 0; j < 8; ++j) { const int n = (lane >> 3) + 8 * j; const LAS float* s = scr + (8 * c) * 65 + n;
        u32x4 o; o.x = pk2(s[0 * 65], s[1 * 65]); o.y = pk2(s[2 * 65], s[3 * 65]); o.z = pk2(s[4 * 65], s[5 * 65]); o.w = pk2(s[6 * 65], s[7 * 65]);
        *(u32x4*)(WT + (size_t)(drow0 + n) * K + k0 + 8 * c) = o; }
    asm volatile("s_waitcnt lgkmcnt(0)" ::: "memory");
}
__device__ __forceinline__ void prologue(ldsp lds, const Params& p) {
    const int tid = ltid(), lane = tid & 63, wave = __builtin_amdgcn_readfirstlane(tid >> 6);
    const int gw = blockIdx.x * 8 + wave, NGW = gridDim.x * 8;
    LAS float* scr = (LAS float*)(lds + wave * 16640);
    unsigned char* ws = p.ws;
    constexpr int I_IN = 16 * 64, I_OUT = 16 * 16, I_PW = 4 * 4, I_L = I_IN + I_OUT + I_PW;
    for (int it = gw; it < 2 * I_L; it += NGW) {
        const int l = it / I_L; int r = it - l * I_L;
        if (r < I_IN) { const int kb = r >> 6, nb = r & 63; tr_item(p.w_in + (size_t)l * D * DIN, DIN, srcmap128(nb >> 1) + 64 * (nb & 1), p.norm_g + l * D, 64 * kb, (bf16*)(ws + WS_BT1) + (size_t)l * DIN * D, D, 64 * nb, scr, lane); continue; }
        r -= I_IN;
        if (r < I_OUT) { const int kb = r >> 4, nb = r & 15; tr_item(p.w_out + (size_t)l * D * D, D, 64 * nb, nullptr, 64 * kb, (bf16*)(ws + WS_BT2) + (size_t)l * D * D, D, 64 * nb, scr, lane); continue; }
        r -= I_OUT;
        { const int kb = r >> 2, nb = r & 3; tr_item(p.conv_pw + (size_t)l * 65536, 256, 64 * nb, nullptr, 64 * kb, (bf16*)(ws + WS_PWT) + (size_t)l * 65536, 256, 64 * nb, scr, lane); }
    }
    { const int gt = blockIdx.x * 512 + tid, NT = gridDim.x * 512; bf16* o = (bf16*)(ws + WS_SGW);
      for (int i = gt; i < 2 * 4 * 128 * 128 / 4; i += NT) { const f32x4 v = *(const f32x4*)(p.sgu_w + 4 * (size_t)i); u32x2 w; w.x = pk2(v[0], v[1]); w.y = pk2(v[2], v[3]); *(u32x2*)(o + 4 * (size_t)i) = w; } }
    bf16* XB = (bf16*)(ws + WS_XB); float* part = (float*)(ws + WS_PART);
    for (int r = gw; r < M; r += 4 * NGW) {
        f32x4 v[4][4];
#pragma unroll
        for (int u = 0; u < 4; ++u) { const int rr = r + u * NGW; if (rr < M) { const float* src = (rr < M0) ? p.xp + (size_t)rr * D : p.xs + (size_t)(rr - M0) * D;
#pragma unroll
            for (int j = 0; j < 4; ++j) v[u][j] = __builtin_nontemporal_load((const f32x4*)src + lane + 64 * j); } }
#pragma unroll
        for (int u = 0; u < 4; ++u) { const int rr = r + u * NGW; if (rr < M) { float s = 0.f;
            unsigned long long* o8 = (unsigned long long*)(XB + (size_t)rr * D) + lane;
#pragma unroll
            for (int j = 0; j < 4; ++j) { const f32x4 t = v[u][j]; s += (t[0] * t[0] + t[1] * t[1]) + (t[2] * t[2] + t[3] * t[3]); o8[64 * j] = (unsigned long long)pk2(t[0], t[1]) | ((unsigned long long)pk2(t[2], t[3]) << 32); }
            s = wave_sum(s);
            if (lane < 16) part[(size_t)lane * M + rr] = lane == 0 ? s : 0.f; } }
    }
}

__device__ __forceinline__ void final_norm(const Params& p) {
    const int tid = ltid(), lane = tid & 63, wave = tid >> 6;
    const int gw = blockIdx.x * 8 + wave, NGW = gridDim.x * 8;
    const float* part = (const float*)(p.ws + WS_PART);
    f32x4 g[4];
#pragma unroll
    for (int j = 0; j < 4; ++j) g[j] = *((const f32x4*)p.final_g + lane + 64 * j);
    const bf16* XB = (const bf16*)(p.ws + WS_XB);
    for (int r = gw; r < M; r += 4 * NGW) {
        u32x2 v[4][4]; float s[4];
#pragma unroll
        for (int u = 0; u < 4; ++u) { const int rr = r + u * NGW; if (rr < M) { s[u] = lane < 16 ? part[(size_t)lane * M + rr] : 0.f;
#pragma unroll
            for (int j = 0; j < 4; ++j) v[u][j] = ((const u32x2*)(XB + (size_t)rr * D))[lane + 64 * j]; } }
#pragma unroll
        for (int u = 0; u < 4; ++u) { const int rr = r + u * NGW; if (rr < M) { const float rs = __builtin_amdgcn_rsqf(wave_sum(s[u]) * (1.f / D) + EPS);
#pragma unroll
            for (int j = 0; j < 4; ++j) { const f32x4 x = {bflo(v[u][j].x), bfhi(v[u][j].x), bflo(v[u][j].y), bfhi(v[u][j].y)}; __builtin_nontemporal_store(x * rs * g[j], (f32x4*)(p.out + (size_t)rr * D) + lane + 64 * j); } } }
    }
}

constexpr int L_LNP = 122880;
#define CONV_LOAD_IN(inr_, item_, tid_) do { const int r0_ = (item_) * 64; int s0_, s1_; if (r0_ < M0) { s0_ = r0_ & ~8191; s1_ = s0_ + 8192; } else { s0_ = M0 + ((r0_ - M0) & ~4095); s1_ = s0_ + 4096; } \
    _Pragma("unroll") for (int k_ = 0; k_ < 6; ++k_) { const int idx_ = (tid_) + 512 * k_, row_ = idx_ >> 5, c16_ = idx_ & 31, gr_ = r0_ - 15 + row_; \
        u32x4 v_ = {0u, 0u, 0u, 0u}; if (idx_ < 94 * 32 && gr_ >= s0_ && gr_ < s1_) v_ = *(const u32x4*)((const bf16*)(p.ws + WS_GLU) + (size_t)gr_ * 256 + c16_ * 8); (inr_)[k_] = v_; } } while (0)
__device__ __forceinline__ void conv_item(ldsp lds, int item, int layer, const Params& p, const f32x2 (&w2)[31], const f32x2 bb2, u32x4 (&inr)[6], int next_item) {
    const int tid = ltid(), lane = tid & 63, w = __builtin_amdgcn_readfirstlane(tid >> 6), r16 = lane & 15, quad = lane >> 4;
    const int r0 = item * 64;
    const bf16* pwT = (const bf16*)(p.ws + WS_PWT) + (size_t)layer * 65536;
    ldsp IN = lds;
    LAS float* CV = (LAS float*)(lds + 49152);
    ldsp AO = lds;
#pragma unroll
    for (int k = 0; k < 6; ++k) { const int idx = tid + 512 * k, row = idx >> 5, c16 = idx & 31; if (idx < 94 * 32) *(LAS u32x4*)(IN + row * 512 + c16 * 16) = inr[k]; }
    u32x2 gpre[4][2];
#pragma unroll
    for (int m = 0; m < 4; ++m)
#pragma unroll
        for (int nt = 0; nt < 2; ++nt) gpre[m][nt] = *(const u32x2*)((const bf16*)(p.ws + WS_Y) + (size_t)(r0 + 16 * m + r16) * 1024 + PC_YA + 32 * w + 16 * nt + 4 * quad);
    LBAR();
    {
        const int cp = tid & 127, qtr = tid >> 7;
#pragma unroll 1
        for (int ob = 0; ob < 2; ++ob) {
            const int t0 = 16 * qtr + 8 * ob;
            f32x2 x[38];
#pragma unroll
            for (int i = 0; i < 38; ++i) { const unsigned u = *(LAS unsigned*)(IN + (t0 + i) * 512 + cp * 4); x[i] = (f32x2){bflo(u), bfhi(u)}; }
            f32x2 a0[8];
#pragma unroll
            for (int o = 0; o < 8; ++o) a0[o] = bb2;
#pragma unroll
            for (int j = 0; j < 31; ++j)
#pragma unroll
                for (int o = 0; o < 8; ++o) a0[o] = x[o + j] * w2[j] + a0[o];
#pragma unroll
            for (int o = 0; o < 8; ++o) *(LAS f32x2*)(CV + (t0 + o) * 288 + 2 * cp) = a0[o];
        }
    }
    LBAR();
    bf16x8 pwf[8][2];
#pragma unroll
    for (int kk = 0; kk < 8; ++kk) { pwf[kk][0] = *(const bf16x8*)(pwT + (size_t)(32 * w + r16) * 256 + 32 * kk + 8 * quad); pwf[kk][1] = *(const bf16x8*)(pwT + (size_t)(32 * w + 16 + r16) * 256 + 32 * kk + 8 * quad); }
    {
        const int tok = tid >> 3, part = tid & 7;
        f32x4 v[8]; float s = 0.f;
#pragma unroll
        for (int i = 0; i < 8; ++i) { v[i] = *(LAS f32x4*)(CV + tok * 288 + 32 * i + 4 * part); s += (v[i][0] + v[i][1]) + (v[i][2] + v[i][3]); }
        s += __shfl_xor(s, 1); s += __shfl_xor(s, 2); s += __shfl_xor(s, 4);
        const float mean = s * (1.f / 256.f); float q = 0.f;
#pragma unroll
        for (int i = 0; i < 8; ++i) { v[i] = v[i] - mean; q += (v[i][0] * v[i][0] + v[i][1] * v[i][1]) + (v[i][2] * v[i][2] + v[i][3] * v[i][3]); }
        q += __shfl_xor(q, 1); q += __shfl_xor(q, 2); q += __shfl_xor(q, 4);
        const float rstd = __builtin_amdgcn_rsqf(q * (1.f / 256.f) + EPS);
#pragma unroll
        for (int i = 0; i < 8; ++i) { const int c = 32 * i + 4 * part; const f32x4 gg = *(LAS f32x4*)(lds + L_LNP + c * 4), bb = *(LAS f32x4*)(lds + L_LNP + 1024 + c * 4);
            f32x4 y = v[i] * rstd * gg + bb;
            u32x2 o; o.x = pk2(siluf_(y[0]), siluf_(y[1])); o.y = pk2(siluf_(y[2]), siluf_(y[3]));
            *(LAS u32x2*)(AO + tok * 528 + c * 2) = o; }
    }
    LBAR();
    { const int nit = next_item >= 0 ? next_item : item; CONV_LOAD_IN(inr, nit, tid); }
    {
        f32x4 acc[4][2];
#pragma unroll
        for (int m = 0; m < 4; ++m) { acc[m][0] = (f32x4){0.f, 0.f, 0.f, 0.f}; acc[m][1] = (f32x4){0.f, 0.f, 0.f, 0.f}; }
#pragma unroll
        for (int kk = 0; kk < 8; ++kk) {
            const bf16x8 b0 = pwf[kk][0], b1 = pwf[kk][1]; bf16x8 af[4];
#pragma unroll
            for (int m = 0; m < 4; ++m) af[m] = *(LAS bf16x8*)(AO + (16 * m + r16) * 528 + (32 * kk + 8 * quad) * 2);
#pragma unroll
            for (int m = 0; m < 4; ++m) { acc[m][0] = MFMA16(b0, af[m], acc[m][0]); acc[m][1] = MFMA16(b1, af[m], acc[m][1]); }
        }
#pragma unroll
        for (int m = 0; m < 4; ++m)
#pragma unroll
            for (int nt = 0; nt < 2; ++nt) { bf16* gp = (bf16*)(p.ws + WS_Y) + (size_t)(r0 + 16 * m + r16) * 1024 + PC_YA + 32 * w + 16 * nt + 4 * quad;
                const u32x2 g = gpre[m][nt]; u32x2 o; o.x = pk2(acc[m][nt][0] * bflo(g.x), acc[m][nt][1] * bfhi(g.x)); o.y = pk2(acc[m][nt][2] * bflo(g.y), acc[m][nt][3] * bfhi(g.y));
                *(u32x2*)gp = o; }
    }
    LBAR();
}

__device__ __forceinline__ void sgu_item(ldsp lds, int item, int layer, const Params& p, u32x4 (&bv)[8], int next_item) {
    const int tid = ltid(), lane = tid & 63, w = __builtin_amdgcn_readfirstlane(tid >> 6), r16 = lane & 15, quad = lane >> 4;
    const int r0 = (item >> 1) * 128, hp = item & 1;
    const bf16* SW = (const bf16*)(p.ws + WS_SGW) + (size_t)layer * 65536; const float* sb = p.sgu_b + layer * 512;
    ldsp VT = lds;
    u32x2 upre[2][4], gpre[2][4];
    { const int h = 2 * hp + (w >> 2), tq = w & 3;
#pragma unroll
      for (int tti = 0; tti < 2; ++tti)
#pragma unroll
          for (int dt = 0; dt < 4; ++dt) { const size_t row = (size_t)(r0 + 16 * (2 * tq + tti) + r16); const int ch = h * 64 + 16 * dt + 4 * quad;
              upre[tti][dt] = *(const u32x2*)((const bf16*)(p.ws + WS_BU) + row * 256 + ch); gpre[tti][dt] = *(const u32x2*)((const bf16*)(p.ws + WS_Y) + row * 1024 + PC_YB + ch); } }
    {
        const int tok = tid >> 2, part = tid & 3;
        float v[64]; float s = 0.f;
#pragma unroll
        for (int i = 0; i < 8; ++i) { const u32x4 t = bv[i];
            v[8 * i + 0] = bflo(t.x); v[8 * i + 1] = bfhi(t.x); v[8 * i + 2] = bflo(t.y); v[8 * i + 3] = bfhi(t.y); v[8 * i + 4] = bflo(t.z); v[8 * i + 5] = bfhi(t.z); v[8 * i + 6] = bflo(t.w); v[8 * i + 7] = bfhi(t.w); }
#pragma unroll
        for (int i = 0; i < 64; ++i) s += v[i];
        s += __shfl_xor(s, 1); s += __shfl_xor(s, 2);
        const float mean = s * (1.f / 256.f); float q = 0.f;
#pragma unroll
        for (int i = 0; i < 64; ++i) { v[i] -= mean; q += v[i] * v[i]; }
        q += __shfl_xor(q, 1); q += __shfl_xor(q, 2);
        const float rstd = __builtin_amdgcn_rsqf(q * (1.f / 256.f) + EPS);
        const bool odd = tok & 1;
        unsigned own[16];
#pragma unroll
        for (int i = 0; i < 8; ++i) {
            if ((i >> 2) != hp) continue;
            const int cbp = (32 * i + 8 * part) * 4;
            const f32x4 g0 = *(LAS f32x4*)(lds + L_LNP + 2048 + cbp), g1 = *(LAS f32x4*)(lds + L_LNP + 2048 + cbp + 16), b0 = *(LAS f32x4*)(lds + L_LNP + 3072 + cbp), b1 = *(LAS f32x4*)(lds + L_LNP + 3072 + cbp + 16);
            own[(i & 3) * 4 + 0] = pk2(v[8 * i + 0] * rstd * g0[0] + b0[0], v[8 * i + 1] * rstd * g0[1] + b0[1]);
            own[(i & 3) * 4 + 1] = pk2(v[8 * i + 2] * rstd * g0[2] + b0[2], v[8 * i + 3] * rstd * g0[3] + b0[3]);
            own[(i & 3) * 4 + 2] = pk2(v[8 * i + 4] * rstd * g1[0] + b1[0], v[8 * i + 5] * rstd * g1[1] + b1[1]);
            own[(i & 3) * 4 + 3] = pk2(v[8 * i + 6] * rstd * g1[2] + b1[2], v[8 * i + 7] * rstd * g1[3] + b1[3]);
        }
        unsigned oth[16];
#pragma unroll
        for (int k = 0; k < 16; ++k) oth[k] = (unsigned)__shfl_xor((int)own[k], 4);
#pragma unroll
        for (int k = 0; k < 16; ++k) {
            const int cb = 32 * (4 * hp + (k >> 2)) + 8 * part, e2 = 2 * (k & 3);
            const unsigned val = odd ? ((oth[k] >> 16) | (own[k] & 0xffff0000u)) : ((own[k] & 0xffffu) | (oth[k] << 16));
            const int ch = cb + e2 + (odd ? 1 : 0), t0 = tok & ~1;
            *(LAS unsigned*)(VT + ch * 272 + t0 * 2) = val;
        }
    }
    LBAR();
    bf16x8 wfp[2][4];
    { const int h = 2 * hp + (w >> 2), tq = w & 3;
#pragma unroll
      for (int tti = 0; tti < 2; ++tti)
#pragma unroll
          for (int kk = 0; kk < 4; ++kk) wfp[tti][kk] = *(const bf16x8*)(SW + (size_t)(h * 128 + 16 * (2 * tq + tti) + r16) * 128 + 32 * kk + 8 * quad); }
    { const int nit = next_item >= 0 ? next_item : item; const bf16* srcn = (const bf16*)(p.ws + WS_BV) + (size_t)((nit >> 1) * 128 + (tid >> 2)) * 256;
#pragma unroll
      for (int i = 0; i < 8; ++i) bv[i] = *(const u32x4*)(srcn + 32 * i + 8 * (tid & 3)); }
    {
        const int h = 2 * hp + (w >> 2), tq = w & 3;
        bf16x8 vf[4][4];
#pragma unroll
        for (int dt = 0; dt < 4; ++dt)
#pragma unroll
            for (int kk = 0; kk < 4; ++kk) vf[dt][kk] = *(LAS bf16x8*)(VT + (h * 64 + 16 * dt + r16) * 272 + (32 * kk + 8 * quad) * 2);
#pragma unroll
        for (int tti = 0; tti < 2; ++tti) {
            const int tt = 2 * tq + tti;
            bf16x8 wf[4];
#pragma unroll
            for (int kk = 0; kk < 4; ++kk) wf[kk] = wfp[tti][kk];
            f32x4 acc[4];
#pragma unroll
            for (int dt = 0; dt < 4; ++dt) { acc[dt] = (f32x4){0.f, 0.f, 0.f, 0.f};
#pragma unroll
                for (int kk = 0; kk < 4; ++kk) acc[dt] = MFMA16(vf[dt][kk], wf[kk], acc[dt]); }
            const float bias = sb[h * 128 + 16 * tt + r16];
            bf16* rowy = (bf16*)(p.ws + WS_Y) + (size_t)(r0 + 16 * tt + r16) * 1024; const bf16* rowu = (const bf16*)(p.ws + WS_BU) + (size_t)(r0 + 16 * tt + r16) * 256;
#pragma unroll
            for (int dt = 0; dt < 4; ++dt) { const int ch = h * 64 + 16 * dt + 4 * quad;
                const u32x2 uu = upre[tti][dt], g = gpre[tti][dt]; u32x2 o;
                o.x = pk2(bflo(uu.x) * (acc[dt][0] + bias) * bflo(g.x), bfhi(uu.x) * (acc[dt][1] + bias) * bfhi(g.x));
                o.y = pk2(bflo(uu.y) * (acc[dt][2] + bias) * bflo(g.y), bfhi(uu.y) * (acc[dt][3] + bias) * bfhi(g.y));
                *(u32x2*)(rowy + PC_YB + ch) = o; }
        }
    }
    LBAR();
}

constexpr int H_QD = 0, H_KD = 17408, H_KO = 34816, H_Q3 = 52224, H_K0 = 56576, H_KST = 60928, H_VT = 79360, H_SC = 97792, H_TT = 107008, H_ER = 109056, H_DEC = 111104, H_OS = 111616;

__device__ __forceinline__ void score_tile(ldsp lds, int qoff, int koff, int ti, int sj, bool diag, int r16, int quad) {
    f32x4 acc = {0.f, 0.f, 0.f, 0.f};
    bf16x8 ka[4], qa[4];
#pragma unroll
    for (int kk = 0; kk < 4; ++kk) { ka[kk] = *(LAS bf16x8*)(lds + koff + r16 * 272 + (32 * kk + 8 * quad) * 2); qa[kk] = *(LAS bf16x8*)(lds + qoff + r16 * 272 + (32 * kk + 8 * quad) * 2); }
#pragma unroll
    for (int kk = 0; kk < 4; ++kk) acc = MFMA16(ka[kk], qa[kk], acc);
    if (diag) {
#pragma unroll
        for (int e = 0; e < 4; ++e) if (4 * quad + e > r16) acc[e] = 0.f;
    }
    u32x2 o; o.x = pk2(acc[0], acc[1]); o.y = pk2(acc[2], acc[3]);
    *(LAS u32x2*)(lds + H_SC + (16 * ti + r16) * 144 + (16 * sj + 4 * quad) * 2) = o;
}

__device__ __forceinline__ void gate_fk(float z, float lbv, float oml, float& f, float& kk) {
    z = fmaxf(z, -30.f);
    const float e = __expf(-z), s = __builtin_amdgcn_rcpf(1.f + e);
    f = oml * s + lbv; kk = oml * e * s;
}
constexpr int H_T8 = 113664, H_QS = 117760;
#define HG_TOK(c0_, i_) (dir ? (c0_) + 63 - 8 * w - (i_) : (c0_) + 8 * w + (i_))
#define HG_LD(arr_, c0_, i_) (*(const unsigned*)(Pb + ((unsigned)HG_TOK(c0_, i_) * 256u + (arr_))))

constexpr int A_KST = 0, A_VT = 34816, A_T8 = 69632, A_DEC = 73728;
#define HGA_LD(arr_, c0_, i_) (*(const unsigned*)(Pb + ((unsigned)(dir ? (c0_) + 127 - 16 * w - (i_) : (c0_) + 16 * w + (i_)) * 256u + (arr_))))
template <int DIR> __device__ __forceinline__ void hgrn_passA_dir(ldsp lds, int item, int layer, const Params& p) {
    const int tid = ltid(), lane = tid & 63, w = __builtin_amdgcn_readfirstlane(tid >> 6), r16 = lane & 15, quad = lane >> 4;
    constexpr int dir = DIR; const int h = (item >> 1) & 3, sg = item >> 3; const int slot = item;
    const int kp = lane;
    float lb0 = 0.f, lb1 = 0.f;
    if (layer) { const float* lp = dir ? p.lb_b : p.lb_f; const f32x2 a = *(const f32x2*)(lp + 512 + h * 128 + 2 * kp), b = *(const f32x2*)(lp + h * 128 + 2 * kp); lb0 = sigmoidf_(a.x - b.x); lb1 = sigmoidf_(a.y - b.y); }
    const float om0 = 1.f - lb0, om1 = 1.f - lb1;
    f32x4 S[8];
#pragma unroll
    for (int m = 0; m < 8; ++m) S[m] = (f32x4){0.f, 0.f, 0.f, 0.f};
    float pd0 = 1.f, pd1 = 1.f;
    const unsigned char* Pb = p.ws + WS_HQ; const unsigned az = (dir ? 3u : 2u) * HARR + (unsigned)h * HHEAD + kp * 4u, av = HARR + (unsigned)h * HHEAD + kp * 4u;
    unsigned zr[16];
    { const int c0 = sg * 256 + (dir ? 128 : 0);
#pragma unroll
      for (int i = 0; i < 16; ++i) zr[i] = HGA_LD(az, c0, i); }
#pragma unroll 1
    for (int cc = 0; cc < 2; ++cc) {
        unsigned vr[16];
        { const int c0 = sg * 256 + ((dir != 0) == (cc == 0) ? 128 : 0);
#pragma unroll
          for (int i = 0; i < 16; ++i) vr[i] = HGA_LD(av, c0, i); }
        float ks0[16], ks1[16]; float E0 = 1.f, E1 = 1.f;
#pragma unroll
        for (int i = 15; i >= 0; --i) { float f0, f1, k0, k1; gate_fk(bflo(zr[i]), lb0, om0, f0, k0); gate_fk(bfhi(zr[i]), lb1, om1, f1, k1); ks0[i] = k0 * E0; ks1[i] = k1 * E1; E0 *= f0; E1 *= f1; }
        *(LAS f32x2*)(lds + A_T8 + (w * 128 + 2 * kp) * 4) = (f32x2){E0, E1};
#pragma unroll
        for (int hf = 0; hf < 2; ++hf) {
            *(LAS u32x4*)(lds + A_VT + (2 * kp) * 272 + 32 * w + 16 * hf) = (u32x4){__builtin_amdgcn_perm(vr[8 * hf + 1], vr[8 * hf + 0], 0x05040100u), __builtin_amdgcn_perm(vr[8 * hf + 3], vr[8 * hf + 2], 0x05040100u), __builtin_amdgcn_perm(vr[8 * hf + 5], vr[8 * hf + 4], 0x05040100u), __builtin_amdgcn_perm(vr[8 * hf + 7], vr[8 * hf + 6], 0x05040100u)};
            *(LAS u32x4*)(lds + A_VT + (2 * kp + 1) * 272 + 32 * w + 16 * hf) = (u32x4){__builtin_amdgcn_perm(vr[8 * hf + 1], vr[8 * hf + 0], 0x07060302u), __builtin_amdgcn_perm(vr[8 * hf + 3], vr[8 * hf + 2], 0x07060302u), __builtin_amdgcn_perm(vr[8 * hf + 5], vr[8 * hf + 4], 0x07060302u), __builtin_amdgcn_perm(vr[8 * hf + 7], vr[8 * hf + 6], 0x07060302u)}; }
        if (cc == 0) { const int c0 = sg * 256 + (dir ? 0 : 128);
#pragma unroll
            for (int i = 0; i < 16; ++i) zr[i] = HGA_LD(az, c0, i); }
        LBAR();
        float fa0 = 1.f, fa1 = 1.f, d0 = 1.f, d1 = 1.f;
#pragma unroll
        for (int g = 0; g < 8; ++g) { const f32x2 t = *(LAS f32x2*)(lds + A_T8 + (g * 128 + 2 * kp) * 4); d0 *= t.x; d1 *= t.y; if (g > w) { fa0 *= t.x; fa1 *= t.y; } }
#pragma unroll
        for (int hf = 0; hf < 2; ++hf) {
            *(LAS u32x4*)(lds + A_KST + (2 * kp) * 272 + 32 * w + 16 * hf) = (u32x4){pk2(ks0[8 * hf + 0] * fa0, ks0[8 * hf + 1] * fa0), pk2(ks0[8 * hf + 2] * fa0, ks0[8 * hf + 3] * fa0), pk2(ks0[8 * hf + 4] * fa0, ks0[8 * hf + 5] * fa0), pk2(ks0[8 * hf + 6] * fa0, ks0[8 * hf + 7] * fa0)};
            *(LAS u32x4*)(lds + A_KST + (2 * kp + 1) * 272 + 32 * w + 16 * hf) = (u32x4){pk2(ks1[8 * hf + 0] * fa1, ks1[8 * hf + 1] * fa1), pk2(ks1[8 * hf + 2] * fa1, ks1[8 * hf + 3] * fa1), pk2(ks1[8 * hf + 4] * fa1, ks1[8 * hf + 5] * fa1), pk2(ks1[8 * hf + 6] * fa1, ks1[8 * hf + 7] * fa1)}; }
        if (w == 0) { *(LAS f32x2*)(lds + A_DEC + 2 * kp * 4) = (f32x2){d0, d1}; pd0 *= d0; pd1 *= d1; }
        LBAR();
        bf16x8 vf[4];
#pragma unroll
        for (int kk = 0; kk < 4; ++kk) vf[kk] = *(LAS bf16x8*)(lds + A_VT + (16 * w + r16) * 272 + (32 * kk + 8 * quad) * 2);
#pragma unroll
        for (int mh = 0; mh < 4; ++mh) {
            bf16x8 af[2][4]; f32x4 dd[2];
#pragma unroll
            for (int mi = 0; mi < 2; ++mi) { const int m = 2 * mh + mi; dd[mi] = *(LAS f32x4*)(lds + A_DEC + (16 * m + 4 * quad) * 4);
#pragma unroll
                for (int kk = 0; kk < 4; ++kk) af[mi][kk] = *(LAS bf16x8*)(lds + A_KST + (16 * m + r16) * 272 + (32 * kk + 8 * quad) * 2); }
#pragma unroll
            for (int mi = 0; mi < 2; ++mi) { const int m = 2 * mh + mi; S[m] = S[m] * dd[mi];
#pragma unroll
                for (int kk = 0; kk < 4; ++kk) S[m] = MFMA16(af[mi][kk], vf[kk], S[m]); } }
        LBAR();
    }
    u32x4* sp = (u32x4*)((unsigned char*)p.out + OUT_ST + (size_t)slot * 32768) + (w * 64 + lane) * 4;
#pragma unroll
    for (int i = 0; i < 4; ++i) sp[i] = (u32x4){pk2(S[2 * i][0], S[2 * i][1]), pk2(S[2 * i][2], S[2 * i][3]), pk2(S[2 * i + 1][0], S[2 * i + 1][1]), pk2(S[2 * i + 1][2], S[2 * i + 1][3])};
    if (w == 0) *(f32x2*)((float*)(p.ws + WS_LOGD) + slot * 128 + 2 * kp) = (f32x2){pd0, pd1};
}
__device__ __forceinline__ void hgrn_passA_item(ldsp lds, int item, int layer, const Params& p) { if (item & 1) hgrn_passA_dir<1>(lds, item, layer, p); else hgrn_passA_dir<0>(lds, item, layer, p); }

__device__ __forceinline__ void hgrn_passB(const Params& p) {
    unsigned char* ST = (unsigned char*)p.out + OUT_ST; const float* LD = (const float*)(p.ws + WS_LOGD);
    const int gt = blockIdx.x * 512 + ltid(), NT = gridDim.x * 512;
#pragma unroll 1
    for (int e = gt; e < 64 * 4096; e += NT) {
        const int chain = e >> 12, q = e & 4095, m = q & 7, ln = (q >> 3) & 63, sq = chain >> 3, h = (chain >> 1) & 3, dir = chain & 1;
        const int kd = 16 * m + 4 * (ln >> 4);
        const int seg0 = sq < 4 ? sq * 32 : 128 + (sq - 4) * 16, n = sq < 4 ? 32 : 16;
        const int sgf = dir ? seg0 + n - 1 : seg0, step = dir ? -1 : 1;
        f32x4 carry = {0.f, 0.f, 0.f, 0.f};
#pragma unroll 1
        for (int s0 = 0; s0 < n; s0 += 16) {
            u32x2 loc[16]; f32x4 dd[16];
#pragma unroll
            for (int s = 0; s < 16; ++s) { const int slot = ((sgf + step * (s0 + s)) * 4 + h) * 2 + dir; loc[s] = *(const u32x2*)(ST + (size_t)slot * 32768 + q * 8); dd[s] = *(const f32x4*)(LD + slot * 128 + kd); }
#pragma unroll
            for (int s = 0; s < 16; ++s) { const int slot = ((sgf + step * (s0 + s)) * 4 + h) * 2 + dir;
                *(u32x2*)(ST + (size_t)slot * 32768 + q * 8) = (u32x2){pk2(carry[0], carry[1]), pk2(carry[2], carry[3])};
                carry = dd[s] * carry + (f32x4){bflo(loc[s].x), bfhi(loc[s].x), bflo(loc[s].y), bfhi(loc[s].y)}; }
        }
    }
}

template <int DIR> __device__ __forceinline__ void hgrn_passC_dir(ldsp lds, int item, int layer, const Params& p) {
    const int tid = ltid(), lane = tid & 63, w = __builtin_amdgcn_readfirstlane(tid >> 6), r16 = lane & 15, quad = lane >> 4;
    const int h = item & 3, sg = item >> 2;
    const int kp = lane;
    const f32x4 gn = *(const f32x4*)(p.hgrn_g + layer * 128 + 16 * w + 4 * quad);
    constexpr int dir = DIR;
    {
        const int slot = (sg * 4 + h) * 2 + dir;
        float lb0 = 0.f, lb1 = 0.f;
        if (layer) { const float* lp = dir ? p.lb_b : p.lb_f; const f32x2 a = *(const f32x2*)(lp + 512 + h * 128 + 2 * kp), b = *(const f32x2*)(lp + h * 128 + 2 * kp); lb0 = sigmoidf_(a.x - b.x); lb1 = sigmoidf_(a.y - b.y); }
        const float om0 = 1.f - lb0, om1 = 1.f - lb1;
        f32x4 S[8];
        { const u32x4* sp = (const u32x4*)((const unsigned char*)p.out + OUT_ST + (size_t)slot * 32768) + (w * 64 + lane) * 4;
#pragma unroll
          for (int i = 0; i < 4; ++i) { const u32x4 t = sp[i]; S[2 * i] = (f32x4){bflo(t.x), bfhi(t.x), bflo(t.y), bfhi(t.y)}; S[2 * i + 1] = (f32x4){bflo(t.z), bfhi(t.z), bflo(t.w), bfhi(t.w)}; } }
        unsigned char* Pb = p.ws + WS_HQ; bf16* Y = (bf16*)(p.ws + WS_Y);
        const unsigned aq = (unsigned)h * HHEAD + kp * 4u, az = (dir ? 3u : 2u) * HARR + (unsigned)h * HHEAD + kp * 4u, av = HARR + (unsigned)h * HHEAD + kp * 4u;
        const unsigned colo = 2u * HARR + (unsigned)h * HHEAD + (16 * w + 4 * quad) * 2u;
        unsigned zr[8], qr[8], vr[8];
        { const int c0 = sg * 256 + (dir ? (SEGC - 1) : 0) * 64;
#pragma unroll
          for (int i = 0; i < 8; ++i) { zr[i] = HG_LD(az, c0, i); qr[i] = HG_LD(aq, c0, i); vr[i] = HG_LD(av, c0, i); } }
#pragma unroll 1
        for (int cc = 0; cc < SEGC; ++cc) {
            const int c0 = sg * 256 + (dir ? (SEGC - 1 - cc) : cc) * 64;
            u32x2 ofr[4], ggr[4];
            {
                float el0[8], el1[8], kk0[8], kk1[8], q0[8], q1[8]; float E0 = 1.f, E1 = 1.f;
#pragma unroll
                for (int i = 0; i < 8; ++i) { float f0, f1; gate_fk(bflo(zr[i]), lb0, om0, f0, kk0[i]); gate_fk(bfhi(zr[i]), lb1, om1, f1, kk1[i]); E0 *= f0; E1 *= f1; el0[i] = E0; el1[i] = E1; q0[i] = bflo(qr[i]); q1[i] = bfhi(qr[i]); }
                *(LAS f32x2*)(lds + H_T8 + (w * 128 + 2 * kp) * 4) = (f32x2){E0, E1};
                *(LAS u32x4*)(lds + H_VT + (2 * kp) * 144 + 16 * w) = (u32x4){__builtin_amdgcn_perm(vr[1], vr[0], 0x05040100u), __builtin_amdgcn_perm(vr[3], vr[2], 0x05040100u), __builtin_amdgcn_perm(vr[5], vr[4], 0x05040100u), __builtin_amdgcn_perm(vr[7], vr[6], 0x05040100u)};
                *(LAS u32x4*)(lds + H_VT + (2 * kp + 1) * 144 + 16 * w) = (u32x4){__builtin_amdgcn_perm(vr[1], vr[0], 0x07060302u), __builtin_amdgcn_perm(vr[3], vr[2], 0x07060302u), __builtin_amdgcn_perm(vr[5], vr[4], 0x07060302u), __builtin_amdgcn_perm(vr[7], vr[6], 0x07060302u)};
                if (cc + 1 < SEGC) { const int c1 = sg * 256 + (dir ? (SEGC - 2 - cc) : cc + 1) * 64;
#pragma unroll
                    for (int i = 0; i < 8; ++i) { zr[i] = HG_LD(az, c1, i); qr[i] = HG_LD(aq, c1, i); vr[i] = HG_LD(av, c1, i); } }
                if (dir == 1) {
#pragma unroll
                    for (int tt = 0; tt < 4; ++tt) { const int tok = c0 + 63 - (16 * tt + r16); ofr[tt] = *(const u32x2*)(Pb + ((unsigned)tok * 256u + colo)); ggr[tt] = *(const u32x2*)(Y + (size_t)tok * 1024 + PC_YC + h * 128 + 16 * w + 4 * quad); } }
                LBAR();
                f32x2 T[8], PF[9];
#pragma unroll
                for (int g = 0; g < 8; ++g) T[g] = *(LAS f32x2*)(lds + H_T8 + (g * 128 + 2 * kp) * 4);
                PF[0] = (f32x2){1.f, 1.f};
#pragma unroll
                for (int g = 0; g < 8; ++g) PF[g + 1] = PF[g] * T[g];
                f32x2 pf;
                switch (w) { case 0: pf = PF[0]; break; case 1: pf = PF[1]; break; case 2: pf = PF[2]; break; case 3: pf = PF[3]; break; case 4: pf = PF[4]; break; case 5: pf = PF[5]; break; case 6: pf = PF[6]; break; default: pf = PF[7]; break; }
                float bt0[8], bt1[8];
#pragma unroll
                for (int i = 0; i < 8; ++i) { const int tau = 8 * w + i;
                    const float e0 = pf.x * el0[i], e1 = pf.y * el1[i];
                    bt0[i] = kk0[i] * __builtin_amdgcn_rcpf(fmaxf(e0, 1e-34f)); bt1[i] = kk1[i] * __builtin_amdgcn_rcpf(fmaxf(e1, 1e-34f));
                    *(LAS unsigned*)(lds + H_QS + tau * 272 + kp * 4) = pk2(q0[i] * e0, q1[i] * e1);
                    *(LAS unsigned*)(lds + H_KD + tau * 272 + kp * 4) = pk2(bt0[i], bt1[i]); }
                *(LAS u32x4*)(lds + H_KST + (2 * kp) * 144 + 16 * w) = (u32x4){pk2(bt0[0], bt0[1]), pk2(bt0[2], bt0[3]), pk2(bt0[4], bt0[5]), pk2(bt0[6], bt0[7])};
                *(LAS u32x4*)(lds + H_KST + (2 * kp + 1) * 144 + 16 * w) = (u32x4){pk2(bt1[0], bt1[1]), pk2(bt1[2], bt1[3]), pk2(bt1[4], bt1[5]), pk2(bt1[6], bt1[7])};
                if (w == 4) *(LAS f32x2*)(lds + H_DEC + 2 * kp * 4) = PF[8];
                LBAR();
            }
            if (w < 4) score_tile(lds, H_QS + 16 * w * 272, H_KD + 16 * w * 272, w, w, true, r16, quad);
            else if (w < 7) score_tile(lds, H_QS + 16 * (w - 3) * 272, H_KD + 16 * (w - 4) * 272, w - 3, w - 4, false, r16, quad);
            else score_tile(lds, H_QS + 32 * 272, H_KD, 2, 0, false, r16, quad);
            if (w == 0) score_tile(lds, H_QS + 48 * 272, H_KD + 16 * 272, 3, 1, false, r16, quad);
            if (w == 1) score_tile(lds, H_QS + 48 * 272, H_KD, 3, 0, false, r16, quad);
            if (w == 2) *(LAS u32x2*)(lds + H_SC + (r16) * 144 + (16 + 4 * quad) * 2) = (u32x2){0u, 0u};
            if (w == 3) *(LAS u32x2*)(lds + H_SC + (32 + r16) * 144 + (48 + 4 * quad) * 2) = (u32x2){0u, 0u};
            f32x4 o[4];
            bf16x8 sa[4];
#pragma unroll
            for (int pp = 0; pp < 4; ++pp) sa[pp] = mk8(pk2(S[2 * pp][0], S[2 * pp][1]), pk2(S[2 * pp][2], S[2 * pp][3]), pk2(S[2 * pp + 1][0], S[2 * pp + 1][1]), pk2(S[2 * pp + 1][2], S[2 * pp + 1][3]));
#pragma unroll
            for (int tt = 0; tt < 4; ++tt) { o[tt] = (f32x4){0.f, 0.f, 0.f, 0.f};
                u32x2 qb[4][2];
#pragma unroll
                for (int pp = 0; pp < 4; ++pp) { qb[pp][0] = *(LAS u32x2*)(lds + H_QS + (16 * tt + r16) * 272 + (32 * pp + 4 * quad) * 2); qb[pp][1] = *(LAS u32x2*)(lds + H_QS + (16 * tt + r16) * 272 + (32 * pp + 16 + 4 * quad) * 2); }
#pragma unroll
                for (int pp = 0; pp < 4; ++pp) o[tt] = MFMA16(sa[pp], mk8(qb[pp][0].x, qb[pp][0].y, qb[pp][1].x, qb[pp][1].y), o[tt]); }
            LBAR();
            bf16x8 vf[2];
#pragma unroll
            for (int kk = 0; kk < 2; ++kk) vf[kk] = *(LAS bf16x8*)(lds + H_VT + (16 * w + r16) * 144 + (32 * kk + 8 * quad) * 2);
            bf16x8 scf[4][2];
#pragma unroll
            for (int tt = 0; tt < 4; ++tt)
#pragma unroll
                for (int kk = 0; kk < 2; ++kk) { if (kk == 1 && tt < 2) continue; scf[tt][kk] = *(LAS bf16x8*)(lds + H_SC + (16 * tt + r16) * 144 + (32 * kk + 8 * quad) * 2); }
#pragma unroll
            for (int tt = 0; tt < 4; ++tt)
#pragma unroll
                for (int kk = 0; kk < 2; ++kk) { if (kk == 1 && tt < 2) continue; o[tt] = MFMA16(vf[kk], scf[tt][kk], o[tt]); }
#pragma unroll
            for (int mh = 0; mh < 2; ++mh) {
                bf16x8 af[4][2]; f32x4 dd[4];
#pragma unroll
                for (int mi = 0; mi < 4; ++mi) { const int m = 4 * mh + mi;
#pragma unroll
                    for (int kk = 0; kk < 2; ++kk) af[mi][kk] = *(LAS bf16x8*)(lds + H_KST + (16 * m + r16) * 144 + (32 * kk + 8 * quad) * 2);
                    dd[mi] = *(LAS f32x4*)(lds + H_DEC + (16 * m + 4 * quad) * 4); }
#pragma unroll
                for (int mi = 0; mi < 4; ++mi) { const int m = 4 * mh + mi;
#pragma unroll
                    for (int kk = 0; kk < 2; ++kk) S[m] = MFMA16(af[mi][kk], vf[kk], S[m]);
                    S[m] = S[m] * dd[mi]; } }
            if (dir == 0) {
#pragma unroll
                for (int tt = 0; tt < 4; ++tt) { const int tok = c0 + 16 * tt + r16; u32x2 ov; ov.x = pk2(o[tt][0], o[tt][1]); ov.y = pk2(o[tt][2], o[tt][3]);
                    *(u32x2*)(Pb + ((unsigned)tok * 256u + colo)) = ov; }
                LBAR();
            } else {
#pragma unroll
                for (int tt = 0; tt < 4; ++tt) { const int tok = c0 + 63 - (16 * tt + r16);
                    const u32x2 of = ofr[tt];
                    o[tt][0] += bflo(of.x); o[tt][1] += bfhi(of.x); o[tt][2] += bflo(of.y); o[tt][3] += bfhi(of.y);
                    float ss = (o[tt][0] * o[tt][0] + o[tt][1] * o[tt][1]) + (o[tt][2] * o[tt][2] + o[tt][3] * o[tt][3]);
                    ss += __shfl_xor(ss, 16); ss += __shfl_xor(ss, 32);
                    if (quad == 0) *(LAS float*)(lds + H_OS + (w * 64 + 16 * tt + r16) * 4) = ss; }
                LBAR();
#pragma unroll
                for (int tt = 0; tt < 4; ++tt) { const int tau = 16 * tt + r16, tok = c0 + 63 - tau; float tot = 0.f;
#pragma unroll
                    for (int ww = 0; ww < 8; ++ww) tot += *(LAS float*)(lds + H_OS + (ww * 64 + tau) * 4);
                    const float rs = __builtin_amdgcn_rsqf(tot * (1.f / 128.f) + EPS);
                    bf16* gp = Y + (size_t)tok * 1024 + PC_YC + h * 128 + 16 * w + 4 * quad; const u32x2 g = ggr[tt]; u32x2 ov;
                    ov.x = pk2(o[tt][0] * rs * gn[0] * bflo(g.x), o[tt][1] * rs * gn[1] * bfhi(g.x)); ov.y = pk2(o[tt][2] * rs * gn[2] * bflo(g.y), o[tt][3] * rs * gn[3] * bfhi(g.y));
                    *(u32x2*)gp = ov; }
            }
        }
        __syncthreads();
    }
}
__device__ __forceinline__ void hgrn_passC_item(ldsp lds, int item, int layer, const Params& p) { hgrn_passC_dir<0>(lds, item, layer, p); hgrn_passC_dir<1>(lds, item, layer, p); }

#define XB_TMO      128
#define XB_XCNT(j)  (256  + 64 * (j))
#define XB_XSUB(j)  (1280 + 64 * (j))
#define XB_XGEN(j)  (2304 + 64 * (j))
#define XB_TOP      3328
#define XB_TOPGEN   3392
#define XCD_BAR_WORDS 3456
#define XB_SPIN_CAP (1u << 18)

__device__ __forceinline__ unsigned xb_ld(unsigned* p)              { return __hip_atomic_load(p, __ATOMIC_RELAXED, __HIP_MEMORY_SCOPE_AGENT); }
__device__ __forceinline__ unsigned xb_add(unsigned* p, unsigned v) { return __hip_atomic_fetch_add(p, v, __ATOMIC_RELAXED, __HIP_MEMORY_SCOPE_AGENT); }
__device__ __forceinline__ unsigned xb_xcc_id() { return (unsigned)__builtin_amdgcn_s_getreg((3 << 11) | 20) & 0xFu; }
#define XB_SPIN(cond, bar) do { unsigned _sp = 0; while (cond) { __builtin_amdgcn_s_sleep(1); \
    if ((++_sp & 255u) == 0u) { if (xb_ld(&(bar)[XB_TMO])) break; if (_sp > XB_SPIN_CAP) { atomicAdd(&(bar)[XB_TMO], 1u); break; } } } } while (0)

struct XcdBarrier {
    unsigned* bar; unsigned x;
    volatile LAS unsigned* st;
};

__device__ __forceinline__ XcdBarrier xcd_barrier_post(unsigned* bar, volatile LAS unsigned* st) {
    XcdBarrier b; b.bar = bar; b.x = xb_xcc_id(); b.st = st;
    if (ltid() == 0) (void)xb_add(&bar[XB_XCNT(b.x)], 1u);
    return b;
}
__device__ __forceinline__ void xcd_barrier_complete(unsigned* bar, unsigned x, unsigned& nloc, unsigned& nx) {
    const unsigned G = gridDim.x * gridDim.y * gridDim.z;
    unsigned sum, cnt, mine, sp = 0u;
    for (;;) {
        sum = 0u; cnt = 0u; mine = 0u;
#pragma unroll
        for (unsigned j = 0; j < 16; ++j) { const unsigned c = xb_ld(&bar[XB_XCNT(j)]); sum += c; cnt += (c > 0u) ? 1u : 0u; mine = (j == x) ? c : mine; }
        if (sum == G) break;
        __builtin_amdgcn_s_sleep(1);
        if ((++sp & 255u) == 0u) { if (xb_ld(&bar[XB_TMO])) break; if (sp > XB_SPIN_CAP) { atomicAdd(&bar[XB_TMO], 1u); break; } }
    }
    nloc = mine > 0u ? mine : 1u; nx = cnt > 0u ? cnt : 1u;
}

__device__ __forceinline__ void xcd_barrier(const XcdBarrier& b) {
    asm volatile("s_waitcnt vmcnt(0)" ::: "memory");
    __syncthreads();
    if (ltid() == 0) {
        unsigned* bar = b.bar;
        __builtin_amdgcn_s_waitcnt(0);
        unsigned nloc = b.st[0], nx = b.st[1];
        if (nloc == 0u) { xcd_barrier_complete(bar, b.x, nloc, nx); b.st[0] = nloc; b.st[1] = nx; }
        const unsigned old = xb_add(&bar[XB_XSUB(b.x)], 1u);
        const unsigned gen = old / nloc;
        if (old + 1u == (gen + 1u) * nloc) {
            __builtin_amdgcn_fence(__ATOMIC_RELEASE, "agent");
            asm volatile("s_waitcnt vmcnt(0)" ::: "memory");
            const unsigned og = xb_add(&bar[XB_TOP], 1u);
            const unsigned tg = og / nx;
            if (og + 1u == (tg + 1u) * nx) xb_add(&bar[XB_TOPGEN], 1u);
            else XB_SPIN(xb_ld(&bar[XB_TOPGEN]) == tg, bar);
            __builtin_amdgcn_fence(__ATOMIC_ACQUIRE, "agent");
            xb_add(&bar[XB_XGEN(b.x)], 1u);
            asm volatile("s_waitcnt vmcnt(0)" ::: "memory");
        } else {
            XB_SPIN(xb_ld(&bar[XB_XGEN(b.x)]) == gen, bar);
            __builtin_amdgcn_fence(__ATOMIC_ACQUIRE, "agent");
            asm volatile("s_waitcnt vmcnt(0)" ::: "memory");
        }
    }
    __syncthreads();
}


__global__ void __launch_bounds__(512, 2) fwd_kernel(Params p) {
    extern __shared__ __attribute__((aligned(16))) unsigned char lds_raw[];
    ldsp lds = (ldsp)lds_raw;
    cg::grid_group grid = cg::this_grid();
    unsigned char* ws = p.ws;
    bf16* XB = (bf16*)(ws + WS_XB); float* part = (float*)(ws + WS_PART);
    const int G = gridDim.x, bx = blockIdx.x;
    if (ltid() < 2) *(LAS unsigned*)(lds + LDS_BARST + 4 * ltid()) = 0u;
    __syncthreads();
    const XcdBarrier xbar = xcd_barrier_post((unsigned*)(ws + WS_BAR), (volatile LAS unsigned*)(lds + LDS_BARST));
#pragma unroll 1
    for (int ph = p.ph_lo; ph < p.ph_hi; ++ph) {
        if (ph == 0) prologue(lds, p);
        else if (ph == NPH - 1) final_norm(p);
        else {
            const int layer = (ph - 1) / 5, sub = (ph - 1) % 5;
            if (sub == 0) {
                pg8::Gemm g{layer == 0 ? XB : (const bf16*)p.out, (const bf16*)(ws + WS_BT1) + (size_t)layer * DIN * D, M, DIN, D, D}; pg8::StaticOrder S; S.init(M, DIN, G, bx);
                Epi1 E{ws, part};
                pg8::gemm_phase<Epi1, pg8::StaticOrder, true, true>(lds, g, S, E);
            } else if (sub == 1) {
                for (int it = bx; it < NSEG * 8; it += G) hgrn_passA_item(lds, it, layer, p);
            } else if (sub == 2) {
                hgrn_passB(p);
                { const int t_ = ltid(); if (t_ < 256) { *(LAS float*)(lds + L_LNP + 4 * t_) = p.conv_ln_g[layer * 256 + t_]; *(LAS float*)(lds + L_LNP + 1024 + 4 * t_) = p.conv_ln_b[layer * 256 + t_];
                      *(LAS float*)(lds + L_LNP + 2048 + 4 * t_) = p.sgu_ln_g[layer * 256 + t_]; *(LAS float*)(lds + L_LNP + 3072 + 4 * t_) = p.sgu_ln_b[layer * 256 + t_]; } }
                { f32x2 w2[31]; const int cp = ltid() & 127; const float* cw = p.conv_w + layer * 31 * 256;
#pragma unroll
                  for (int j = 0; j < 31; ++j) w2[j] = *(const f32x2*)(cw + j * 256 + 2 * cp);
                  const f32x2 bb2 = *(const f32x2*)(p.conv_b + layer * 256 + 2 * cp);
                  u32x4 inr[6]; CONV_LOAD_IN(inr, bx < 768 ? bx : 0, ltid());
                  for (int it = bx; it < 768; it += G) conv_item(lds, it, layer, p, w2, bb2, inr, it + G < 768 ? it + G : -1); }
                { u32x4 bv[8]; const int tid_ = ltid(); const int it0 = bx < 768 ? bx : 0;
                  { const bf16* src = (const bf16*)(p.ws + WS_BV) + (size_t)((it0 >> 1) * 128 + (tid_ >> 2)) * 256;
#pragma unroll
                    for (int i = 0; i < 8; ++i) bv[i] = *(const u32x4*)(src + 32 * i + 8 * (tid_ & 3)); }
                  for (int it = bx; it < 768; it += G) sgu_item(lds, it, layer, p, bv, it + G < 768 ? it + G : -1); }
            } else if (sub == 3) {
                for (int it = bx; it < NSEG * 4; it += G) hgrn_passC_item(lds, it, layer, p);
            } else {
                pg8::Gemm g{(const bf16*)(ws + WS_Y), (const bf16*)(ws + WS_BT2) + (size_t)layer * D * D, M, D, D, D}; pg8::StaticOrder S; S.init(M, D, G, bx);
                Epi2 E{p.xp, p.xs, M0, layer == 0 ? (const bf16*)XB : (const bf16*)p.out, nullptr, layer == 0 ? (bf16*)p.out : XB, part};
                pg8::gemm_phase<Epi2, pg8::StaticOrder, true, true>(lds, g, S, E);
            }
        }
        if (ph + 1 < p.ph_hi) { if (p.ph_hi > NPH) grid.sync();
                                xcd_barrier(xbar); }
    }
}

extern "C" void kernel_launch(void* const* d_in, const int* in_sizes, int n_in, void* d_out, int out_size, void* d_ws, size_t ws_size, hipStream_t stream) {
    static int grid = 0;
    if (grid == 0) {
        if (n_in != 18 || out_size != M * D || ws_size < WS_END) { fprintf(stderr, "kernel_launch: unexpected shapes (n_in %d out %d ws %zu)\n", n_in, out_size, ws_size); grid = -1; return; }
        int dev = 0, cus = 0, per_cu = 0;
        hipGetDevice(&dev); hipDeviceGetAttribute(&cus, hipDeviceAttributeMultiprocessorCount, dev);
        hipFuncSetAttribute((const void*)fwd_kernel, hipFuncAttributeMaxDynamicSharedMemorySize, LDS_BYTES);
        if (hipOccupancyMaxActiveBlocksPerMultiprocessor(&per_cu, (const void*)fwd_kernel, 512, LDS_BYTES) != hipSuccess || per_cu < 1) per_cu = 1;
        (void)hipGetLastError();
        grid = cus * per_cu;
    }
    if (grid < 0) return;
    Params p{};
    const float** pp = (const float**)&p;
    for (int i = 0; i < 18; ++i) pp[i] = (const float*)d_in[i];
    p.out = (float*)d_out; p.ws = (unsigned char*)d_ws;
    if (hipMemsetAsync((char*)d_ws + WS_BAR, 0, 16384, stream) != hipSuccess) { fprintf(stderr, "kernel_launch: memset of the barrier words failed\n"); return; }
#if ONE_LAUNCH
    p.ph_lo = 0; p.ph_hi = NPH;
    void* args[] = {&p};
    hipError_t e = hipLaunchCooperativeKernel((const void*)fwd_kernel, dim3(grid), dim3(512), args, LDS_BYTES, stream);
    if (e != hipSuccess) fprintf(stderr, "cooperative launch failed: %s (grid %d)\n", hipGetErrorString(e), grid);
#else
    for (int ph = 0; ph < NPH; ++ph) { p.ph_lo = ph; p.ph_hi = ph + 1; hipLaunchKernelGGL(fwd_kernel, dim3(grid), dim3(512), LDS_BYTES, stream, p); }
#endif
}
```
